# Optimizing an MI355X kernel written in HIP

```python
import jax, jax.numpy as jnp
from jax import lax
import numpy as np

D_MODEL = 2048
BATCH = 1
SEQ = 8192
DEPTH = 1

A_HEAD_DIM = 128
A_WIDTH = D_MODEL // 2
A_HEADS = A_WIDTH // A_HEAD_DIM
A_CHUNK = 64
B_HEAD_DIM = 128
B_WIDTH = D_MODEL // 2
B_HEADS = B_WIDTH // B_HEAD_DIM
Q_BLOCK = 128
D_FF = -(-(8 * D_MODEL) // (3 * 256)) * 256
N_IN = 4 * A_WIDTH + 3 * B_WIDTH + B_HEADS + 2 * D_MODEL
RMS_EPS = 1e-6

kernel_name = "hgrn2_fox_gated_parallel_sandwich_block"


def _in_split_points():
    sizes = [A_WIDTH] * 4 + [B_WIDTH] * 3 + [B_HEADS, D_MODEL, D_MODEL]
    return [int(v) for v in np.cumsum(sizes)[:-1]]


def rms_norm(x, w):
    xf = x.astype(jnp.float32)
    y = xf * lax.rsqrt(jnp.mean(xf * xf, axis=-1, keepdims=True) + RMS_EPS)
    return (y * w.astype(jnp.float32)).astype(x.dtype)


def hgrn2_mixer(q, f_logit, i, g, lb, norm_w):
    B, S, _ = q.shape
    H, D, C = A_HEADS, A_HEAD_DIM, A_CHUNK
    z = f_logit.astype(jnp.float32)
    lb = lb.astype(jnp.float32)
    log_f = jnp.log(lb + (1.0 - lb) * jax.nn.sigmoid(z))
    k = (1.0 - lb) * jax.nn.sigmoid(-z)

    def to_chunks(t):
        return t.astype(jnp.float32).reshape(B, S // C, C, H, D).transpose(1, 0, 3, 2, 4)

    causal = jnp.tril(jnp.ones((C, C), dtype=bool))[None, None, :, :, None]

    def step(state, inp):
        qc, kc, vc, gc = inp
        b = jnp.cumsum(gc, axis=2)
        o_inter = jnp.einsum('bhtk,bhkv->bhtv', qc * jnp.exp(b), state)
        diff = jnp.where(causal, b[:, :, :, None, :] - b[:, :, None, :, :], -jnp.inf)
        scores = jnp.einsum('bhtsk,bhsk->bhts', qc[:, :, :, None, :] * jnp.exp(diff), kc)
        o_intra = jnp.einsum('bhts,bhsv->bhtv', scores, vc)
        b_last = b[:, :, -1:, :]
        k_dec = kc * jnp.exp(b_last - b)
        new_state = jnp.exp(b_last[:, :, 0, :])[..., None] * state + jnp.einsum('bhsk,bhsv->bhkv', k_dec, vc)
        return new_state, o_inter + o_intra

    state0 = jnp.zeros((B, H, D, D), jnp.float32)
    _, o = lax.scan(step, state0, (to_chunks(q), to_chunks(k), to_chunks(i), to_chunks(log_f)))
    o = o.transpose(1, 0, 3, 2, 4).reshape(B, S, H, D)
    o = rms_norm(o, norm_w) * jax.nn.silu(g.astype(jnp.float32).reshape(B, S, H, D))
    return o.reshape(B, S, A_WIDTH).astype(q.dtype)


def fox_mixer(q, k, v, f_logit):
    B, S, _ = q.shape
    H, D, Qb = B_HEADS, B_HEAD_DIM, Q_BLOCK
    n_blk = S // Qb
    qh = q.reshape(B, S, H, D).transpose(0, 2, 1, 3) * (D ** -0.5)
    kh = k.reshape(B, S, H, D).transpose(0, 2, 1, 3)
    vh = v.reshape(B, S, H, D).transpose(0, 2, 1, 3)
    cum = jnp.cumsum(jax.nn.log_sigmoid(f_logit.astype(jnp.float32)), axis=1).transpose(0, 2, 1)
    q_blocks = qh.reshape(B, H, n_blk, Qb, D).transpose(2, 0, 1, 3, 4)
    c_blocks = cum.reshape(B, H, n_blk, Qb).transpose(2, 0, 1, 3)
    pos_k = jnp.arange(S)

    def block(args):
        idx, q_blk, c_blk = args
        pos_q = idx * Qb + jnp.arange(Qb)
        s = jnp.einsum('bhqd,bhkd->bhqk', q_blk, kh).astype(jnp.float32)
        s = s + c_blk[..., None] - cum[:, :, None, :]
        s = jnp.where((pos_q[:, None] >= pos_k[None, :])[None, None], s, -jnp.inf)
        p = jax.nn.softmax(s, axis=-1)
        return jnp.einsum('bhqk,bhkd->bhqd', p.astype(vh.dtype), vh)

    out = lax.map(block, (jnp.arange(n_blk), q_blocks, c_blocks))
    return out.transpose(1, 0, 3, 2, 4).reshape(B, S, B_WIDTH)


def setup_inputs(seed: int = 0) -> dict:
    key = jax.random.key(seed)
    ks = jax.random.split(key, 14)
    f32 = jnp.float32

    def dense(k, fan_in, fan_out):
        return jax.random.normal(k, (DEPTH, fan_in, fan_out), f32) * fan_in ** -0.5

    def gain(k, n):
        return 1.0 + 0.02 * jax.random.normal(k, (DEPTH, n), f32)

    return {
        "x": jax.random.normal(ks[0], (BATCH, SEQ, D_MODEL), f32),
        "w_in": dense(ks[1], D_MODEL, N_IN),
        "b_fox_f": 0.1 * jax.random.normal(ks[2], (DEPTH, B_HEADS), f32),
        "hgrn_lb_logits": jax.random.normal(ks[3], (DEPTH + 1, A_WIDTH), f32),
        "hgrn_norm_w": gain(ks[4], A_HEAD_DIM),
        "w_up_a": dense(ks[5], A_WIDTH, D_MODEL),
        "w_up_b": dense(ks[6], B_WIDTH, D_MODEL),
        "w_o": dense(ks[7], D_MODEL, D_MODEL),
        "norm_mix_pre": gain(ks[8], D_MODEL),
        "norm_mix_post": gain(ks[9], D_MODEL),
        "norm_ffn_pre": gain(ks[10], D_MODEL),
        "norm_ffn_post": gain(ks[11], D_MODEL),
        "w_ffn_in": dense(ks[12], D_MODEL, 2 * D_FF),
        "w_ffn_down": dense(ks[13], D_FF, D_MODEL),
    }


def reference(x, w_in, b_fox_f, hgrn_lb_logits, hgrn_norm_w, w_up_a, w_up_b, w_o,
              norm_mix_pre, norm_mix_post, norm_ffn_pre, norm_ffn_post, w_ffn_in, w_ffn_down):
    split_points = _in_split_points()
    lb_table = jnp.cumsum(jax.nn.softmax(hgrn_lb_logits.astype(jnp.float32), axis=0), axis=0)
    for l in range(DEPTH):
        h = rms_norm(x, norm_mix_pre[l])
        proj = h @ w_in[l]
        a_q, a_f, a_i, a_g, b_q, b_k, b_v, b_f, g_a, g_b = jnp.split(proj, split_points, axis=-1)
        y_a = hgrn2_mixer(a_q, a_f, a_i, a_g, lb_table[l], hgrn_norm_w[l]) @ w_up_a[l]
        y_b = fox_mixer(b_q, b_k, b_v, b_f + b_fox_f[l]) @ w_up_b[l]
        merged = jax.nn.sigmoid(g_a) * y_a + jax.nn.sigmoid(g_b) * y_b
        x = x + rms_norm(merged @ w_o[l], norm_mix_post[l])
        h = rms_norm(x, norm_ffn_pre[l])
        gate, up = jnp.split(h @ w_ffn_in[l], 2, axis=-1)
        x = x + rms_norm((jax.nn.silu(gate) * up) @ w_ffn_down[l], norm_ffn_post[l])
    return x
```

```cpp
#include <hip/hip_runtime.h>
#include <hip/hip_cooperative_groups.h>
#include <cstdio>
#include <cstdint>
namespace cg = cooperative_groups;

constexpr int S = 8192, DM = 2048, AW = 1024, NIN = 11272, DFF = 5632;
constexpr float EPS = 1e-6f;
constexpr float QSCALE = 0.08838834764831845f * 1.4426950408889634f;
constexpr float LOG2E = 1.4426950408889634f;

namespace pg8 {
#define PG8_LAS __attribute__((address_space(3)))
typedef unsigned short bf16_t;
typedef short bf16x8 __attribute__((ext_vector_type(8)));
typedef float f32x4 __attribute__((ext_vector_type(4)));
typedef unsigned u32x4 __attribute__((ext_vector_type(4)));
constexpr int BM = 256, BK = 64, HALF = 128, HTB = HALF * BK * 2  , STAGE_BYTES = 8 * HTB, NXCD = 8, WGM = 8;

__host__ __device__ __forceinline__ int lds_byte(int r, int c) { const int st = (r >> 4) * 2 + (c >> 5), rr = r & 15, cc = c & 31, ob = rr * 64 + cc * 2; return st * 1024 + (ob ^ (((ob >> 9) & 1) << 5)); }
__host__ __device__ __forceinline__ void stage_rc(int b, int& R, int& C) { const int st = b / 1024, sb = b % 1024, swz = sb ^ (((sb >> 9) & 1) << 5); R = (st >> 1) * 16 + swz / 64; C = (st & 1) * 32 + (swz % 64) / 2; }
__host__ __device__ __forceinline__ int perm32(int rho) { const int n = rho >> 4, i = rho & 15; return 8 * (i >> 2) + 4 * n + (i & 3); }

struct Unit { int pm, pn; };
struct Gemm { const bf16_t* A; const bf16_t* Bt; int M, N, K; };

struct StaticOrder {
    int nM, nN, nwg, G, c;
    __host__ __device__ void init(int M, int N, int G_, int c_) { nM = M / BM; nN = N / BM; nwg = nM * nN; G = G_; c = c_; }
    __host__ __device__ bool next(int i, Unit& u) const {
        const long L = (long)i * G + c; if (L >= nwg) return false;
        int wgid = (int)L; { const int q = nwg / NXCD, r = nwg % NXCD, xcd = wgid % NXCD, off = wgid / NXCD; wgid = (xcd < r ? xcd * (q + 1) : r * (q + 1) + (xcd - r) * q) + off; }
        const int nig = WGM * nN, gid = wgid / nig, fm = gid * WGM, gsz = (nM - fm) < WGM ? (nM - fm) : WGM;
        u.pm = fm + ((wgid % nig) % gsz); u.pn = (wgid % nig) / gsz; return true;
    }
    __device__ __forceinline__ void a_ready(const Unit&) const {}
    __device__ __forceinline__ void done(const Unit&) const {}
};

typedef float f32x2_cv __attribute__((ext_vector_type(2))); typedef __bf16 bf16x2_cv __attribute__((ext_vector_type(2)));
__device__ __forceinline__ unsigned cvt_pk_bf16(float lo, float hi) { f32x2_cv v = {lo, hi}; bf16x2_cv b = __builtin_convertvector(v, bf16x2_cv); return __builtin_bit_cast(unsigned, b); }
typedef unsigned u32x2 __attribute__((ext_vector_type(2)));
__device__ __forceinline__ float bf_lo(unsigned w) { return __uint_as_float(w << 16); }
__device__ __forceinline__ float bf_hi(unsigned w) { return __uint_as_float(w & 0xffff0000u); }
__device__ __forceinline__ float sigmoidf_(float z) { return 1.f / (1.f + __expf(-z)); }

struct EpiProj {
    static constexpr bool PERM = true, AFTER_DRAIN = false, HAS_MID = false;
    bf16_t* proj; float* alf; bf16_t* gab; const float* lb; unsigned* kmax;
    template <int MODE>
    __device__ __forceinline__ void tile(const f32x4 (&acc)[2][2][4][2], bf16_t* base, int ldc, int row0, int col0) const {
        float lbv[2][8];
        if (MODE == 1) {
#pragma unroll
            for (int bj = 0; bj < 2; ++bj)
#pragma unroll
                for (int j = 0; j < 8; ++j) lbv[bj][j] = lb[col0 + bj * HALF + j];
        }
#pragma unroll
        for (int ai = 0; ai < 2; ++ai)
#pragma unroll
            for (int m = 0; m < 4; ++m) {
                const size_t ro = (size_t)(row0 + ai * HALF + m * 16) * ldc + col0;
#pragma unroll
                for (int bj = 0; bj < 2; ++bj) {
                    float v[8];
#pragma unroll
                    for (int j = 0; j < 4; ++j) { v[j] = acc[ai][bj][m][0][j]; v[4 + j] = acc[ai][bj][m][1][j]; }
                    if (MODE == 1) {
                        float lf[8];
#pragma unroll
                        for (int j = 0; j < 8; ++j) {
                            const float z = v[j], l = lbv[bj][j];
                            const float t = __expf(-z), sg = __builtin_amdgcn_rcpf(1.f + t), sn = (t > 3.0e38f) ? 1.f : t * sg;
                            lf[j] = __logf(l + (1.f - l) * sg); v[j] = (1.f - l) * sn;
                        }
                        float* ap = alf + ro + bj * HALF;
                        *(f32x4*)ap = (f32x4){lf[0], lf[1], lf[2], lf[3]}; *(f32x4*)(ap + 4) = (f32x4){lf[4], lf[5], lf[6], lf[7]};
                    } else if (MODE == 2) {
#pragma unroll
                        for (int j = 0; j < 8; ++j) v[j] *= QSCALE;
                    } else if (MODE == 3) {
#pragma unroll
                        for (int j = 0; j < 8; ++j) v[j] = __builtin_amdgcn_rcpf(1.f + __expf(-v[j]));
                    }
                    u32x4 w; w.x = cvt_pk_bf16(v[0], v[1]); w.y = cvt_pk_bf16(v[2], v[3]); w.z = cvt_pk_bf16(v[4], v[5]); w.w = cvt_pk_bf16(v[6], v[7]);
                    *(u32x4*)(base + ro + bj * HALF) = w;
                }
            }
    }
    __device__ __forceinline__ void operator()(const f32x4 (&acc)[2][2][4][2], const Unit& u, int wr, int wc, int fr, int fq) const {
        const int pn = u.pn; const int row0 = u.pm * BM + wr * 64 + fr;
        if (pn < 28) {
            const int grp = pn >> 2; bf16_t* base = proj + (size_t)grp * ((size_t)S * 1024); const int col0 = (pn & 3) * 256 + wc * 32 + 8 * fq;
            if (grp == 1) tile<1>(acc, base, 1024, row0, col0); else if (grp == 4) tile<2>(acc, base, 1024, row0, col0); else tile<0>(acc, base, 1024, row0, col0);
            if (grp == 5) {
                float mx[2] = {0.f, 0.f};
#pragma unroll
                for (int ai = 0; ai < 2; ++ai)
#pragma unroll
                    for (int bj = 0; bj < 2; ++bj)
#pragma unroll
                        for (int m = 0; m < 4; ++m)
#pragma unroll
                            for (int n = 0; n < 2; ++n)
#pragma unroll
                                for (int j = 0; j < 4; ++j) mx[bj] = fmaxf(mx[bj], fabsf(acc[ai][bj][m][n][j]));
#pragma unroll
                for (int bj = 0; bj < 2; ++bj) {
#pragma unroll
                    for (int o = 1; o < 64; o <<= 1) mx[bj] = fmaxf(mx[bj], __shfl_xor(mx[bj], o));
                    if ((fr | (fq << 4)) == 0) __hip_atomic_fetch_max(kmax + 2 * (pn & 3) + bj, __float_as_uint(mx[bj]), __ATOMIC_RELAXED, __HIP_MEMORY_SCOPE_AGENT);
                }
            }
        } else {
            const int q = pn - 28; bf16_t* base = gab + (size_t)(q >> 3) * ((size_t)S * 2048); const int col0 = (q & 7) * 256 + wc * 32 + 8 * fq;
            tile<3>(acc, base, 2048, row0, col0);
        }
    }
};
struct EpiUp {
    static constexpr bool PERM = true, AFTER_DRAIN = false, HAS_MID = true;
    const bf16_t* ga; const bf16_t* gb; bf16_t* mg;
    __device__ __forceinline__ void mid(f32x4 (&acc)[2][2][4][2], const Unit& u, int wr, int wc, int fr, int fq) const {
        asm volatile("" : "+v"(fr), "+v"(fq));
        const int row0 = u.pm * BM + wr * 64 + fr, col0 = u.pn * BM + wc * 32 + 8 * fq;
#pragma unroll
        for (int ai = 0; ai < 2; ++ai) {
            u32x4 av[4][2], bv[4][2];
#pragma unroll
            for (int m = 0; m < 4; ++m)
#pragma unroll
                for (int bj = 0; bj < 2; ++bj) { const size_t ro = (size_t)(row0 + ai * HALF + m * 16) * DM + col0 + bj * HALF; av[m][bj] = *(const u32x4*)(ga + ro); bv[m][bj] = *(const u32x4*)(gb + ro); }
#pragma unroll
            for (int m = 0; m < 4; ++m)
#pragma unroll
                for (int bj = 0; bj < 2; ++bj) {
#pragma unroll
                    for (int q = 0; q < 4; ++q) { const unsigned aw = av[m][bj][q], bw = bv[m][bj][q];
                        const float r0 = bf_lo(aw) * __builtin_amdgcn_rcpf(fmaxf(bf_lo(bw), 1e-30f)), r1 = bf_hi(aw) * __builtin_amdgcn_rcpf(fmaxf(bf_hi(bw), 1e-30f));
                        acc[ai][bj][m][q >> 1][2 * (q & 1)] *= r0; acc[ai][bj][m][q >> 1][2 * (q & 1) + 1] *= r1; } }
            asm volatile("" ::: "memory");
        }
    }
    __device__ __forceinline__ void operator()(const f32x4 (&acc)[2][2][4][2], const Unit& u, int wr, int wc, int fr, int fq) const {
        const int row0 = u.pm * BM + wr * 64 + fr, col0 = u.pn * BM + wc * 32 + 8 * fq;
#pragma unroll
        for (int ai = 0; ai < 2; ++ai) {
            u32x4 gv[4][2];
#pragma unroll
            for (int m = 0; m < 4; ++m)
#pragma unroll
                for (int bj = 0; bj < 2; ++bj) gv[m][bj] = *(const u32x4*)(gb + (size_t)(row0 + ai * HALF + m * 16) * DM + col0 + bj * HALF);
#pragma unroll
            for (int m = 0; m < 4; ++m)
#pragma unroll
                for (int bj = 0; bj < 2; ++bj) { const size_t ro = (size_t)(row0 + ai * HALF + m * 16) * DM + col0 + bj * HALF;
                    const u32x4 gq = gv[m][bj];
                    float v[8];
#pragma unroll
                    for (int j = 0; j < 4; ++j) { v[j] = acc[ai][bj][m][0][j]; v[4 + j] = acc[ai][bj][m][1][j]; }
                    v[0] *= bf_lo(gq.x); v[1] *= bf_hi(gq.x); v[2] *= bf_lo(gq.y); v[3] *= bf_hi(gq.y); v[4] *= bf_lo(gq.z); v[5] *= bf_hi(gq.z); v[6] *= bf_lo(gq.w); v[7] *= bf_hi(gq.w);
                    u32x4 w; w.x = cvt_pk_bf16(v[0], v[1]); w.y = cvt_pk_bf16(v[2], v[3]); w.z = cvt_pk_bf16(v[4], v[5]); w.w = cvt_pk_bf16(v[6], v[7]);
                    *(u32x4*)(mg + ro) = w; }
        }
    }
};
struct EpiT16 {
    static constexpr bool PERM = true, AFTER_DRAIN = false, HAS_MID = false;
    bf16_t* O;
    __device__ __forceinline__ void operator()(const f32x4 (&acc)[2][2][4][2], const Unit& u, int wr, int wc, int fr, int fq) const {
        const int row0 = u.pm * BM + wr * 64 + fr, col0 = u.pn * BM + wc * 32 + 8 * fq;
#pragma unroll
        for (int ai = 0; ai < 2; ++ai)
#pragma unroll
            for (int m = 0; m < 4; ++m)
#pragma unroll
                for (int bj = 0; bj < 2; ++bj) { const f32x4 v0 = acc[ai][bj][m][0], v1 = acc[ai][bj][m][1];
                    u32x4 w; w.x = cvt_pk_bf16(v0[0], v0[1]); w.y = cvt_pk_bf16(v0[2], v0[3]); w.z = cvt_pk_bf16(v1[0], v1[1]); w.w = cvt_pk_bf16(v1[2], v1[3]);
                    *(u32x4*)(O + (size_t)(row0 + ai * HALF + m * 16) * DM + col0 + bj * HALF) = w; }
    }
};
struct EpiF32 {
    static constexpr bool PERM = false, AFTER_DRAIN = false, HAS_MID = false;
    float* O; int ldc;
    __device__ __forceinline__ void operator()(const f32x4 (&acc)[2][2][4][2], const Unit& u, int wr, int wc, int fr, int fq) const {
        const int row0 = u.pm * BM + wr * 64 + fr, col0 = u.pn * BM + wc * 32 + 4 * fq;
#pragma unroll
        for (int ai = 0; ai < 2; ++ai)
#pragma unroll
            for (int m = 0; m < 4; ++m) {
                float* rp = O + (size_t)(row0 + ai * HALF + m * 16) * ldc + col0;
#pragma unroll
                for (int bj = 0; bj < 2; ++bj)
#pragma unroll
                    for (int n = 0; n < 2; ++n) *(f32x4*)(rp + bj * HALF + n * 16) = acc[ai][bj][m][n];
            }
    }
};
struct EpiSwiglu {
    static constexpr bool PERM = true, AFTER_DRAIN = false, HAS_MID = false;
    bf16_t* hid;
    __device__ __forceinline__ void operator()(const f32x4 (&acc)[2][2][4][2], const Unit& u, int wr, int wc, int fr, int fq) const {
        const int row0 = u.pm * BM + wr * 64 + fr, col0 = u.pn * HALF + wc * 32 + 8 * fq;
#pragma unroll
        for (int ai = 0; ai < 2; ++ai)
#pragma unroll
            for (int m = 0; m < 4; ++m) {
                float v[8];
#pragma unroll
                for (int j = 0; j < 4; ++j) { const float g0 = acc[ai][0][m][0][j], g1 = acc[ai][0][m][1][j];
                    v[j] = g0 / (1.f + __expf(-g0)) * acc[ai][1][m][0][j]; v[4 + j] = g1 / (1.f + __expf(-g1)) * acc[ai][1][m][1][j]; }
                u32x4 w; w.x = cvt_pk_bf16(v[0], v[1]); w.y = cvt_pk_bf16(v[2], v[3]); w.z = cvt_pk_bf16(v[4], v[5]); w.w = cvt_pk_bf16(v[6], v[7]);
                *(u32x4*)(hid + (size_t)(row0 + ai * HALF + m * 16) * DFF + col0) = w;
            }
    }
};

template <class Epi, class Sched, bool ALIGN_EPI = false, bool SP2 = false>
__device__ __forceinline__ void gemm_phase(PG8_LAS unsigned char* lds, const Gemm g, const Sched& S, const Epi& E) {
    const int tid = threadIdx.x, wid = __builtin_amdgcn_readfirstlane(tid >> 6), lane = tid & 63, wr = wid >> 2, wc = wid & 3, fr = lane & 15, fq = lane >> 4;
    const int K = g.K, nt = K / BK;
    unsigned voffA[2], voffB[2];
#pragma unroll
    for (int i = 0; i < 2; ++i) { int R, C; stage_rc(tid * 16 + i * 8192, R, C); const int Rb = Epi::PERM ? ((R & ~31) + perm32(R & 31)) : R;
        voffA[i] = (unsigned)(R * K + C) * 2u; voffB[i] = (unsigned)(Rb * K + C) * 2u; }
    const size_t kstep = (size_t)(BK * 2);
    const size_t hstep = (size_t)HALF * K * 2;
    const size_t tstep = 2 * hstep;
    const unsigned ldsw = (unsigned)wid * 1024u;
    const int aoff = lds_byte(wr * 64 + fr, fq * 8), boff = lds_byte(wc * 32 + fr, fq * 8);
#define PG8_SA(b, h) (((b) * 2 + (h)) * HTB)
#define PG8_SB(b, h) ((4 + (b) * 2 + (h)) * HTB)
#define PG8_STAGE(bufoff, gbase, voff) do { _Pragma("unroll") for (int _i = 0; _i < 2; ++_i) \
        __builtin_amdgcn_global_load_lds((const unsigned*)((const char*)(gbase) + (voff)[_i]), (PG8_LAS unsigned*)(lds + (bufoff) + ldsw + _i * 8192), 16, 0, 0); } while (0)
#define PG8_LDA(dst, b, h) do { _Pragma("unroll") for (int m = 0; m < 4; ++m) _Pragma("unroll") for (int k = 0; k < 2; ++k) dst[m][k] = *(const PG8_LAS bf16x8*)(lds + PG8_SA(b, h) + aoff + m * 2048 + k * 1024); } while (0)
#define PG8_LDB(dst, b, h) do { _Pragma("unroll") for (int n = 0; n < 2; ++n) _Pragma("unroll") for (int k = 0; k < 2; ++k) dst[n][k] = *(const PG8_LAS bf16x8*)(lds + PG8_SB(b, h) + boff + n * 2048 + k * 1024); } while (0)
#define PG8_MMA(ai, bj, At, Bt) do { __builtin_amdgcn_s_setprio(1); _Pragma("unroll") for (int m = 0; m < 4; ++m) _Pragma("unroll") for (int n = 0; n < 2; ++n) _Pragma("unroll") for (int k = 0; k < 2; ++k) \
        acc[ai][bj][m][n] = __builtin_amdgcn_mfma_f32_16x16x32_bf16(Bt[n][k], At[m][k], acc[ai][bj][m][n], 0, 0, 0); __builtin_amdgcn_s_setprio(0); } while (0)
#define PG8_WAIT_V(n) asm volatile("s_waitcnt vmcnt(" #n ")" ::: "memory")
#define PG8_WAIT_L(n) asm volatile("s_waitcnt lgkmcnt(" #n ")" ::: "memory")
#define PG8_BAR __builtin_amdgcn_s_barrier()
#define PG8_SCHED __builtin_amdgcn_sched_barrier(0)
    Unit cur, nxt; int ui = 0;
    if (!S.next(0, cur)) return;
    f32x4 acc[2][2][4][2];
#pragma unroll
    for (int a = 0; a < 2; ++a)
#pragma unroll
        for (int b = 0; b < 2; ++b)
#pragma unroll
            for (int m = 0; m < 4; ++m)
#pragma unroll
                for (int n = 0; n < 2; ++n) acc[a][b][m][n] = (f32x4){0.f, 0.f, 0.f, 0.f};
    bf16x8 At[4][2], B0[2][2], B1[2][2];
    const char* cA = (const char*)g.A + (size_t)cur.pm * tstep; const char* cB = (const char*)g.Bt + (size_t)cur.pn * tstep;
    S.a_ready(cur);
    if constexpr (SP2) {
        PG8_STAGE(PG8_SB(0, 0), cB, voffB); PG8_STAGE(PG8_SB(0, 1), cB + hstep, voffB); PG8_STAGE(PG8_SA(0, 0), cA, voffA); PG8_STAGE(PG8_SA(0, 1), cA + hstep, voffA);
        if (wr == 1) PG8_BAR;
        PG8_WAIT_V(2); PG8_BAR;
        PG8_STAGE(PG8_SB(1, 0), cB + kstep, voffB); PG8_STAGE(PG8_SA(1, 0), cA + kstep, voffA); PG8_STAGE(PG8_SB(1, 1), cB + hstep + kstep, voffB);
        PG8_WAIT_V(6); PG8_BAR;
    } else {
        PG8_STAGE(PG8_SB(0, 0), cB, voffB); PG8_STAGE(PG8_SA(0, 0), cA, voffA); PG8_STAGE(PG8_SB(0, 1), cB + hstep, voffB); PG8_STAGE(PG8_SA(0, 1), cA + hstep, voffA);
        if (wr == 1) PG8_BAR;
        PG8_WAIT_V(4); PG8_BAR;
        PG8_STAGE(PG8_SB(1, 0), cB + kstep, voffB); PG8_STAGE(PG8_SA(1, 0), cA + kstep, voffA); PG8_STAGE(PG8_SB(1, 1), cB + hstep + kstep, voffB);
        PG8_WAIT_V(6); PG8_BAR;
    }
    for (;;) {
        const bool has_next = S.next(ui + 1, nxt);
        const char* nA = has_next ? (const char*)g.A + (size_t)nxt.pm * tstep : cA; const char* nB = has_next ? (const char*)g.Bt + (size_t)nxt.pn * tstep : cB;
        for (int t = 0; t < nt; t += 2) {
            if constexpr (Epi::HAS_MID) { if (t == (nt >> 1)) E.mid(acc, cur, wr, wc, fr, fq); }
            const bool last = (t == nt - 2);
            const char* a1 = cA + (size_t)(t + 1) * kstep;
            const char* a2 = last ? nA : cA + (size_t)(t + 2) * kstep; const char* b2 = last ? nB : cB + (size_t)(t + 2) * kstep;
            const char* a3 = a2 + kstep; const char* b3 = b2 + kstep;
            if (last && has_next) S.a_ready(nxt);
            if constexpr (SP2) {
            PG8_LDB(B0, 0, 0); PG8_LDB(B1, 0, 1); PG8_SCHED; PG8_LDA(At, 0, 0); PG8_STAGE(PG8_SA(1, 1), a1 + hstep, voffA);
            PG8_WAIT_V(8); PG8_WAIT_L(0); PG8_BAR; PG8_MMA(0, 0, At, B0); PG8_MMA(0, 1, At, B1); PG8_BAR; PG8_SCHED;
            PG8_LDA(At, 0, 1); PG8_STAGE(PG8_SB(0, 0), b2, voffB); PG8_STAGE(PG8_SB(0, 1), b2 + hstep, voffB); PG8_STAGE(PG8_SA(0, 0), a2, voffA);
            PG8_WAIT_V(8); PG8_WAIT_L(0); PG8_BAR; PG8_MMA(1, 0, At, B0); PG8_MMA(1, 1, At, B1); PG8_BAR; PG8_SCHED;
            PG8_LDB(B0, 1, 0); PG8_LDB(B1, 1, 1); PG8_SCHED; PG8_LDA(At, 1, 0); PG8_STAGE(PG8_SA(0, 1), a2 + hstep, voffA);
            PG8_WAIT_V(8); PG8_WAIT_L(0); PG8_BAR; PG8_MMA(0, 0, At, B0); PG8_MMA(0, 1, At, B1); PG8_BAR; PG8_SCHED;
            PG8_LDA(At, 1, 1); PG8_STAGE(PG8_SB(1, 0), b3, voffB); PG8_STAGE(PG8_SB(1, 1), b3 + hstep, voffB); PG8_STAGE(PG8_SA(1, 0), a3, voffA);
            PG8_WAIT_V(8); PG8_WAIT_L(0); PG8_BAR; PG8_MMA(1, 0, At, B0); PG8_MMA(1, 1, At, B1); PG8_BAR; PG8_SCHED;
            } else {
            PG8_LDB(B0, 0, 0); PG8_SCHED; PG8_LDA(At, 0, 0); PG8_STAGE(PG8_SA(1, 1), a1 + hstep, voffA);
            PG8_WAIT_L(8); PG8_BAR; PG8_WAIT_L(0); PG8_MMA(0, 0, At, B0); PG8_BAR; PG8_SCHED;
            PG8_LDB(B1, 0, 1); PG8_STAGE(PG8_SB(0, 0), b2, voffB);
            PG8_BAR; PG8_WAIT_L(0); PG8_MMA(0, 1, At, B1); PG8_BAR;
            PG8_LDA(At, 0, 1); PG8_STAGE(PG8_SA(0, 0), a2, voffA);
            PG8_BAR; PG8_WAIT_L(0); PG8_MMA(1, 0, At, B0); PG8_BAR; PG8_SCHED;
            PG8_STAGE(PG8_SB(0, 1), b2 + hstep, voffB);
            PG8_WAIT_V(6); PG8_BAR; PG8_MMA(1, 1, At, B1); PG8_BAR;
            PG8_LDB(B0, 1, 0); PG8_SCHED; PG8_LDA(At, 1, 0); PG8_STAGE(PG8_SA(0, 1), a2 + hstep, voffA);
            PG8_WAIT_L(8); PG8_BAR; PG8_WAIT_L(0); PG8_MMA(0, 0, At, B0); PG8_BAR; PG8_SCHED;
            PG8_LDB(B1, 1, 1); PG8_STAGE(PG8_SB(1, 0), b3, voffB);
            PG8_BAR; PG8_WAIT_L(0); PG8_MMA(0, 1, At, B1); PG8_BAR;
            PG8_LDA(At, 1, 1); PG8_STAGE(PG8_SA(1, 0), a3, voffA);
            PG8_BAR; PG8_WAIT_L(0); PG8_MMA(1, 0, At, B0); PG8_BAR; PG8_SCHED;
            PG8_STAGE(PG8_SB(1, 1), b3 + hstep, voffB);
            PG8_WAIT_V(6); PG8_BAR; PG8_MMA(1, 1, At, B1); PG8_BAR;
            }
        }
        if constexpr (ALIGN_EPI) { if (wr == 0) PG8_BAR; }
        if constexpr (!Epi::AFTER_DRAIN) { E(acc, cur, wr, wc, fr, fq); S.done(cur); }
        if (!has_next) break;
#pragma unroll
        for (int a = 0; a < 2; ++a)
#pragma unroll
            for (int b = 0; b < 2; ++b)
#pragma unroll
                for (int m = 0; m < 4; ++m)
#pragma unroll
                    for (int n = 0; n < 2; ++n) acc[a][b][m][n] = (f32x4){0.f, 0.f, 0.f, 0.f};
        cur = nxt; cA = nA; cB = nB; ++ui;
        if constexpr (ALIGN_EPI) { if (wr == 1) PG8_BAR; }
    }
    PG8_WAIT_V(0);
    if constexpr (!ALIGN_EPI) { if (wr == 0) PG8_BAR; }
    PG8_BAR;
    if constexpr (Epi::AFTER_DRAIN) { E.fused(acc, cur, wr, wc, fr, fq, lds, wid, lane); S.done(cur); }
#undef PG8_SA
#undef PG8_SB
#undef PG8_STAGE
#undef PG8_LDA
#undef PG8_LDB
#undef PG8_MMA
#undef PG8_WAIT_V
#undef PG8_WAIT_L
#undef PG8_BAR
#undef PG8_SCHED
}
}

#include <hip/hip_bf16.h>
namespace fox {
constexpr int D = 128, PITCH = 1024, OPITCH = 2048;
constexpr float THR2 = 11.5f, LOG2E_ = 1.4426950408889634f;
constexpr bool WSKIP = false;
constexpr int NW = 8, QBLK = 32, KVBLK = 64, QB = NW * QBLK;
constexpr int SHM_V = KVBLK * D * 2, SHM_K = KVBLK * D * 2;
constexpr int LDS_BYTES = 2 * SHM_V + 2 * SHM_K + NW * 64 * 4;

using bf16 = __hip_bfloat16;
typedef short bf16x8 __attribute__((ext_vector_type(8)));
typedef short s16x4 __attribute__((ext_vector_type(4)));
typedef float f32x16 __attribute__((ext_vector_type(16)));
typedef float f32x4 __attribute__((ext_vector_type(4)));
typedef unsigned u32x4 __attribute__((ext_vector_type(4)));
template <class A, class Bt> struct same_t { static constexpr bool v = false; };
template <class A> struct same_t<A, A> { static constexpr bool v = true; };

#define KSWZ(row, colB) ((row) * 256 + ((colB) ^ (((row) & 7) << 4)))
#define SBAR() __builtin_amdgcn_sched_barrier(0)
__device__ __forceinline__ int v_st(int k, int c) { const int kk = (k & ~0xC) | ((k & 4) << 1) | ((k & 8) >> 1); return ((kk >> 3) * 4 + (c >> 5)) * 512 + ((kk & 7) * 32 + (c & 31)) * 2; }
__device__ __forceinline__ int v_rd_base(int lane) { return ((lane & 3) << 3) | (((lane >> 2) & 3) << 6) | (((lane >> 4) & 1) << 5) | (((lane >> 5) & 1) << 8); }
constexpr int v_rd_off(int d0, int ks, int half) { return d0 * 512 + ks * 4096 + half * 2048; }
__device__ __forceinline__ int crow(int r, int hi) { return (r & 3) + 8 * (r >> 2) + 4 * hi; }
__device__ __forceinline__ unsigned cvtpk(float lo, float hi) {
    unsigned r; asm volatile("v_cvt_pk_bf16_f32 %0, %1, %2" : "=v"(r) : "v"(lo), "v"(hi)); return r;
}
__device__ __forceinline__ bf16x8 pack8(f32x4 a, f32x4 b) {
    u32x4 w = {cvtpk(a[0], a[1]), cvtpk(a[2], a[3]), cvtpk(b[0], b[1]), cvtpk(b[2], b[3])};
    return *reinterpret_cast<bf16x8*>(&w);
}
template <class T> __device__ __forceinline__ bf16x8 load8(const T* p) {
    if constexpr (same_t<T, float>::v) { return pack8(*(const f32x4*)p, *(const f32x4*)(p + 4)); }
    else { return *reinterpret_cast<const bf16x8*>(p); }
}
__device__ __forceinline__ void mask_tile(f32x16& p0, f32x16& p1, int dq, unsigned W) {
    const float NEG = -__builtin_inff();
#pragma unroll
    for (int r = 0; r < 16; ++r) {
        const int c = (r & 3) + 8 * (r >> 2);
        if ((unsigned)(dq - c) >= W) p0[r] = NEG;
        if ((unsigned)(dq - c - 32) >= W) p1[r] = NEG;
    }
}
__device__ __forceinline__ void partialSM(f32x16& p0, f32x16& p1, float& m_reg, float& mn, float& alpha, const __attribute__((address_space(3))) float* cbt) {
    SBAR();
#pragma unroll
    for (int g = 0; g < 4; ++g) { const f32x4 b0 = *(const __attribute__((address_space(3))) f32x4*)(cbt + 8 * g), b1 = *(const __attribute__((address_space(3))) f32x4*)(cbt + 32 + 8 * g);
        p0[4 * g] += b0[0]; p0[4 * g + 1] += b0[1]; p0[4 * g + 2] += b0[2]; p0[4 * g + 3] += b0[3];
        p1[4 * g] += b1[0]; p1[4 * g + 1] += b1[1]; p1[4 * g + 2] += b1[2]; p1[4 * g + 3] += b1[3]; }
    float pmax = p0[0]; for (int r = 1; r < 16; ++r) pmax = fmaxf(pmax, p0[r]); for (int r = 0; r < 16; ++r) pmax = fmaxf(pmax, p1[r]);
    { auto rr = __builtin_amdgcn_permlane32_swap(__float_as_uint(pmax), __float_as_uint(pmax), false, false);
      pmax = fmaxf(__uint_as_float(rr[0]), __uint_as_float(rr[1])); }
    if (__builtin_expect(__all((pmax - m_reg) <= THR2), 1)) { mn = m_reg; alpha = 1.f; }
    else { mn = fmaxf(m_reg, pmax); alpha = __builtin_amdgcn_exp2f(m_reg - mn); m_reg = mn; }
    for (int r = 0; r < 16; ++r) p0[r] = p0[r] - mn; for (int r = 0; r < 16; ++r) p1[r] = p1[r] - mn;
    for (int r = 0; r < 16; ++r) p0[r] = __builtin_amdgcn_exp2f(p0[r]);
}
__device__ __forceinline__ void finishSM(f32x16& p0, f32x16& p1, float alpha, float& l_reg, bf16x8& pa0, bf16x8& pa1, bf16x8& pa2, bf16x8& pa3) {
    for (int r = 0; r < 16; ++r) p1[r] = __builtin_amdgcn_exp2f(p1[r]);
    float ps = 0; for (int r = 0; r < 16; ++r) ps += p0[r]; for (int r = 0; r < 16; ++r) ps += p1[r];
    { auto rr = __builtin_amdgcn_permlane32_swap(__float_as_uint(ps), __float_as_uint(ps), false, false);
      ps = __uint_as_float(rr[0]) + __uint_as_float(rr[1]); }
    l_reg = l_reg * alpha + ps;
#define PK4(P, B_, OUT) do { unsigned a0 = cvtpk(P[B_+0], P[B_+1]), a1 = cvtpk(P[B_+2], P[B_+3]);                          \
        unsigned b0 = cvtpk(P[B_+4], P[B_+5]), b1 = cvtpk(P[B_+6], P[B_+7]);                                             \
        auto r0 = __builtin_amdgcn_permlane32_swap(a0, b0, false, false); auto r1 = __builtin_amdgcn_permlane32_swap(a1, b1, false, false); \
        u32x4 w = {r0[0], r1[0], r0[1], r1[1]}; OUT = *reinterpret_cast<bf16x8*>(&w); } while (0)
    PK4(p0, 0, pa0); PK4(p0, 8, pa1); PK4(p1, 0, pa2); PK4(p1, 8, pa3);
#undef PK4
}
template <int KB, bool SK>
__device__ __forceinline__ void qkt(f32x16& p0, f32x16& p1, const char* K_lds, int r32, int hi, const bf16x8* qr, bool act) {
    if (SK && !act) { const float NEG = -__builtin_inff();
#pragma unroll
        for (int r = 0; r < 16; ++r) { p0[r] = NEG; p1[r] = NEG; } return; }
    p0 = f32x16{}; p1 = f32x16{};
    const char* kb[4];
#pragma unroll
    for (int dd = 0; dd < 4; ++dd) kb[dd] = K_lds + KB * SHM_K + KSWZ(r32, (dd * 16 + hi * 8) * 2);
#pragma unroll
    for (int d0 = 0; d0 < 8; ++d0) { const char* a = kb[d0 & 3] + (d0 >> 2) * 128;
        bf16x8 b0 = *reinterpret_cast<const bf16x8*>(a);
        bf16x8 b1 = *reinterpret_cast<const bf16x8*>(a + 32 * 256);
        p0 = __builtin_amdgcn_mfma_f32_32x32x16_bf16(b0, qr[d0], p0, 0, 0, 0);
        p1 = __builtin_amdgcn_mfma_f32_32x32x16_bf16(b1, qr[d0], p1, 0, 0, 0); }
}
template <int VB, bool SK>
__device__ __forceinline__ void pv_tile(f32x16* o, int vb0, bf16x8 pa0, bf16x8 pa1, bf16x8 pa2, bf16x8 pa3, bool act) {
    if (SK && !act) return;
#define TRRD(dst, off) asm volatile("ds_read_b64_tr_b16 %0, %1 offset:%2" : "=&v"(dst) : "v"(vb0), "i"(off) : "memory")
#define PV_D0(d0) do { s16x4 l0, l1, l2, l3, h0, h1, h2, h3; constexpr int b_ = VB * SHM_V + v_rd_off(d0, 0, 0);     \
        TRRD(l0, b_); TRRD(h0, b_ + 2048); TRRD(l1, b_ + 4096); TRRD(h1, b_ + 6144); TRRD(l2, b_ + 8192); TRRD(h2, b_ + 10240); TRRD(l3, b_ + 12288); TRRD(h3, b_ + 14336); \
        asm volatile("s_waitcnt lgkmcnt(0)" ::: "memory"); SBAR();                 \
        o[d0] = __builtin_amdgcn_mfma_f32_32x32x16_bf16(pa0, (bf16x8){l0[0], l0[1], l0[2], l0[3], h0[0], h0[1], h0[2], h0[3]}, o[d0], 0, 0, 0);   \
        o[d0] = __builtin_amdgcn_mfma_f32_32x32x16_bf16(pa1, (bf16x8){l1[0], l1[1], l1[2], l1[3], h1[0], h1[1], h1[2], h1[3]}, o[d0], 0, 0, 0);   \
        o[d0] = __builtin_amdgcn_mfma_f32_32x32x16_bf16(pa2, (bf16x8){l2[0], l2[1], l2[2], l2[3], h2[0], h2[1], h2[2], h2[3]}, o[d0], 0, 0, 0);   \
        o[d0] = __builtin_amdgcn_mfma_f32_32x32x16_bf16(pa3, (bf16x8){l3[0], l3[1], l3[2], l3[3], h3[0], h3[1], h3[2], h3[3]}, o[d0], 0, 0, 0); } while (0)
    PV_D0(0); PV_D0(1); PV_D0(2); PV_D0(3);
#undef PV_D0
#undef TRRD
}

template <class TIn, class TOut> struct BlockRef { const TIn* Q; const TIn* K; const TIn* V; TOut* O; const float* C; int P0; int JLO; };
template <class TIn> struct Seam {
    bf16x8 qr[8];
    bf16x8 st_v0, st_v1, st_k0, st_k1; f32x4 sf0, sf1, sf2, sf3;
    f32x4 tq[16];
};
__device__ __forceinline__ int swa_jlo(int P0, int W) { const int lowk = P0 - W + 1; return lowk > 0 ? lowk / KVBLK : 0; }
#define ROW(p, k0, rr) ((p) + (size_t)((k0) + (rr)) * PITCH + sc)
#define VMW() asm volatile("s_waitcnt vmcnt(0)" ::: "memory")
#define VMWN(n) asm volatile("s_waitcnt vmcnt(%0)" :: "i"(n) : "memory")
#define SLOAD_H(Kp, Vp, k0) do { S.st_v0 = load8<TIn>(ROW(Vp, k0, sr)); S.st_v1 = load8<TIn>(ROW(Vp, k0, 32 + sr));              \
                         S.st_k0 = load8<TIn>(ROW(Kp, k0, sr)); S.st_k1 = load8<TIn>(ROW(Kp, k0, 32 + sr)); } while (0)
#define SWRITE_HK(bf) do { *(bf16x8*)(K_lds + (bf) * SHM_K + kws) = S.st_k0; *(bf16x8*)(K_lds + (bf) * SHM_K + kws + 32 * 256) = S.st_k1; } while (0)
#define SWRITE_HV(bf) do { *(bf16x8*)(V_lds + (bf) * SHM_V + vst0) = S.st_v0; *(bf16x8*)(V_lds + (bf) * SHM_V + vst1) = S.st_v1; } while (0)
#define SWRITE_H(bf) do { SWRITE_HV(bf); SWRITE_HK(bf); } while (0)
#define SLOAD_F(p, k0) do { S.sf0 = *(const f32x4*)ROW(p, k0, sr); S.sf1 = *(const f32x4*)(ROW(p, k0, sr) + 4);                \
                            S.sf2 = *(const f32x4*)ROW(p, k0, 32 + sr); S.sf3 = *(const f32x4*)(ROW(p, k0, 32 + sr) + 4); } while (0)
#define SWRITE_KF(bf) do { *(bf16x8*)(K_lds + (bf) * SHM_K + kws) = pack8(S.sf0, S.sf1); *(bf16x8*)(K_lds + (bf) * SHM_K + kws + 32 * 256) = pack8(S.sf2, S.sf3); } while (0)
#define SWRITE_VF(bf) do { *(bf16x8*)(V_lds + (bf) * SHM_V + vst0) = pack8(S.sf0, S.sf1); *(bf16x8*)(V_lds + (bf) * SHM_V + vst1) = pack8(S.sf2, S.sf3); } while (0)
template <class TIn, class TOut>
__device__ __forceinline__ void causal_swa_prime(const BlockRef<TIn, TOut>& cur, int W, char* lds, Seam<TIn>& S) {
    constexpr bool F32 = same_t<TIn, float>::v;
    const int tid = threadIdx.x, wid = __builtin_amdgcn_readfirstlane(tid >> 6), lane = tid & 63, r32 = lane & 31, hi = lane >> 5;
    const int sr = tid >> 4, sc = (tid & 15) * 8, kws = KSWZ(sr, sc * 2); char* K_lds = lds + 2 * SHM_V;
    const int kb0 = cur.JLO * KVBLK;
    for (int d0 = 0; d0 < 8; ++d0) S.qr[d0] = load8<TIn>(cur.Q + (size_t)(wid * QBLK + r32) * PITCH + d0 * 16 + hi * 8);
    if constexpr (F32) { SLOAD_F((const float*)cur.K, kb0); VMW(); SWRITE_KF(0); SBAR(); SLOAD_F((const float*)cur.V, kb0); }
    else { SLOAD_H(cur.K, cur.V, kb0); VMW(); SWRITE_HK(0); }
    __syncthreads();
}
template <class TIn, class TOut>
__device__ __forceinline__ void causal_swa_block(const BlockRef<TIn, TOut>& cur, const BlockRef<TIn, TOut>& nxt, int skv, int W, char* lds, Seam<TIn>& S) {
    constexpr bool F32 = same_t<TIn, float>::v;
    const int tid = threadIdx.x, wid = __builtin_amdgcn_readfirstlane(tid >> 6), lane = tid & 63, r32 = lane & 31, hi = lane >> 5;
    const int j_lo = cur.JLO;
    int j_hi = (cur.P0 + QB - 1) / KVBLK + 1; if (j_hi > skv / KVBLK) j_hi = skv / KVBLK;
    const int NT = j_hi - j_lo;
    const int kbn = nxt.JLO * KVBLK;
    const int qlo = cur.P0 + wid * QBLK, qm = qlo + r32 - 4 * hi;
    char* V_lds = lds; char* K_lds = lds + 2 * SHM_V;
    float* ws = (float*)(lds + 2 * SHM_V + 2 * SHM_K) + wid * 64; float* li_l = ws, * al_l = ws + 32;
    __attribute__((address_space(3))) float* cb = (__attribute__((address_space(3))) float*)(lds + LDS_BYTES);
    { const float cref = cur.C[cur.P0]; const int nk = j_hi * KVBLK; int tq = tid * 4; asm volatile("" : "+v"(tq));
      for (int k = j_lo * KVBLK + tq; k < nk; k += 2048) { const f32x4 c4 = *(const f32x4*)(cur.C + k); *(__attribute__((address_space(3))) f32x4*)(cb + k) = (f32x4){(cref - c4[0]) * LOG2E_, (cref - c4[1]) * LOG2E_, (cref - c4[2]) * LOG2E_, (cref - c4[3]) * LOG2E_}; } }
    __syncthreads();
    const __attribute__((address_space(3))) float* cbh = cb + 4 * hi;
    float m_reg = -1e30f, l_reg = 0; f32x16 o[4] = {};
    const int sr = tid >> 4, sc = (tid & 15) * 8, vst0 = v_st(sr, sc), vst1 = v_st(32 + sr, sc), kws = KSWZ(sr, sc * 2);
    const int vb0 = (int)(uintptr_t)V_lds + v_rd_base(lane);
    const TIn* Kh = cur.K; const TIn* Vh = cur.V;
#define RESC(a) do { if (__any((a) < 1.f)) { if (hi == 0) al_l[r32] = (a); asm volatile("s_waitcnt lgkmcnt(0)" ::: "memory");              \
                     for (int d_ = 0; d_ < 4; ++d_) for (int r = 0; r < 16; ++r) o[d_][r] *= al_l[crow(r, hi)]; } } while (0)
#define KBASE(t) ((j_lo + (t)) * KVBLK)
#define ACT(t) (KBASE(t) <= qlo + QBLK - 1 && KBASE(t) + KVBLK - 1 >= qlo - W + 1)
#define MASKT(P0_, P1_, t) do { const int kb_ = KBASE(t); if ((!SK || ACT(t)) && (kb_ + KVBLK - 1 > qlo || kb_ <= qlo + QBLK - 1 - W)) mask_tile(P0_, P1_, qm - kb_, (unsigned)W); } while (0)
    constexpr int NQL = F32 ? 16 : 8;
    constexpr bool SK = WSKIP && !F32;
#define SEAM_K0() do { VMWN(NQL); if constexpr (F32) { SWRITE_KF(0); SBAR(); SLOAD_F((const float*)nxt.V, kbn); } else { SWRITE_HK(0); } SBAR(); } while (0)
    f32x16 pA0, pA1, pB0, pB1; float mnA, mnB, alA, alB; bf16x8 pa0, pa1, pa2, pa3;
    if constexpr (F32) { VMW(); SWRITE_VF(0); SBAR(); } else { SWRITE_HV(0); SBAR(); }
    if (NT > 1) { if constexpr (F32) SLOAD_F((const float*)Kh, KBASE(1)); else SLOAD_H(Kh, Vh, KBASE(1)); }
    SBAR(); qkt<0, SK>(pA0, pA1, K_lds, r32, hi, S.qr, ACT(0));
    if constexpr (F32) { if (NT > 1) { VMW(); SWRITE_KF(1); SBAR(); SLOAD_F((const float*)Vh, KBASE(1)); } }
    MASKT(pA0, pA1, 0); partialSM(pA0, pA1, m_reg, mnA, alA, cbh + KBASE(0));
    if (NT > 1) { VMW(); if constexpr (F32) { SWRITE_VF(1); SBAR(); if (NT > 2) SLOAD_F((const float*)Kh, KBASE(2)); } else SWRITE_H(1); }
    __syncthreads();
#define HALF_STEP(PX0, PX1, mnX, alX, PY0, PY1, alY, t, KB, VB, SB) do {                                                      \
        SBAR(); qkt<KB, SK>(PX0, PX1, K_lds, r32, hi, S.qr, ACT(t));                                             \
        finishSM(PY0, PY1, alY, l_reg, pa0, pa1, pa2, pa3); SBAR();                                                           \
        if ((t) + 1 < NT) { if constexpr (F32) { VMW(); SWRITE_KF(SB); SBAR(); SLOAD_F((const float*)Vh, KBASE((t) + 1)); }  \
                            else { SLOAD_H(Kh, Vh, KBASE((t) + 1)); } SBAR(); }                                               \
        pv_tile<VB, SK>(o, vb0, pa0, pa1, pa2, pa3, ACT((t) - 1)); MASKT(PX0, PX1, (t)); partialSM(PX0, PX1, m_reg, mnX, alX, cbh + KBASE(t));                                        \
        __syncthreads();                                                                                                      \
        if ((t) + 1 < NT) { VMW(); if constexpr (F32) { SWRITE_VF(SB); SBAR(); if ((t) + 2 < NT) SLOAD_F((const float*)Kh, KBASE((t) + 2)); } \
                            else { SWRITE_H(SB); } }                                                                          \
        RESC(alX); __syncthreads(); } while (0)
    for (int t = 1; t + 1 < NT; t += 2) {
        HALF_STEP(pB0, pB1, mnB, alB, pA0, pA1, alA, t, 1, 0, 0);
        HALF_STEP(pA0, pA1, mnA, alA, pB0, pB1, alB, t + 1, 0, 1, 1);
    }
    const bool even = (NT & 1) == 0;
    if (even) { SBAR(); qkt<1, SK>(pB0, pB1, K_lds, r32, hi, S.qr, ACT(NT - 1)); SBAR(); }
#define QROW(e) (nxt.Q + (size_t)(wid * QBLK + r32) * PITCH + ((e) >> 1) * 16 + hi * 8 + ((e) & 1) * 4)
    if constexpr (F32) { SLOAD_F((const float*)nxt.K, kbn); SBAR();
#pragma unroll
        for (int e = 0; e < 8; ++e) S.tq[e] = *(const f32x4*)QROW(e); }
    else { SLOAD_H(nxt.K, nxt.V, kbn); SBAR();
#pragma unroll
        for (int d0 = 0; d0 < 8; ++d0) S.qr[d0] = load8<TIn>(nxt.Q + (size_t)(wid * QBLK + r32) * PITCH + d0 * 16 + hi * 8); }
    SBAR();
    finishSM(pA0, pA1, alA, l_reg, pa0, pa1, pa2, pa3); SBAR();
    if constexpr (F32) {
#pragma unroll
        for (int e = 8; e < 16; ++e) S.tq[e] = *(const f32x4*)QROW(e); SBAR(); }
#undef QROW
    pv_tile<0, SK>(o, vb0, pa0, pa1, pa2, pa3, ACT(even ? NT - 2 : NT - 1));
    if (even) { MASKT(pB0, pB1, NT - 1); partialSM(pB0, pB1, m_reg, mnB, alB, cbh + KBASE(NT - 1)); __syncthreads(); RESC(alB);
        finishSM(pB0, pB1, alB, l_reg, pa0, pa1, pa2, pa3); SBAR(); pv_tile<1, SK>(o, vb0, pa0, pa1, pa2, pa3, ACT(NT - 1)); }
    SBAR(); SEAM_K0();
    if (hi == 0) li_l[r32] = l_reg; asm volatile("s_waitcnt lgkmcnt(0)" ::: "memory");
    float rli[16];
#pragma unroll
    for (int r = 0; r < 16; ++r) rli[r] = __builtin_amdgcn_rcpf(li_l[crow(r, hi)]);
    TOut* Ow = cur.O + (size_t)(wid * QBLK) * OPITCH;
#pragma unroll
    for (int r = 0; r < 16; ++r) { const int orow = crow(r, hi);
#pragma unroll
        for (int d0 = 0; d0 < 4; ++d0) { const float v = o[d0][r] * rli[r];
            if constexpr (same_t<TOut, float>::v) { Ow[(size_t)orow * OPITCH + d0 * 32 + r32] = v; }
            else { const float vn = __shfl_xor(v, 1);
                   if ((r32 & 1) == 0) *(unsigned*)(Ow + (size_t)orow * OPITCH + d0 * 32 + r32) = cvtpk(v, vn); } } }
    if constexpr (F32) {
#pragma unroll
        for (int d0 = 0; d0 < 8; ++d0) S.qr[d0] = pack8(S.tq[2 * d0], S.tq[2 * d0 + 1]); }
    __syncthreads();
#undef RESC
#undef KBASE
#undef ACT
#undef MASKT
#undef SEAM_K0
#undef HALF_STEP
}
#undef ROW
#undef VMW
#undef VMWN
#undef SLOAD_H
#undef SWRITE_HK
#undef SWRITE_HV
#undef SWRITE_H
#undef SLOAD_F
#undef SWRITE_KF
#undef SWRITE_VF

constexpr int FOX_LDS_BYTES = LDS_BYTES + 8192 * 4;
struct AttnT { const bf16* BQ; const bf16* BK; const bf16* BV; bf16* OB; const float* CUM; const unsigned* KMAX; };
__device__ __forceinline__ BlockRef<bf16, bf16> fox_ref(const AttnT& T, int L_, int pass, int jlo) {
    constexpr int NQB = 8192 / QB;
    const int h = L_ % 8, qb = NQB - 1 - L_ / 8; BlockRef<bf16, bf16> r; (void)pass;
    r.Q = T.BQ + (size_t)qb * QB * PITCH + h * D; r.O = T.OB + (size_t)qb * QB * OPITCH + h * D; r.K = T.BK + h * D; r.V = T.BV + h * D; r.C = T.CUM + (size_t)h * 8192; r.P0 = qb * QB; r.JLO = jlo; return r;
}
constexpr float PRUNE_T2 = 40.f;
__device__ __forceinline__ int fox_jlo(const AttnT& T, int L_, int pass, char* lds) {
    constexpr int NQB = 8192 / QB;
    int tid = threadIdx.x; asm volatile("" : "+v"(tid));
    const int lane = tid & 63, wid = tid >> 6; (void)pass;
    const int h = L_ % 8, qb = NQB - 1 - L_ / 8, P0 = qb * QB;
    float* red = (float*)(lds + LDS_BYTES + 8192 * 4);
    { const bf16* qp = T.BQ + (size_t)(P0 + (tid >> 1)) * PITCH + h * D + (tid & 1) * 64; float s = 0.f;
#pragma unroll
      for (int i = 0; i < 8; ++i) { const u32x4 v = *(const u32x4*)(qp + 8 * i);
#pragma unroll
          for (int j = 0; j < 4; ++j) s += fabsf(__uint_as_float(v[j] << 16)) + fabsf(__uint_as_float(v[j] & 0xffff0000u)); }
      s += __shfl_xor(s, 1);
#pragma unroll
      for (int o = 2; o < 64; o <<= 1) s = fmaxf(s, __shfl_xor(s, o));
      if (lane == 0) red[wid] = s; }
    __syncthreads();
    float q1 = red[0];
#pragma unroll
    for (int i = 1; i < 8; ++i) q1 = fmaxf(q1, red[i]);
    const float B2 = q1 * __uint_as_float(T.KMAX[h]) * 1.01f;
    const float* C = T.CUM + (size_t)h * 8192; const float cref = C[P0];
    const int ntb = P0 / KVBLK;
    bool skip = false;
    if (tid < ntb) skip = (cref - C[tid * KVBLK + KVBLK - 1]) * LOG2E_ + 2.f * B2 < -PRUNE_T2;
    const int cnt = __popcll(__ballot(skip));
    __syncthreads();
    if (lane == 0) red[wid] = (float)cnt;
    __syncthreads();
    int jlo = 0;
#pragma unroll
    for (int i = 0; i < 8; ++i) jlo += (int)red[i];
    __syncthreads();
    return __builtin_amdgcn_readfirstlane(jlo);
}
__device__ __forceinline__ void attn_phase(char* lds, const AttnT T, int first, int stride) {
    constexpr int NQB = 8192 / QB, TOTAL = NQB * 8;
    int SKV_ = 8192, W = 8192; asm volatile("" : "+s"(SKV_), "+s"(W));
    int L = first; if (L >= TOTAL) return;
    int pass = 0;
    BlockRef<bf16, bf16> cur = fox_ref(T, L, 0, fox_jlo(T, L, 0, lds));
    Seam<bf16> Sm;
    causal_swa_prime<bf16, bf16>(cur, W, lds, Sm);
    for (;;) {
        const bool more_pass = false, more_item = L + stride < TOTAL, last = !more_pass && !more_item;
        int passn = pass + 1, Ln = L;
        if (!more_pass) { passn = 0; Ln = more_item ? L + stride : L; }
        BlockRef<bf16, bf16> nxt = cur;
        if (!last) { const int jn = fox_jlo(T, Ln, passn, lds); nxt = fox_ref(T, Ln, passn, jn); }
        causal_swa_block<bf16, bf16>(cur, nxt, SKV_, W, lds, Sm);
        if (last) break;
        cur = nxt; pass = passn; L = Ln;
    }
}
#undef KSWZ
#undef SBAR
}

namespace hg {
typedef short bf16x8 __attribute__((ext_vector_type(8)));
typedef float f32x4 __attribute__((ext_vector_type(4)));
typedef unsigned u32x4 __attribute__((ext_vector_type(4)));
typedef unsigned short bf16;
#define HLAS __attribute__((address_space(3)))
constexpr int PQ = 136, PS = 72;
constexpr int L_B = 0;
constexpr int L_QT = 34816;
constexpr int L_Q0 = L_QT + 17408;
constexpr int L_KT = L_Q0 + 17408;
constexpr int L_VT = L_KT + 43520;
constexpr int L_P = L_VT + 18432;
constexpr int L_RED = L_P + 9216;
constexpr int L_END = L_RED + 512 + 2048;
static_assert(L_END <= 147328, "hgrn LDS map");
__device__ __forceinline__ float bfl(unsigned w) { return __uint_as_float(w << 16); }
__device__ __forceinline__ float bfh(unsigned w) { return __uint_as_float(w & 0xffff0000u); }
__device__ __forceinline__ unsigned pkbf(float lo, float hi) { return pg8::cvt_pk_bf16(lo, hi); }
struct T { const bf16 *AQ, *AK, *AI, *AG; const float* ALF; bf16* LT; float* DV; bf16* OA; const float* nw; };

__device__ __forceinline__ void load_b_issue(const float* ALF, int t0, int hcol, int tid, float (&loc)[16]) {
    const int k = tid & 127, seg = tid >> 7;
    const float* p = ALF + (size_t)(t0 + 16 * seg) * 1024 + hcol + k;
#pragma unroll
    for (int i = 0; i < 16; ++i) loc[i] = p[(size_t)i * 1024];
}
__device__ __forceinline__ void load_b_finish(HLAS unsigned char* lds, int tid, float (&loc)[16]) {
    HLAS float* B = (HLAS float*)(lds + L_B); HLAS float* tot = (HLAS float*)(lds + L_RED + 512);
    const int k = tid & 127, seg = tid >> 7;
    float run = 0.f;
#pragma unroll
    for (int i = 0; i < 16; ++i) { run += loc[i]; loc[i] = run; }
    tot[seg * 128 + k] = run;
    __syncthreads();
    float pre = 0.f;
#pragma unroll
    for (int s2 = 0; s2 < 3; ++s2) { const float v = tot[s2 * 128 + k]; pre += (s2 < seg) ? v : 0.f; }
#pragma unroll
    for (int i = 0; i < 16; ++i) B[(16 * seg + i) * 128 + k] = pre + loc[i];
    __syncthreads();
}
__device__ __forceinline__ void store_vt(HLAS unsigned char* lds, int tid, const u32x4 (&vv)[2]) {
    HLAS bf16* VT = (HLAS bf16*)(lds + L_VT);
#pragma unroll
    for (int it = 0; it < 2; ++it) { const int item = tid + 512 * it, s = item >> 4, k8 = (item & 15) * 8;
        const int sx = s ^ (((k8 >> 3) & 7) << 3);
#pragma unroll
        for (int j = 0; j < 4; ++j) { VT[(k8 + 2 * j) * PS + sx] = (bf16)(vv[it][j] & 0xffffu); VT[(k8 + 2 * j + 1) * PS + sx] = (bf16)(vv[it][j] >> 16); } }
}
__device__ __forceinline__ void passA_unit(HLAS unsigned char* lds, const T& P, int c, int h) {
    const int tid = threadIdx.x, lane = tid & 63, w = __builtin_amdgcn_readfirstlane(tid >> 6), t0 = c * 64, hcol = h * 128;
    float loc[16]; u32x4 kkv[2], vv[2];
    load_b_issue(P.ALF, t0, hcol, tid, loc);
#pragma unroll
    for (int it = 0; it < 2; ++it) { const int item = tid + 512 * it, s = item >> 4, k8 = (item & 15) * 8;
        kkv[it] = *(const u32x4*)(P.AK + (size_t)(t0 + s) * 1024 + hcol + k8); vv[it] = *(const u32x4*)(P.AI + (size_t)(t0 + s) * 1024 + hcol + k8); }
    load_b_finish(lds, tid, loc);
    HLAS float* B = (HLAS float*)(lds + L_B); HLAS bf16* KdT = (HLAS bf16*)(lds + L_KT); HLAS bf16* VT = (HLAS bf16*)(lds + L_VT);
#pragma unroll
    for (int it = 0; it < 2; ++it) { const int item = tid + 512 * it, s = item >> 4, k8 = (item & 15) * 8;
        const u32x4 kk = kkv[it];
        const f32x4 l0 = *(const HLAS f32x4*)(B + 63 * 128 + k8), l1 = *(const HLAS f32x4*)(B + 63 * 128 + k8 + 4);
        const f32x4 s0 = *(const HLAS f32x4*)(B + s * 128 + k8), s1 = *(const HLAS f32x4*)(B + s * 128 + k8 + 4);
        float kd[8];
        kd[0] = bfl(kk[0]) * __expf(l0[0] - s0[0]); kd[1] = bfh(kk[0]) * __expf(l0[1] - s0[1]); kd[2] = bfl(kk[1]) * __expf(l0[2] - s0[2]); kd[3] = bfh(kk[1]) * __expf(l0[3] - s0[3]);
        kd[4] = bfl(kk[2]) * __expf(l1[0] - s1[0]); kd[5] = bfh(kk[2]) * __expf(l1[1] - s1[1]); kd[6] = bfl(kk[3]) * __expf(l1[2] - s1[2]); kd[7] = bfh(kk[3]) * __expf(l1[3] - s1[3]);
        const int sx = s ^ (((k8 >> 3) & 7) << 3);
#pragma unroll
        for (int j = 0; j < 4; ++j) { const unsigned pw = pkbf(kd[2 * j], kd[2 * j + 1]); KdT[(k8 + 2 * j) * PS + sx] = (bf16)(pw & 0xffffu); KdT[(k8 + 2 * j + 1) * PS + sx] = (bf16)(pw >> 16); } }
    store_vt(lds, tid, vv);
    if (tid < 128) P.DV[(size_t)(c * 8 + h) * 128 + tid] = __expf(B[63 * 128 + tid]);
    __syncthreads();
    const int fr = lane & 15, fq = lane >> 4;
    bf16x8 a[2];
#pragma unroll
    for (int ks = 0; ks < 2; ++ks) a[ks] = *(const HLAS bf16x8*)(VT + (16 * w + fr) * PS + ((32 * ks + 8 * fq) ^ (((2 * w + (fr >> 3)) & 7) << 3)));
    bf16* out = P.LT + ((size_t)(c * 8 + h) * 128 + 16 * w + 4 * fq) * 128 + fr;
#pragma unroll
    for (int kt = 0; kt < 8; ++kt) { f32x4 acc = {0.f, 0.f, 0.f, 0.f};
#pragma unroll
        for (int ks = 0; ks < 2; ++ks) { const bf16x8 b = *(const HLAS bf16x8*)(KdT + (16 * kt + fr) * PS + ((32 * ks + 8 * fq) ^ (((2 * kt + (fr >> 3)) & 7) << 3))); acc = __builtin_amdgcn_mfma_f32_16x16x32_bf16(a[ks], b, acc, 0, 0, 0); }
#pragma unroll
        for (int r = 0; r < 4; ++r) out[(size_t)r * 128 + 16 * kt] = (bf16)(pkbf(acc[r], 0.f) & 0xffffu); }
    __syncthreads();
}
__device__ __forceinline__ void scan_all(const T& P, int gtid, int gthreads) {
    for (int e = gtid; e < 8 * 128 * 128; e += gthreads) {
        const int h = e >> 14, k = e & 127; bf16* p = P.LT + e; const float* d = P.DV + h * 128 + k;
        float s = 0.f;
        for (int c0 = 0; c0 < 128; c0 += 32) { float L[32], dd[32];
#pragma unroll
            for (int i = 0; i < 32; ++i) { L[i] = __uint_as_float((unsigned)p[(size_t)(c0 + i) * 131072] << 16); dd[i] = d[(size_t)(c0 + i) * 1024]; }
#pragma unroll
            for (int i = 0; i < 32; ++i) { p[(size_t)(c0 + i) * 131072] = (bf16)(pkbf(s, 0.f) & 0xffffu); s = dd[i] * s + L[i]; } }
    }
}
__device__ __forceinline__ void passC_unit(HLAS unsigned char* lds, const T& P, int c, int h) {
    const int tid = threadIdx.x, lane = tid & 63, w = __builtin_amdgcn_readfirstlane(tid >> 6), t0 = c * 64, hcol = h * 128;
    const int fr = lane & 15, fq = lane >> 4;
    float loc[16]; u32x4 qqv[2], kkv[2], vv[2], stv[4]; bf16 gg[4][4];
    load_b_issue(P.ALF, t0, hcol, tid, loc);
#pragma unroll
    for (int it = 0; it < 2; ++it) { const int item = tid + 512 * it, t = item >> 4, k8 = (item & 15) * 8; const size_t o_ = (size_t)(t0 + t) * 1024 + hcol + k8;
        qqv[it] = *(const u32x4*)(P.AQ + o_); kkv[it] = *(const u32x4*)(P.AK + o_); vv[it] = *(const u32x4*)(P.AI + o_); }
    { const bf16* src = P.LT + (size_t)(c * 8 + h) * 16384;
#pragma unroll
      for (int it = 0; it < 4; ++it) { const int item = tid + 512 * it, v = item >> 4, k8 = (item & 15) * 8; stv[it] = *(const u32x4*)(src + v * 128 + k8); } }
#pragma unroll
    for (int i = 0; i < 4; ++i)
#pragma unroll
        for (int r = 0; r < 4; ++r) gg[i][r] = P.AG[(size_t)(t0 + 16 * (w >> 1) + 4 * fq + r) * 1024 + hcol + 16 * ((w & 1) * 4 + i) + fr];
    load_b_finish(lds, tid, loc);
    HLAS float* B = (HLAS float*)(lds + L_B); HLAS bf16* QT = (HLAS bf16*)(lds + L_QT); HLAS bf16* Q0 = (HLAS bf16*)(lds + L_Q0); HLAS bf16* KT = (HLAS bf16*)(lds + L_KT);
    HLAS bf16* VT = (HLAS bf16*)(lds + L_VT); HLAS bf16* PP = (HLAS bf16*)(lds + L_P); HLAS bf16* ST = (HLAS bf16*)(lds + L_B); HLAS float* red = (HLAS float*)(lds + L_RED);
#pragma unroll
    for (int it = 0; it < 2; ++it) { const int item = tid + 512 * it, t = item >> 4, k8 = (item & 15) * 8, J = t >> 4;
        const u32x4 qq = qqv[it], kk = kkv[it];
        float bt[8], q[8], kf[8];
        { const f32x4 x0 = *(const HLAS f32x4*)(B + t * 128 + k8), x1 = *(const HLAS f32x4*)(B + t * 128 + k8 + 4);
#pragma unroll
          for (int j = 0; j < 4; ++j) { bt[j] = x0[j]; bt[4 + j] = x1[j]; q[2 * j] = bfl(qq[j]); q[2 * j + 1] = bfh(qq[j]); kf[2 * j] = bfl(kk[j]); kf[2 * j + 1] = bfh(kk[j]); } }
        { float e0[8]; u32x4 o;
#pragma unroll
          for (int j = 0; j < 8; ++j) e0[j] = q[j] * __expf(bt[j]);
          o[0] = pkbf(e0[0], e0[1]); o[1] = pkbf(e0[2], e0[3]); o[2] = pkbf(e0[4], e0[5]); o[3] = pkbf(e0[6], e0[7]);
          *(HLAS u32x4*)(Q0 + t * PQ + k8) = o; }
        for (int I = J; I < 4; ++I) {
            const f32x4 r0 = *(const HLAS f32x4*)(B + (16 * I) * 128 + k8), r1 = *(const HLAS f32x4*)(B + (16 * I) * 128 + k8 + 4);
            float br[8];
#pragma unroll
            for (int j = 0; j < 4; ++j) { br[j] = r0[j]; br[4 + j] = r1[j]; }
            float e1[8]; u32x4 o;
#pragma unroll
            for (int j = 0; j < 8; ++j) e1[j] = kf[j] * __expf(br[j] - bt[j]);
            o[0] = pkbf(e1[0], e1[1]); o[1] = pkbf(e1[2], e1[3]); o[2] = pkbf(e1[4], e1[5]); o[3] = pkbf(e1[6], e1[7]);
            const int off = (I == 0) ? 0 : (I == 1) ? 16 : (I == 2) ? 48 : 96;
            *(HLAS u32x4*)(KT + (off + t) * PQ + k8) = o;
            if (I == J) {
#pragma unroll
                for (int j = 0; j < 8; ++j) e1[j] = q[j] * __expf(bt[j] - br[j]);
                o[0] = pkbf(e1[0], e1[1]); o[1] = pkbf(e1[2], e1[3]); o[2] = pkbf(e1[4], e1[5]); o[3] = pkbf(e1[6], e1[7]);
                *(HLAS u32x4*)(QT + t * PQ + k8) = o; }
        } }
    store_vt(lds, tid, vv);
    __syncthreads();
#pragma unroll
    for (int it = 0; it < 4; ++it) { const int item = tid + 512 * it, v = item >> 4, k8 = (item & 15) * 8; *(HLAS u32x4*)(ST + v * PQ + k8) = stv[it]; }
    for (int idx = w; idx < 10; idx += 8) {
        const int I = (idx >= 6) ? 3 : (idx >= 3) ? 2 : (idx >= 1) ? 1 : 0, J = idx - ((I * (I + 1)) >> 1), off = (I == 0) ? 0 : (I == 1) ? 16 : (I == 2) ? 48 : 96;
        f32x4 acc = {0.f, 0.f, 0.f, 0.f};
#pragma unroll
        for (int ks = 0; ks < 4; ++ks) { const bf16x8 a = *(const HLAS bf16x8*)(QT + (16 * I + fr) * PQ + 32 * ks + 8 * fq), b = *(const HLAS bf16x8*)(KT + (off + 16 * J + fr) * PQ + 32 * ks + 8 * fq);
            acc = __builtin_amdgcn_mfma_f32_16x16x32_bf16(a, b, acc, 0, 0, 0); }
#pragma unroll
        for (int r = 0; r < 4; ++r) { const float v = (I == J && fr > 4 * fq + r) ? 0.f : acc[r]; PP[(16 * I + 4 * fq + r) * PS + 16 * J + fr] = (bf16)(pkbf(v, 0.f) & 0xffffu); } }
    if (w >= 2) { const int z = w - 2, I = (z < 3) ? 0 : (z < 5) ? 1 : 2, J = (z < 3) ? z + 1 : (z < 5) ? z - 1 : 3;
#pragma unroll
        for (int r = 0; r < 4; ++r) PP[(16 * I + 4 * fq + r) * PS + 16 * J + fr] = (bf16)0; }
    __syncthreads();
    { const int I = w >> 1, vh = w & 1;
      f32x4 acc[4];
#pragma unroll
      for (int i = 0; i < 4; ++i) { const int vt = vh * 4 + i; f32x4 a4 = {0.f, 0.f, 0.f, 0.f};
#pragma unroll
          for (int ks = 0; ks < 2; ++ks) { const bf16x8 a = *(const HLAS bf16x8*)(PP + (16 * I + fr) * PS + 32 * ks + 8 * fq), b = *(const HLAS bf16x8*)(VT + (16 * vt + fr) * PS + ((32 * ks + 8 * fq) ^ (((2 * vt + (fr >> 3)) & 7) << 3)));
              a4 = __builtin_amdgcn_mfma_f32_16x16x32_bf16(a, b, a4, 0, 0, 0); }
#pragma unroll
          for (int ks = 0; ks < 4; ++ks) { const bf16x8 a = *(const HLAS bf16x8*)(Q0 + (16 * I + fr) * PQ + 32 * ks + 8 * fq), b = *(const HLAS bf16x8*)(ST + (16 * vt + fr) * PQ + 32 * ks + 8 * fq);
              a4 = __builtin_amdgcn_mfma_f32_16x16x32_bf16(a, b, a4, 0, 0, 0); }
          acc[i] = a4; }
      float ss[4];
#pragma unroll
      for (int r = 0; r < 4; ++r) { float s = 0.f;
#pragma unroll
          for (int i = 0; i < 4; ++i) s += acc[i][r] * acc[i][r];
          s += __shfl_xor(s, 1); s += __shfl_xor(s, 2); s += __shfl_xor(s, 4); s += __shfl_xor(s, 8); ss[r] = s; }
      if (fr == 0) {
#pragma unroll
          for (int r = 0; r < 4; ++r) red[(I * 2 + vh) * 16 + 4 * fq + r] = ss[r]; }
      __syncthreads();
#pragma unroll
      for (int r = 0; r < 4; ++r) { const float tot = red[(I * 2) * 16 + 4 * fq + r] + red[(I * 2 + 1) * 16 + 4 * fq + r]; ss[r] = rsqrtf(tot * (1.f / 128.f) + 1e-6f); }
#pragma unroll
      for (int i = 0; i < 4; ++i) { const int v = 16 * (vh * 4 + i) + fr; const float nwv = P.nw[v];
#pragma unroll
          for (int r = 0; r < 4; ++r) { const size_t o_ = (size_t)(t0 + 16 * I + 4 * fq + r) * 1024 + hcol + v;
              const float g = __uint_as_float((unsigned)gg[i][r] << 16);
              P.OA[(size_t)(t0 + 16 * I + 4 * fq + r) * 2048 + hcol + v] = (bf16)(pkbf(acc[i][r] * ss[r] * nwv * (g / (1.f + __expf(-g))), 0.f) & 0xffffu); } }
    }
    __syncthreads();
}
#undef HLAS
}


#define GAS __attribute__((address_space(1)))
#define LAS __attribute__((address_space(3)))
typedef unsigned short bf16;
typedef unsigned v4u __attribute__((ext_vector_type(4)));
typedef float f32x4 __attribute__((ext_vector_type(4)));
constexpr int NWAVES = 8;
constexpr size_t MiB = 1u << 20;
constexpr size_t WS_BAR = 65536, BAR_BYTES = 16384;
constexpr size_t WS_LB = 0;
constexpr size_t WS_WUA = 1 * MiB, WS_WUB = 5 * MiB, WS_WO = 9 * MiB, WS_WFI = 17 * MiB, WS_WFD = 61 * MiB;
constexpr size_t WS_WIN = 83 * MiB;
constexpr size_t WS_OA = 83 * MiB, WS_OB = 99 * MiB, WS_DV = 115 * MiB;
constexpr size_t WS_H1 = 127 * MiB;
constexpr size_t WS_PROJ = 159 * MiB;
constexpr size_t WS_ALF = 271 * MiB;
constexpr size_t WS_T = 159 * MiB;
constexpr size_t WS_HID = 223 * MiB;
constexpr size_t WS_END = 311 * MiB;
static_assert(WS_ALF + 32 * MiB <= WS_END && WS_HID + 88 * MiB <= WS_END, "ws map");
constexpr size_t WS_LS2 = 304 * MiB, WS_CUM2 = 305 * MiB;

__device__ __forceinline__ unsigned f2bf(float f) { unsigned u = __builtin_bit_cast(unsigned, f); return (u + 0x7fffu + ((u >> 16) & 1u)) >> 16; }
__device__ __forceinline__ unsigned pk2(float lo, float hi) { return f2bf(lo) | (f2bf(hi) << 16); }
__device__ __forceinline__ float bf2f(bf16 u) { return __uint_as_float((unsigned)u << 16); }
__device__ __forceinline__ float wave_sum(float v) {
#pragma unroll
    for (int o = 1; o < 64; o <<= 1) v += __shfl_xor(v, o);
    return v;
}
#define LDS_WAIT() asm volatile("s_waitcnt lgkmcnt(0)" ::: "memory")

typedef GAS unsigned gu32;
#define RLX_AGENT __ATOMIC_RELAXED, __HIP_MEMORY_SCOPE_AGENT
struct Args { const float* in[14]; float* out; unsigned char* ws; int ph_lo, ph_hi; };

struct TrItem { const float* src; bf16* dst; };
__device__ __forceinline__ void tr_load(const TrItem& t, int ldw, int lane, f32x4 (&a)[8], f32x4 (&b)[8]) {
    const int r = lane >> 4, c = lane & 15;
#pragma unroll
    for (int i = 0; i < 8; ++i) { const float* p = t.src + (size_t)(8 * i + 2 * r) * ldw + 4 * c; a[i] = *(const f32x4*)p; b[i] = *(const f32x4*)(p + ldw); }
}
__device__ __forceinline__ void tr_store(const TrItem& t, int DP, int lane, LAS unsigned* scr, const f32x4 (&a)[8], const f32x4 (&b)[8]) {
    const int r = lane >> 4, c = lane & 15;
#pragma unroll
    for (int i = 0; i < 8; ++i) { const int kp = (4 * i + r) ^ (4 * (c & 7));
#pragma unroll
        for (int j = 0; j < 4; ++j) scr[(4 * c + j) * 32 + kp] = pg8::cvt_pk_bf16(a[i][j], b[i][j]); }
    LDS_WAIT(); asm volatile("" ::: "memory");
#pragma unroll
    for (int it = 0; it < 8; ++it) { const int n = 8 * it + (lane >> 3), g = lane & 7;
        const v4u o = *(const LAS v4u*)(scr + n * 32 + ((4 * g) ^ (4 * ((n >> 2) & 7))));
        *(v4u*)(t.dst + (size_t)n * DP + 8 * g) = o; }
    LDS_WAIT(); asm volatile("" ::: "memory");
}
__device__ __forceinline__ TrItem tr_item(const float* W, int ldw, int DP, int ncols, bf16* WT, int row_off, int mode, int it) {
    const int nblk = ncols / 64, kb = it / nblk, nb = it % nblk, n0 = 64 * nb;
    const int drow0 = mode ? ((n0 >> 7) * 256 + (n0 & 127) + row_off) : (row_off + n0);
    TrItem t; t.src = W + (size_t)(64 * kb) * ldw + n0; t.dst = WT + (size_t)drow0 * DP + 64 * kb; return t;
}
__device__ __forceinline__ void p0_matrix(const float* W, int ldw, int K, int ncols, bf16* WT, int row_off, int mode, LAS unsigned* scr, int lane, int gw, int NGW, int DP = 0) {
    if (DP == 0) DP = K;
    const int nitems = (K / 64) * (ncols / 64);
    int it = gw; if (it >= nitems) return;
    f32x4 a0[8], b0[8], a1[8], b1[8];
    TrItem t0 = tr_item(W, ldw, DP, ncols, WT, row_off, mode, it), t1 = t0;
    tr_load(t0, ldw, lane, a0, b0);
    for (;;) {
        const int it1 = it + NGW, it2 = it1 + NGW;
        if (it1 < nitems) { t1 = tr_item(W, ldw, DP, ncols, WT, row_off, mode, it1); tr_load(t1, ldw, lane, a1, b1); }
        tr_store(t0, DP, lane, scr, a0, b0);
        if (it1 >= nitems) break;
        if (it2 < nitems) { t0 = tr_item(W, ldw, DP, ncols, WT, row_off, mode, it2); tr_load(t0, ldw, lane, a0, b0); }
        tr_store(t1, DP, lane, scr, a1, b1);
        if (it2 >= nitems) break;
        it = it2;
    }
}

struct Frame {
    LAS unsigned char* lds; int tid, lane, wave, G;
    const float *x, *w_in, *b_fox, *lbl, *hnw, *w_up_a, *w_up_b, *w_o, *n_mix_pre, *n_mix_post, *n_ffn_pre, *n_ffn_post, *w_ffn_in, *w_ffn_down;
    float* out; unsigned char* ws;
};

__device__ __forceinline__ void p0_prologue(Frame& F) {
    LAS unsigned* scr = (LAS unsigned*)(F.lds + F.wave * 16384);
    const int gw = blockIdx.x * NWAVES + F.wave, NGW = F.G * NWAVES;
    if (blockIdx.x == 0) { float* LB = (float*)(F.ws + WS_LB); for (int c = F.tid; c < AW; c += 512) LB[c] = 1.f / (1.f + expf(F.lbl[AW + c] - F.lbl[c])); }
    LAS float* wfT = (LAS float*)F.lds;
    for (int k = F.tid; k < DM; k += 512) { const f32x4 a4 = *(const f32x4*)(F.w_in + (size_t)k * NIN + 7168), b4 = *(const f32x4*)(F.w_in + (size_t)k * NIN + 7172);
        wfT[0 * DM + k] = a4.x; wfT[1 * DM + k] = a4.y; wfT[2 * DM + k] = a4.z; wfT[3 * DM + k] = a4.w; wfT[4 * DM + k] = b4.x; wfT[5 * DM + k] = b4.y; wfT[6 * DM + k] = b4.z; wfT[7 * DM + k] = b4.w; }
    __syncthreads();
    {
        bf16* H1 = (bf16*)(F.ws + WS_H1); float* LS = (float*)(F.ws + WS_LS2);
        f32x4 wn[8], va[8], vb[8];
#pragma unroll
        for (int j = 0; j < 8; ++j) wn[j] = ((const f32x4*)F.n_mix_pre + F.lane)[64 * j];
#define P0_LOAD(m_, v_) do { const f32x4* xr_ = (const f32x4*)(F.x + (size_t)(m_) * DM) + F.lane; _Pragma("unroll") for (int j = 0; j < 8; ++j) v_[j] = xr_[64 * j]; } while (0)
#define P0_ROW(m_, v) do { \
            asm volatile("" ::: "memory");                                      \
            float s = 0.f; \
            _Pragma("unroll") for (int j = 0; j < 8; ++j) s += (v[j].x * v[j].x + v[j].y * v[j].y) + (v[j].z * v[j].z + v[j].w * v[j].w); \
            const float rstd = rsqrtf(wave_sum(s) * (1.f / DM) + EPS); \
            float fd[8] = {0.f, 0.f, 0.f, 0.f, 0.f, 0.f, 0.f, 0.f}; \
            unsigned long long* o8 = (unsigned long long*)(H1 + (size_t)(m_) * DM) + F.lane; \
            _Pragma("unroll") for (int j = 0; j < 8; ++j) { v[j] = v[j] * rstd * wn[j]; \
                o8[64 * j] = (unsigned long long)pk2(v[j].x, v[j].y) | ((unsigned long long)pk2(v[j].z, v[j].w) << 32); \
                _Pragma("unroll") for (int e = 0; e < 8; ++e) { const f32x4 wv = *(const LAS f32x4*)(wfT + e * DM + 256 * j + 4 * F.lane); fd[e] += (v[j].x * wv.x + v[j].y * wv.y) + (v[j].z * wv.z + v[j].w * wv.w); } } \
            _Pragma("unroll") for (int e = 0; e < 8; ++e) fd[e] = wave_sum(fd[e]); \
            if (F.lane < 8) { float z = fd[0]; \
                _Pragma("unroll") for (int e = 1; e < 8; ++e) z = (F.lane == e) ? fd[e] : z; \
                z += F.b_fox[F.lane]; \
                LS[(size_t)(m_) * 8 + F.lane] = fminf(z, 0.f) - log1pf(expf(-fabsf(z))); } } while (0)
        int m = gw;
        if (m < S) { P0_LOAD(m, va);
            for (;;) { const int m1 = m + NGW, m2 = m1 + NGW;
                if (m1 < S) P0_LOAD(m1, vb);
                P0_ROW(m, va);
                if (m1 >= S) break;
                if (m2 < S) P0_LOAD(m2, va);
                P0_ROW(m1, vb);
                if (m2 >= S) break;
                m = m2; } }
#undef P0_LOAD
#undef P0_ROW
    }
    __syncthreads();
    p0_matrix(F.w_in, NIN, DM, 7168, (bf16*)(F.ws + WS_WIN), 0, 0, scr, F.lane, gw, NGW);
    p0_matrix(F.w_in + 7176, NIN, DM, 4096, (bf16*)(F.ws + WS_WIN), 7168, 0, scr, F.lane, gw, NGW);
}
__device__ __forceinline__ void late_weights(Frame& F, int my, int nidle) {
    LAS unsigned* scr = (LAS unsigned*)(F.lds + F.wave * 16384);
    const int gw = my * NWAVES + F.wave, NGW = nidle * NWAVES;
    p0_matrix(F.w_up_a, DM, AW, DM, (bf16*)(F.ws + WS_WUA), 0, 0, scr, F.lane, gw, NGW, 2 * AW);
    p0_matrix(F.w_up_b, DM, AW, DM, (bf16*)(F.ws + WS_WUA) + AW, 0, 0, scr, F.lane, gw, NGW, 2 * AW);
    p0_matrix(F.w_o, DM, DM, DM, (bf16*)(F.ws + WS_WO), 0, 0, scr, F.lane, gw, NGW);
    p0_matrix(F.w_ffn_in, 2 * DFF, DM, DFF, (bf16*)(F.ws + WS_WFI), 0, 1, scr, F.lane, gw, NGW);
    p0_matrix(F.w_ffn_in + DFF, 2 * DFF, DM, DFF, (bf16*)(F.ws + WS_WFI), 128, 1, scr, F.lane, gw, NGW);
}
__device__ __forceinline__ void cum_scan(Frame& F) {
    const float* LS = (const float*)(F.ws + WS_LS2); float* CUM = (float*)(F.ws + WS_CUM2);
    const int h = F.wave, lane = F.lane;
    double carry = 0.0;
    for (int c0 = 0; c0 < S / 64; c0 += 8) {
        float v[8];
#pragma unroll
        for (int i = 0; i < 8; ++i) v[i] = LS[(size_t)((c0 + i) * 64 + lane) * 8 + h];
#pragma unroll
        for (int i = 0; i < 8; ++i) {
            double x = (double)v[i];
#pragma unroll
            for (int o = 1; o < 64; o <<= 1) { const double y = __shfl_up(x, o); x += (lane >= o) ? y : 0.0; }
            CUM[(size_t)h * S + (c0 + i) * 64 + lane] = (float)(carry + x);
            carry += __shfl(x, 63);
        }
    }
}
#define BF4(tw) ((f32x4){__uint_as_float((unsigned)(tw) << 16), __uint_as_float((unsigned)(tw) & 0xffff0000u), __uint_as_float((unsigned)((tw) >> 32) << 16), __uint_as_float((unsigned)((tw) >> 32) & 0xffff0000u)})
__device__ __forceinline__ void r1_load(Frame& F, int m, f32x4 (&v)[8], f32x4 (&xv)[8]) {
    const unsigned long long* tr = (const unsigned long long*)((const bf16*)(F.ws + WS_T) + (size_t)m * DM) + F.lane; const f32x4* xr = (const f32x4*)(F.x + (size_t)m * DM) + F.lane;
#pragma unroll
    for (int j = 0; j < 8; ++j) { const unsigned long long tw = tr[64 * j]; v[j] = BF4(tw); xv[j] = xr[64 * j]; }
}
__device__ __forceinline__ void r1_finish(Frame& F, int m, f32x4 (&v)[8], const f32x4 (&xv)[8], const f32x4 (&wa)[8], const f32x4 (&wb)[8]) {
    float s = 0.f;
#pragma unroll
    for (int j = 0; j < 8; ++j) s += (v[j].x * v[j].x + v[j].y * v[j].y) + (v[j].z * v[j].z + v[j].w * v[j].w);
    const float rstd = rsqrtf(wave_sum(s) * (1.f / DM) + EPS); float s2 = 0.f;
#pragma unroll
    for (int j = 0; j < 8; ++j) { v[j] = xv[j] + v[j] * rstd * wa[j]; s2 += (v[j].x * v[j].x + v[j].y * v[j].y) + (v[j].z * v[j].z + v[j].w * v[j].w); }
    f32x4* orow = (f32x4*)(F.out + (size_t)m * DM) + F.lane;
#pragma unroll
    for (int j = 0; j < 8; ++j) orow[64 * j] = v[j];
    const float rstd2 = rsqrtf(wave_sum(s2) * (1.f / DM) + EPS);
    unsigned long long* o8 = (unsigned long long*)((bf16*)(F.ws + WS_H1) + (size_t)m * DM) + F.lane;
#pragma unroll
    for (int j = 0; j < 8; ++j) { const f32x4 h = v[j] * rstd2 * wb[j]; o8[64 * j] = (unsigned long long)pk2(h.x, h.y) | ((unsigned long long)pk2(h.z, h.w) << 32); }
}
__device__ __forceinline__ void rowpass1(Frame& F, int gw, int NGW, int mend) {
    int m = gw; if (m >= mend) return;
    f32x4 wa[8], wb[8], v0[8], x0[8], v1[8], x1[8];
#pragma unroll
    for (int j = 0; j < 8; ++j) { wa[j] = ((const f32x4*)F.n_mix_post + F.lane)[64 * j]; wb[j] = ((const f32x4*)F.n_ffn_pre + F.lane)[64 * j]; }
    r1_load(F, m, v0, x0);
    for (;;) {
        const int m1 = m + NGW, m2 = m1 + NGW;
        if (m1 < mend) r1_load(F, m1, v1, x1);
        r1_finish(F, m, v0, x0, wa, wb);
        if (m1 >= mend) break;
        if (m2 < mend) r1_load(F, m2, v0, x0);
        r1_finish(F, m1, v1, x1, wa, wb);
        if (m2 >= mend) break;
        m = m2;
    }
}
__device__ __forceinline__ void r2_load(Frame& F, int m, f32x4 (&v)[8], f32x4 (&xv)[8]) {
    const unsigned long long* tr = (const unsigned long long*)((const bf16*)(F.ws + WS_T) + (size_t)m * DM) + F.lane; const f32x4* orow = (const f32x4*)(F.out + (size_t)m * DM) + F.lane;
#pragma unroll
    for (int j = 0; j < 8; ++j) { const unsigned long long tw = tr[64 * j]; v[j] = BF4(tw); xv[j] = orow[64 * j]; }
}
__device__ __forceinline__ void r2_finish(Frame& F, int m, const f32x4 (&v)[8], const f32x4 (&xv)[8], const f32x4 (&wa)[8]) {
    float s = 0.f;
#pragma unroll
    for (int j = 0; j < 8; ++j) s += (v[j].x * v[j].x + v[j].y * v[j].y) + (v[j].z * v[j].z + v[j].w * v[j].w);
    const float rstd = rsqrtf(wave_sum(s) * (1.f / DM) + EPS);
    f32x4* orow = (f32x4*)(F.out + (size_t)m * DM) + F.lane;
#pragma unroll
    for (int j = 0; j < 8; ++j) orow[64 * j] = xv[j] + v[j] * rstd * wa[j];
}
__device__ __forceinline__ void rowpass2(Frame& F, int gw, int NGW, int mend) {
    int m = gw; if (m >= mend) return;
    f32x4 wa[8], v0[8], x0[8], v1[8], x1[8];
#pragma unroll
    for (int j = 0; j < 8; ++j) wa[j] = ((const f32x4*)F.n_ffn_post + F.lane)[64 * j];
    r2_load(F, m, v0, x0);
    for (;;) {
        const int m1 = m + NGW, m2 = m1 + NGW;
        if (m1 < mend) r2_load(F, m1, v1, x1);
        r2_finish(F, m, v0, x0, wa);
        if (m1 >= mend) break;
        if (m2 < mend) r2_load(F, m2, v0, x0);
        r2_finish(F, m1, v1, x1, wa);
        if (m2 >= mend) break;
        m = m2;
    }
}
#undef BF4

#define XB_TMO      128
#define XB_XCNT(j)  (256  + 64 * (j))
#define XB_XSUB(j)  (1280 + 64 * (j))
#define XB_XGEN(j)  (2304 + 64 * (j))
#define XB_TOP      3328
#define XB_TOPGEN   3392
#define XCD_BAR_WORDS 3456
#define XB_SPIN_CAP (1u << 18)

__device__ __forceinline__ unsigned xb_ld(unsigned* p)              { return __hip_atomic_load(p, __ATOMIC_RELAXED, __HIP_MEMORY_SCOPE_AGENT); }
__device__ __forceinline__ unsigned xb_add(unsigned* p, unsigned v) { return __hip_atomic_fetch_add(p, v, __ATOMIC_RELAXED, __HIP_MEMORY_SCOPE_AGENT); }
__device__ __forceinline__ unsigned xb_xcc_id() { return (unsigned)__builtin_amdgcn_s_getreg((3 << 11) | 20) & 0xFu; }
#define XB_SPIN(cond, bar) do { unsigned _sp = 0; while (cond) { __builtin_amdgcn_s_sleep(1); \
    if ((++_sp & 255u) == 0u) { if (xb_ld(&(bar)[XB_TMO])) break; if (_sp > XB_SPIN_CAP) { atomicAdd(&(bar)[XB_TMO], 1u); break; } } } } while (0)

struct XcdBarrier {
    unsigned* bar; unsigned x;
    volatile LAS unsigned* st;
};

__device__ __forceinline__ XcdBarrier xcd_barrier_post(unsigned* bar, volatile LAS unsigned* st) {
    XcdBarrier b; b.bar = bar; b.x = xb_xcc_id(); b.st = st;
    if (threadIdx.x == 0) (void)xb_add(&bar[XB_XCNT(b.x)], 1u);
    return b;
}
__device__ __forceinline__ void xcd_barrier_complete(unsigned* bar, unsigned x, unsigned& nloc, unsigned& nx) {
    const unsigned G = gridDim.x * gridDim.y * gridDim.z;
    unsigned sum, cnt, mine, sp = 0u;
    for (;;) {
        sum = 0u; cnt = 0u; mine = 0u;
#pragma unroll
        for (unsigned j = 0; j < 16; ++j) { const unsigned c = xb_ld(&bar[XB_XCNT(j)]); sum += c; cnt += (c > 0u) ? 1u : 0u; mine = (j == x) ? c : mine; }
        if (sum == G) break;
        __builtin_amdgcn_s_sleep(1);
        if ((++sp & 255u) == 0u) { if (xb_ld(&bar[XB_TMO])) break; if (sp > XB_SPIN_CAP) { atomicAdd(&bar[XB_TMO], 1u); break; } }
    }
    nloc = mine > 0u ? mine : 1u; nx = cnt > 0u ? cnt : 1u;
}

__device__ __forceinline__ void xcd_barrier(const XcdBarrier& b) {
    asm volatile("s_waitcnt vmcnt(0)" ::: "memory");
    __syncthreads();
    if (threadIdx.x == 0) {
        unsigned* bar = b.bar;
        __builtin_amdgcn_s_waitcnt(0);
        unsigned nloc = b.st[0], nx = b.st[1];
        if (nloc == 0u) { xcd_barrier_complete(bar, b.x, nloc, nx); b.st[0] = nloc; b.st[1] = nx; }
        const unsigned old = xb_add(&bar[XB_XSUB(b.x)], 1u);
        const unsigned gen = old / nloc;
        if (old + 1u == (gen + 1u) * nloc) {
            __builtin_amdgcn_fence(__ATOMIC_RELEASE, "agent");
            asm volatile("s_waitcnt vmcnt(0)" ::: "memory");
            const unsigned og = xb_add(&bar[XB_TOP], 1u);
            const unsigned tg = og / nx;
            if (og + 1u == (tg + 1u) * nx) xb_add(&bar[XB_TOPGEN], 1u);
            else XB_SPIN(xb_ld(&bar[XB_TOPGEN]) == tg, bar);
            __builtin_amdgcn_fence(__ATOMIC_ACQUIRE, "agent");
            xb_add(&bar[XB_XGEN(b.x)], 1u);
            asm volatile("s_waitcnt vmcnt(0)" ::: "memory");
        } else {
            XB_SPIN(xb_ld(&bar[XB_XGEN(b.x)]) == gen, bar);
            __builtin_amdgcn_fence(__ATOMIC_ACQUIRE, "agent");
            asm volatile("s_waitcnt vmcnt(0)" ::: "memory");
        }
    }
    __syncthreads();
}

constexpr int LDS_BYTES = 147456;
enum { PH_PRO = 0, PH_GEMM1 = 1, PH_MIX = 2, PH_SCAN = 3, PH_HOUT = 4, PH_UPA = 5, PH_WO = 6, PH_ROW1 = 7, PH_FFI = 8, PH_FFD = 9, PH_ROW2 = 10, PH_N = 11 };
__global__ void __launch_bounds__(NWAVES * 64, 2) mega(Args a) {
    extern __shared__ __attribute__((aligned(16))) unsigned char lds[];
    Frame F;
    F.lds = (LAS unsigned char*)lds; F.tid = threadIdx.x; F.lane = F.tid & 63; F.wave = __builtin_amdgcn_readfirstlane(F.tid >> 6); F.G = gridDim.x;
    F.x = a.in[0]; F.w_in = a.in[1]; F.b_fox = a.in[2]; F.lbl = a.in[3]; F.hnw = a.in[4]; F.w_up_a = a.in[5]; F.w_up_b = a.in[6]; F.w_o = a.in[7];
    F.n_mix_pre = a.in[8]; F.n_mix_post = a.in[9]; F.n_ffn_pre = a.in[10]; F.n_ffn_post = a.in[11]; F.w_ffn_in = a.in[12]; F.w_ffn_down = a.in[13];
    F.out = a.out; F.ws = a.ws;
    unsigned char* ws = a.ws;
    const int lo = a.ph_lo, hi = a.ph_hi;
#define IN(k) (lo <= (k) && (k) < hi)
#define REFRESH() do { int t_ = threadIdx.x; asm volatile("" : "+v"(t_)); F.tid = t_; F.lane = t_ & 63; F.wave = __builtin_amdgcn_readfirstlane(t_ >> 6); } while (0)
    if (a.ph_lo < 0) cg::this_grid().sync();
    volatile LAS unsigned* MISC = (volatile LAS unsigned*)(F.lds + 147328);
    if (threadIdx.x < 32) MISC[threadIdx.x] = 0u;
    __syncthreads();
    XcdBarrier bar; bar.bar = (unsigned*)(a.ws + WS_BAR); bar.x = 0; bar.st = nullptr;
    const bool fused = (hi - lo) > 1;
    if (fused) bar = xcd_barrier_post((unsigned*)(a.ws + WS_BAR), MISC + 8);
#define SEAM(k) do { if (IN(k) && IN((k) + 1)) xcd_barrier(bar); } while (0)
    pg8::bf16_t* H1 = (pg8::bf16_t*)(ws + WS_H1);
    if (IN(PH_PRO)) { REFRESH(); p0_prologue(F); }
    SEAM(PH_PRO);
    if (IN(PH_GEMM1)) {
        const int rounds = (32 * 44 + F.G - 1) / F.G, GC = (32 * 44 + rounds - 1) / rounds, nconv = F.G - GC;
        if ((int)blockIdx.x == F.G - 1) { REFRESH(); cum_scan(F); __syncthreads(); }
        if ((int)blockIdx.x < GC) {
            pg8::Gemm g{H1, (const pg8::bf16_t*)(ws + WS_WIN), S, 11264, DM}; pg8::StaticOrder So; So.init(S, 11264, GC, (int)blockIdx.x);
            pg8::EpiProj E{(pg8::bf16_t*)(ws + WS_PROJ), (float*)(ws + WS_ALF), (pg8::bf16_t*)a.out, (const float*)(ws + WS_LB), (unsigned*)(ws + WS_BAR + 15360)};
            pg8::gemm_phase<pg8::EpiProj, pg8::StaticOrder, true, true>(F.lds, g, So, E);
            if (nconv == 0) { REFRESH(); late_weights(F, (int)blockIdx.x, F.G); }
        } else { REFRESH(); late_weights(F, (int)blockIdx.x - GC, nconv); }
    }
    SEAM(PH_GEMM1);
    const hg::T HT{(const hg::bf16*)(ws + WS_PROJ), (const hg::bf16*)(ws + WS_PROJ) + (size_t)S * 1024, (const hg::bf16*)(ws + WS_PROJ) + (size_t)2 * S * 1024, (const hg::bf16*)(ws + WS_PROJ) + (size_t)3 * S * 1024,
                   (const float*)(ws + WS_ALF), (hg::bf16*)(ws + WS_H1), (float*)(ws + WS_DV), (hg::bf16*)(ws + WS_OA), a.in[4]};
    if (IN(PH_MIX)) {
        { const fox::bf16* PR = (const fox::bf16*)(ws + WS_PROJ);
          const fox::AttnT AT{PR + (size_t)4 * S * 1024, PR + (size_t)5 * S * 1024, PR + (size_t)6 * S * 1024, (fox::bf16*)(ws + WS_OA) + AW, (const float*)(ws + WS_CUM2), (const unsigned*)(ws + WS_BAR + 15360)};
          fox::attn_phase((char*)lds, AT, (int)blockIdx.x, (int)gridDim.x); }
        __syncthreads();
        for (int u = (int)blockIdx.x; u < 1024; u += (int)gridDim.x) hg::passA_unit(F.lds, HT, u >> 3, u & 7);
    }
    SEAM(PH_MIX);
    if (IN(PH_SCAN)) hg::scan_all(HT, (int)(blockIdx.x * 512 + threadIdx.x), (int)(gridDim.x * 512));
    SEAM(PH_SCAN);
    if (IN(PH_HOUT)) { for (int u = (int)blockIdx.x; u < 1024; u += (int)gridDim.x) hg::passC_unit(F.lds, HT, u >> 3, u & 7); }
    SEAM(PH_HOUT);
    if (IN(PH_UPA)) {
        pg8::Gemm g{(const pg8::bf16_t*)(ws + WS_OA), (const pg8::bf16_t*)(ws + WS_WUA), S, DM, DM}; pg8::StaticOrder So; So.init(S, DM, F.G, (int)blockIdx.x);
        pg8::EpiUp E{(const pg8::bf16_t*)a.out, (const pg8::bf16_t*)a.out + (size_t)S * DM, H1};
        pg8::gemm_phase<pg8::EpiUp, pg8::StaticOrder, true, true>(F.lds, g, So, E);
    }
    SEAM(PH_UPA);
    if (IN(PH_WO)) {
        pg8::Gemm g{H1, (const pg8::bf16_t*)(ws + WS_WO), S, DM, DM}; pg8::StaticOrder So; So.init(S, DM, F.G, (int)blockIdx.x);
        pg8::EpiT16 E{(pg8::bf16_t*)(ws + WS_T)};
        pg8::gemm_phase<pg8::EpiT16, pg8::StaticOrder, true, true>(F.lds, g, So, E);
    }
    SEAM(PH_WO);
    if (IN(PH_ROW1)) { REFRESH(); rowpass1(F, blockIdx.x * NWAVES + F.wave, F.G * NWAVES, S); }
    SEAM(PH_ROW1);
    if (IN(PH_FFI)) {
        pg8::Gemm g{H1, (const pg8::bf16_t*)(ws + WS_WFI), S, 2 * DFF, DM}; pg8::StaticOrder So; So.init(S, 2 * DFF, F.G, (int)blockIdx.x);
        pg8::EpiSwiglu E{(pg8::bf16_t*)(ws + WS_HID)};
        pg8::gemm_phase<pg8::EpiSwiglu, pg8::StaticOrder, true, true>(F.lds, g, So, E);
        { const int rem = (32 * 44) % F.G, my = rem ? (int)blockIdx.x - rem : (int)blockIdx.x;
          if (my >= 0) { REFRESH(); LAS unsigned* scr = (LAS unsigned*)(F.lds + F.wave * 16384);
              p0_matrix(F.w_ffn_down, DM, DFF, DM, (bf16*)(F.ws + WS_WFD), 0, 0, scr, F.lane, my * NWAVES + F.wave, (rem ? F.G - rem : F.G) * NWAVES); } }
    }
    SEAM(PH_FFI);
    if (IN(PH_FFD)) {
        pg8::Gemm g{(const pg8::bf16_t*)(ws + WS_HID), (const pg8::bf16_t*)(ws + WS_WFD), S, DM, DFF}; pg8::StaticOrder So; So.init(S, DM, F.G, (int)blockIdx.x);
        pg8::EpiT16 E{(pg8::bf16_t*)(ws + WS_T)};
        pg8::gemm_phase<pg8::EpiT16, pg8::StaticOrder, true, true>(F.lds, g, So, E);
    }
    SEAM(PH_FFD);
    if (IN(PH_ROW2)) { REFRESH(); rowpass2(F, blockIdx.x * NWAVES + F.wave, F.G * NWAVES, S); }
#undef IN
#undef SEAM
}

extern "C" void kernel_launch(void* const* d_in, const int* in_sizes, int n_in, void* d_out, int out_size, void* d_ws, size_t ws_size, hipStream_t stream) {
    static int grid = 0;
    if (grid == 0) {
        if (n_in != 14 || out_size != S * DM || ws_size < WS_END) { fprintf(stderr, "kernel_launch: unexpected shapes (n_in %d out %d ws %zu)\n", n_in, out_size, ws_size); grid = -1; return; }
        if (hipFuncSetAttribute((const void*)mega, hipFuncAttributeMaxDynamicSharedMemorySize, LDS_BYTES) != hipSuccess) { fprintf(stderr, "hipFuncSetAttribute failed\n"); grid = -1; return; }
        int dev = 0, cus = 0, per_cu = 0;
        hipGetDevice(&dev); hipDeviceGetAttribute(&cus, hipDeviceAttributeMultiprocessorCount, dev);
        hipOccupancyMaxActiveBlocksPerMultiprocessor(&per_cu, (const void*)mega, NWAVES * 64, LDS_BYTES);
        (void)hipGetLastError();
        if (per_cu < 1) { fprintf(stderr, "occupancy query says %d\n", per_cu); }
        grid = cus;
    }
    if (grid < 0) return;
    Args a{};
    for (int i = 0; i < 14; ++i) a.in[i] = (const float*)d_in[i];
    a.out = (float*)d_out; a.ws = (unsigned char*)d_ws;
    unsigned char* ws = (unsigned char*)d_ws;
    (void)hipMemsetAsync(ws + WS_BAR, 0, BAR_BYTES, stream);
    a.ph_lo = 0; a.ph_hi = PH_N;
    void* kargs[] = {&a};
    hipError_t e = hipLaunchCooperativeKernel((const void*)mega, dim3(grid), dim3(NWAVES * 64), kargs, LDS_BYTES, stream);
    if (e != hipSuccess) fprintf(stderr, "cooperative launch failed: %s (grid %d)\n", hipGetErrorString(e), grid);
}
```

```cpp
#include <hip/hip_runtime.h>
#include <hip/hip_cooperative_groups.h>
#include <cstdio>
#include <cstdint>
namespace cg = cooperative_groups;

constexpr int S = 8192, DM = 2048, AW = 1024, NIN = 11272, DFF = 5632;
constexpr float EPS = 1e-6f;
constexpr float QSCALE = 0.08838834764831845f * 1.4426950408889634f;
constexpr float LOG2E = 1.4426950408889634f;

namespace pg8 {
#define PG8_LAS __attribute__((address_space(3)))
typedef unsigned short bf16_t;
typedef short bf16x8 __attribute__((ext_vector_type(8)));
typedef float f32x4 __attribute__((ext_vector_type(4)));
typedef unsigned u32x4 __attribute__((ext_vector_type(4)));
constexpr int BM = 256, BK = 64, HALF = 128, HTB = HALF * BK * 2  , STAGE_BYTES = 8 * HTB, NXCD = 8, WGM = 8;

__host__ __device__ __forceinline__ int lds_byte(int r, int c) { const int st = (r >> 4) * 2 + (c >> 5), rr = r & 15, cc = c & 31, ob = rr * 64 + cc * 2; return st * 1024 + (ob ^ (((ob >> 9) & 1) << 5)); }
__host__ __device__ __forceinline__ void stage_rc(int b, int& R, int& C) { const int st = b / 1024, sb = b % 1024, swz = sb ^ (((sb >> 9) & 1) << 5); R = (st >> 1) * 16 + swz / 64; C = (st & 1) * 32 + (swz % 64) / 2; }
__host__ __device__ __forceinline__ int perm32(int rho) { const int n = rho >> 4, i = rho & 15; return 8 * (i >> 2) + 4 * n + (i & 3); }

struct Unit { int pm, pn; };
struct Gemm { const bf16_t* A; const bf16_t* Bt; int M, N, K; };

struct StaticOrder {
    int nM, nN, nwg, G, c;
    __host__ __device__ void init(int M, int N, int G_, int c_) { nM = M / BM; nN = N / BM; nwg = nM * nN; G = G_; c = c_; }
    __host__ __device__ bool next(int i, Unit& u) const {
        const long L = (long)i * G + c; if (L >= nwg) return false;
        int wgid = (int)L; { const int q = nwg / NXCD, r = nwg % NXCD, xcd = wgid % NXCD, off = wgid / NXCD; wgid = (xcd < r ? xcd * (q + 1) : r * (q + 1) + (xcd - r) * q) + off; }
        const int nig = WGM * nN, gid = wgid / nig, fm = gid * WGM, gsz = (nM - fm) < WGM ? (nM - fm) : WGM;
        u.pm = fm + ((wgid % nig) % gsz); u.pn = (wgid % nig) / gsz; return true;
    }
    __device__ __forceinline__ void a_ready(const Unit&) const {}
    __device__ __forceinline__ void done(const Unit&) const {}
};

typedef float f32x2_cv __attribute__((ext_vector_type(2))); typedef __bf16 bf16x2_cv __attribute__((ext_vector_type(2)));
__device__ __forceinline__ unsigned cvt_pk_bf16(float lo, float hi) { f32x2_cv v = {lo, hi}; bf16x2_cv b = __builtin_convertvector(v, bf16x2_cv); return __builtin_bit_cast(unsigned, b); }
typedef unsigned u32x2 __attribute__((ext_vector_type(2)));
__device__ __forceinline__ float bf_lo(unsigned w) { return __uint_as_float(w << 16); }
__device__ __forceinline__ float bf_hi(unsigned w) { return __uint_as_float(w & 0xffff0000u); }
__device__ __forceinline__ float sigmoidf_(float z) { return 1.f / (1.f + __expf(-z)); }

struct EpiProj {
    static constexpr bool PERM = true, AFTER_DRAIN = false, HAS_MID = false;
    bf16_t* proj; float* alf; bf16_t* gab; const float* lb; unsigned* kmax;
    template <int MODE>
    __device__ __forceinline__ void tile(const f32x4 (&acc)[2][2][4][2], bf16_t* base, int ldc, int row0, int col0) const {
        float lbv[2][8];
        if (MODE == 1) {
#pragma unroll
            for (int bj = 0; bj < 2; ++bj)
#pragma unroll
                for (int j = 0; j < 8; ++j) lbv[bj][j] = lb[col0 + bj * HALF + j];
        }
#pragma unroll
        for (int ai = 0; ai < 2; ++ai)
#pragma unroll
            for (int m = 0; m < 4; ++m) {
                const size_t ro = (size_t)(row0 + ai * HALF + m * 16) * ldc + col0;
#pragma unroll
                for (int bj = 0; bj < 2; ++bj) {
                    float v[8];
#pragma unroll
                    for (int j = 0; j < 4; ++j) { v[j] = acc[ai][bj][m][0][j]; v[4 + j] = acc[ai][bj][m][1][j]; }
                    if (MODE == 1) {
                        float lf[8];
#pragma unroll
                        for (int j = 0; j < 8; ++j) {
                            const float z = v[j], l = lbv[bj][j];
                            const float t = __expf(-z), sg = __builtin_amdgcn_rcpf(1.f + t), sn = (t > 3.0e38f) ? 1.f : t * sg;
                            lf[j] = __logf(l + (1.f - l) * sg); v[j] = (1.f - l) * sn;
                        }
                        float* ap = alf + ro + bj * HALF;
                        *(f32x4*)ap = (f32x4){lf[0], lf[1], lf[2], lf[3]}; *(f32x4*)(ap + 4) = (f32x4){lf[4], lf[5], lf[6], lf[7]};
                    } else if (MODE == 2) {
#pragma unroll
                        for (int j = 0; j < 8; ++j) v[j] *= QSCALE;
                    } else if (MODE == 3) {
#pragma unroll
                        for (int j = 0; j < 8; ++j) v[j] = __builtin_amdgcn_rcpf(1.f + __expf(-v[j]));
                    }
                    u32x4 w; w.x = cvt_pk_bf16(v[0], v[1]); w.y = cvt_pk_bf16(v[2], v[3]); w.z = cvt_pk_bf16(v[4], v[5]); w.w = cvt_pk_bf16(v[6], v[7]);
                    *(u32x4*)(base + ro + bj * HALF) = w;
                }
            }
    }
    __device__ __forceinline__ void operator()(const f32x4 (&acc)[2][2][4][2], const Unit& u, int wr, int wc, int fr, int fq) const {
        const int pn = u.pn; const int row0 = u.pm * BM + wr * 64 + fr;
        if (pn < 28) {
            const int grp = pn >> 2; bf16_t* base = proj + (size_t)grp * ((size_t)S * 1024); const int col0 = (pn & 3) * 256 + wc * 32 + 8 * fq;
            if (grp == 1) tile<1>(acc, base, 1024, row0, col0); else if (grp == 4) tile<2>(acc, base, 1024, row0, col0); else tile<0>(acc, base, 1024, row0, col0);
            if (grp == 5) {
                float mx[2] = {0.f, 0.f};
#pragma unroll
                for (int ai = 0; ai < 2; ++ai)
#pragma unroll
                    for (int bj = 0; bj < 2; ++bj)
#pragma unroll
                        for (int m = 0; m < 4; ++m)
#pragma unroll
                            for (int n = 0; n < 2; ++n)
#pragma unroll
                                for (int j = 0; j < 4; ++j) mx[bj] = fmaxf(mx[bj], fabsf(acc[ai][bj][m][n][j]));
#pragma unroll
                for (int bj = 0; bj < 2; ++bj) {
#pragma unroll
                    for (int o = 1; o < 64; o <<= 1) mx[bj] = fmaxf(mx[bj], __shfl_xor(mx[bj], o));
                    if ((fr | (fq << 4)) == 0) __hip_atomic_fetch_max(kmax + 2 * (pn & 3) + bj, __float_as_uint(mx[bj]), __ATOMIC_RELAXED, __HIP_MEMORY_SCOPE_AGENT);
                }
            }
        } else {
            const int q = pn - 28; bf16_t* base = gab + (size_t)(q >> 3) * ((size_t)S * 2048); const int col0 = (q & 7) * 256 + wc * 32 + 8 * fq;
            tile<3>(acc, base, 2048, row0, col0);
        }
    }
};
struct EpiUp {
    static constexpr bool PERM = true, AFTER_DRAIN = false, HAS_MID = true;
    const bf16_t* ga; const bf16_t* gb; bf16_t* mg;
    __device__ __forceinline__ void mid(f32x4 (&acc)[2][2][4][2], const Unit& u, int wr, int wc, int fr, int fq) const {
        asm volatile("" : "+v"(fr), "+v"(fq));
        const int row0 = u.pm * BM + wr * 64 + fr, col0 = u.pn * BM + wc * 32 + 8 * fq;
#pragma unroll
        for (int ai = 0; ai < 2; ++ai) {
            u32x4 av[4][2], bv[4][2];
#pragma unroll
            for (int m = 0; m < 4; ++m)
#pragma unroll
                for (int bj = 0; bj < 2; ++bj) { const size_t ro = (size_t)(row0 + ai * HALF + m * 16) * DM + col0 + bj * HALF; av[m][bj] = *(const u32x4*)(ga + ro); bv[m][bj] = *(const u32x4*)(gb + ro); }
#pragma unroll
            for (int m = 0; m < 4; ++m)
#pragma unroll
                for (int bj = 0; bj < 2; ++bj) {
#pragma unroll
                    for (int q = 0; q < 4; ++q) { const unsigned aw = av[m][bj][q], bw = bv[m][bj][q];
                        const float r0 = bf_lo(aw) * __builtin_amdgcn_rcpf(fmaxf(bf_lo(bw), 1e-30f)), r1 = bf_hi(aw) * __builtin_amdgcn_rcpf(fmaxf(bf_hi(bw), 1e-30f));
                        acc[ai][bj][m][q >> 1][2 * (q & 1)] *= r0; acc[ai][bj][m][q >> 1][2 * (q & 1) + 1] *= r1; } }
            asm volatile("" ::: "memory");
        }
    }
    __device__ __forceinline__ void operator()(const f32x4 (&acc)[2][2][4][2], const Unit& u, int wr, int wc, int fr, int fq) const {
        const int row0 = u.pm * BM + wr * 64 + fr, col0 = u.pn * BM + wc * 32 + 8 * fq;
#pragma unroll
        for (int ai = 0; ai < 2; ++ai) {
            u32x4 gv[4][2];
#pragma unroll
            for (int m = 0; m < 4; ++m)
#pragma unroll
                for (int bj = 0; bj < 2; ++bj) gv[m][bj] = *(const u32x4*)(gb + (size_t)(row0 + ai * HALF + m * 16) * DM + col0 + bj * HALF);
#pragma unroll
            for (int m = 0; m < 4; ++m)
#pragma unroll
                for (int bj = 0; bj < 2; ++bj) { const size_t ro = (size_t)(row0 + ai * HALF + m * 16) * DM + col0 + bj * HALF;
                    const u32x4 gq = gv[m][bj];
                    float v[8];
#pragma unroll
                    for (int j = 0; j < 4; ++j) { v[j] = acc[ai][bj][m][0][j]; v[4 + j] = acc[ai][bj][m][1][j]; }
                    v[0] *= bf_lo(gq.x); v[1] *= bf_hi(gq.x); v[2] *= bf_lo(gq.y); v[3] *= bf_hi(gq.y); v[4] *= bf_lo(gq.z); v[5] *= bf_hi(gq.z); v[6] *= bf_lo(gq.w); v[7] *= bf_hi(gq.w);
                    u32x4 w; w.x = cvt_pk_bf16(v[0], v[1]); w.y = cvt_pk_bf16(v[2], v[3]); w.z = cvt_pk_bf16(v[4], v[5]); w.w = cvt_pk_bf16(v[6], v[7]);
                    *(u32x4*)(mg + ro) = w; }
        }
    }
};
struct EpiT16 {
    static constexpr bool PERM = true, AFTER_DRAIN = false, HAS_MID = false;
    bf16_t* O;
    __device__ __forceinline__ void operator()(const f32x4 (&acc)[2][2][4][2], const Unit& u, int wr, int wc, int fr, int fq) const {
        const int row0 = u.pm * BM + wr * 64 + fr, col0 = u.pn * BM + wc * 32 + 8 * fq;
#pragma unroll
        for (int ai = 0; ai < 2; ++ai)
#pragma unroll
            for (int m = 0; m < 4; ++m)
#pragma unroll
                for (int bj = 0; bj < 2; ++bj) { const f32x4 v0 = acc[ai][bj][m][0], v1 = acc[ai][bj][m][1];
                    u32x4 w; w.x = cvt_pk_bf16(v0[0], v0[1]); w.y = cvt_pk_bf16(v0[2], v0[3]); w.z = cvt_pk_bf16(v1[0], v1[1]); w.w = cvt_pk_bf16(v1[2], v1[3]);
                    *(u32x4*)(O + (size_t)(row0 + ai * HALF + m * 16) * DM + col0 + bj * HALF) = w; }
    }
};
struct EpiF32 {
    static constexpr bool PERM = false, AFTER_DRAIN = false, HAS_MID = false;
    float* O; int ldc;
    __device__ __forceinline__ void operator()(const f32x4 (&acc)[2][2][4][2], const Unit& u, int wr, int wc, int fr, int fq) const {
        const int row0 = u.pm * BM + wr * 64 + fr, col0 = u.pn * BM + wc * 32 + 4 * fq;
#pragma unroll
        for (int ai = 0; ai < 2; ++ai)
#pragma unroll
            for (int m = 0; m < 4; ++m) {
                float* rp = O + (size_t)(row0 + ai * HALF + m * 16) * ldc + col0;
#pragma unroll
                for (int bj = 0; bj < 2; ++bj)
#pragma unroll
                    for (int n = 0; n < 2; ++n) *(f32x4*)(rp + bj * HALF + n * 16) = acc[ai][bj][m][n];
            }
    }
};
struct EpiSwiglu {
    static constexpr bool PERM = true, AFTER_DRAIN = false, HAS_MID = false;
    bf16_t* hid;
    __device__ __forceinline__ void operator()(const f32x4 (&acc)[2][2][4][2], const Unit& u, int wr, int wc, int fr, int fq) const {
        const int row0 = u.pm * BM + wr * 64 + fr, col0 = u.pn * HALF + wc * 32 + 8 * fq;
#pragma unroll
        for (int ai = 0; ai < 2; ++ai)
#pragma unroll
            for (int m = 0; m < 4; ++m) {
                float v[8];
#pragma unroll
                for (int j = 0; j < 4; ++j) { const float g0 = acc[ai][0][m][0][j], g1 = acc[ai][0][m][1][j];
                    v[j] = g0 / (1.f + __expf(-g0)) * acc[ai][1][m][0][j]; v[4 + j] = g1 / (1.f + __expf(-g1)) * acc[ai][1][m][1][j]; }
                u32x4 w; w.x = cvt_pk_bf16(v[0], v[1]); w.y = cvt_pk_bf16(v[2], v[3]); w.z = cvt_pk_bf16(v[4], v[5]); w.w = cvt_pk_bf16(v[6], v[7]);
                *(u32x4*)(hid + (size_t)(row0 + ai * HALF + m * 16) * DFF + col0) = w;
            }
    }
};

template <class Epi, class Sched, bool ALIGN_EPI = false, bool SP2 = false>
__device__ __forceinline__ void gemm_phase(PG8_LAS unsigned char* lds, const Gemm g, const Sched& S, const Epi& E) {
    const int tid = threadIdx.x, wid = __builtin_amdgcn_readfirstlane(tid >> 6), lane = tid & 63, wr = wid >> 2, wc = wid & 3, fr = lane & 15, fq = lane >> 4;
    const int K = g.K, nt = K / BK;
    unsigned voffA[2], voffB[2];
#pragma unroll
    for (int i = 0; i < 2; ++i) { int R, C; stage_rc(tid * 16 + i * 8192, R, C); const int Rb = Epi::PERM ? ((R & ~31) + perm32(R & 31)) : R;
        voffA[i] = (unsigned)(R * K + C) * 2u; voffB[i] = (unsigned)(Rb * K + C) * 2u; }
    const size_t kstep = (size_t)(BK * 2);
    const size_t hstep = (size_t)HALF * K * 2;
    const size_t tstep = 2 * hstep;
    const unsigned ldsw = (unsigned)wid * 1024u;
    const int aoff = lds_byte(wr * 64 + fr, fq * 8), boff = lds_byte(wc * 32 + fr, fq * 8);
#define PG8_SA(b, h) (((b) * 2 + (h)) * HTB)
#define PG8_SB(b, h) ((4 + (b) * 2 + (h)) * HTB)
#define PG8_STAGE(bufoff, gbase, voff) do { _Pragma("unroll") for (int _i = 0; _i < 2; ++_i) \
        __builtin_amdgcn_global_load_lds((const unsigned*)((const char*)(gbase) + (voff)[_i]), (PG8_LAS unsigned*)(lds + (bufoff) + ldsw + _i * 8192), 16, 0, 0); } while (0)
#define PG8_LDA(dst, b, h) do { _Pragma("unroll") for (int m = 0; m < 4; ++m) _Pragma("unroll") for (int k = 0; k < 2; ++k) dst[m][k] = *(const PG8_LAS bf16x8*)(lds + PG8_SA(b, h) + aoff + m * 2048 + k * 1024); } while (0)
#define PG8_LDB(dst, b, h) do { _Pragma("unroll") for (int n = 0; n < 2; ++n) _Pragma("unroll") for (int k = 0; k < 2; ++k) dst[n][k] = *(const PG8_LAS bf16x8*)(lds + PG8_SB(b, h) + boff + n * 2048 + k * 1024); } while (0)
#define PG8_MMA(ai, bj, At, Bt) do { __builtin_amdgcn_s_setprio(1); _Pragma("unroll") for (int m = 0; m < 4; ++m) _Pragma("unroll") for (int n = 0; n < 2; ++n) _Pragma("unroll") for (int k = 0; k < 2; ++k) \
        acc[ai][bj][m][n] = __builtin_amdgcn_mfma_f32_16x16x32_bf16(Bt[n][k], At[m][k], acc[ai][bj][m][n], 0, 0, 0); __builtin_amdgcn_s_setprio(0); } while (0)
#define PG8_WAIT_V(n) asm volatile("s_waitcnt vmcnt(" #n ")" ::: "memory")
#define PG8_WAIT_L(n) asm volatile("s_waitcnt lgkmcnt(" #n ")" ::: "memory")
#define PG8_BAR __builtin_amdgcn_s_barrier()
#define PG8_SCHED __builtin_amdgcn_sched_barrier(0)
    Unit cur, nxt; int ui = 0;
    if (!S.next(0, cur)) return;
    f32x4 acc[2][2][4][2];
#pragma unroll
    for (int a = 0; a < 2; ++a)
#pragma unroll
        for (int b = 0; b < 2; ++b)
#pragma unroll
            for (int m = 0; m < 4; ++m)
#pragma unroll
                for (int n = 0; n < 2; ++n) acc[a][b][m][n] = (f32x4){0.f, 0.f, 0.f, 0.f};
    bf16x8 At[4][2], B0[2][2], B1[2][2];
    const char* cA = (const char*)g.A + (size_t)cur.pm * tstep; const char* cB = (const char*)g.Bt + (size_t)cur.pn * tstep;
    S.a_ready(cur);
    if constexpr (SP2) {
        PG8_STAGE(PG8_SB(0, 0), cB, voffB); PG8_STAGE(PG8_SB(0, 1), cB + hstep, voffB); PG8_STAGE(PG8_SA(0, 0), cA, voffA); PG8_STAGE(PG8_SA(0, 1), cA + hstep, voffA);
        if (wr == 1) PG8_BAR;
        PG8_WAIT_V(2); PG8_BAR;
        PG8_STAGE(PG8_SB(1, 0), cB + kstep, voffB); PG8_STAGE(PG8_SA(1, 0), cA + kstep, voffA); PG8_STAGE(PG8_SB(1, 1), cB + hstep + kstep, voffB);
        PG8_WAIT_V(6); PG8_BAR;
    } else {
        PG8_STAGE(PG8_SB(0, 0), cB, voffB); PG8_STAGE(PG8_SA(0, 0), cA, voffA); PG8_STAGE(PG8_SB(0, 1), cB + hstep, voffB); PG8_STAGE(PG8_SA(0, 1), cA + hstep, voffA);
        if (wr == 1) PG8_BAR;
        PG8_WAIT_V(4); PG8_BAR;
        PG8_STAGE(PG8_SB(1, 0), cB + kstep, voffB); PG8_STAGE(PG8_SA(1, 0), cA + kstep, voffA); PG8_STAGE(PG8_SB(1, 1), cB + hstep + kstep, voffB);
        PG8_WAIT_V(6); PG8_BAR;
    }
    for (;;) {
        const bool has_next = S.next(ui + 1, nxt);
        const char* nA = has_next ? (const char*)g.A + (size_t)nxt.pm * tstep : cA; const char* nB = has_next ? (const char*)g.Bt + (size_t)nxt.pn * tstep : cB;
        for (int t = 0; t < nt; t += 2) {
            if constexpr (Epi::HAS_MID) { if (t == (nt >> 1)) E.mid(acc, cur, wr, wc, fr, fq); }
            const bool last = (t == nt - 2);
            const char* a1 = cA + (size_t)(t + 1) * kstep;
            const char* a2 = last ? nA : cA + (size_t)(t + 2) * kstep; const char* b2 = last ? nB : cB + (size_t)(t + 2) * kstep;
            const char* a3 = a2 + kstep; const char* b3 = b2 + kstep;
            if (last && has_next) S.a_ready(nxt);
            if constexpr (SP2) {
            PG8_LDB(B0, 0, 0); PG8_LDB(B1, 0, 1); PG8_SCHED; PG8_LDA(At, 0, 0); PG8_STAGE(PG8_SA(1, 1), a1 + hstep, voffA);
            PG8_WAIT_V(8); PG8_WAIT_L(0); PG8_BAR; PG8_MMA(0, 0, At, B0); PG8_MMA(0, 1, At, B1); PG8_BAR; PG8_SCHED;
            PG8_LDA(At, 0, 1); PG8_STAGE(PG8_SB(0, 0), b2, voffB); PG8_STAGE(PG8_SB(0, 1), b2 + hstep, voffB); PG8_STAGE(PG8_SA(0, 0), a2, voffA);
            PG8_WAIT_V(8); PG8_WAIT_L(0); PG8_BAR; PG8_MMA(1, 0, At, B0); PG8_MMA(1, 1, At, B1); PG8_BAR; PG8_SCHED;
            PG8_LDB(B0, 1, 0); PG8_LDB(B1, 1, 1); PG8_SCHED; PG8_LDA(At, 1, 0); PG8_STAGE(PG8_SA(0, 1), a2 + hstep, voffA);
            PG8_WAIT_V(8); PG8_WAIT_L(0); PG8_BAR; PG8_MMA(0, 0, At, B0); PG8_MMA(0, 1, At, B1); PG8_BAR; PG8_SCHED;
            PG8_LDA(At, 1, 1); PG8_STAGE(PG8_SB(1, 0), b3, voffB); PG8_STAGE(PG8_SB(1, 1), b3 + hstep, voffB); PG8_STAGE(PG8_SA(1, 0), a3, voffA);
            PG8_WAIT_V(8); PG8_WAIT_L(0); PG8_BAR; PG8_MMA(1, 0, At, B0); PG8_MMA(1, 1, At, B1); PG8_BAR; PG8_SCHED;
            } else {
            PG8_LDB(B0, 0, 0); PG8_SCHED; PG8_LDA(At, 0, 0); PG8_STAGE(PG8_SA(1, 1), a1 + hstep, voffA);
            PG8_WAIT_L(8); PG8_BAR; PG8_WAIT_L(0); PG8_MMA(0, 0, At, B0); PG8_BAR; PG8_SCHED;
            PG8_LDB(B1, 0, 1); PG8_STAGE(PG8_SB(0, 0), b2, voffB);
            PG8_BAR; PG8_WAIT_L(0); PG8_MMA(0, 1, At, B1); PG8_BAR;
            PG8_LDA(At, 0, 1); PG8_STAGE(PG8_SA(0, 0), a2, voffA);
            PG8_BAR; PG8_WAIT_L(0); PG8_MMA(1, 0, At, B0); PG8_BAR; PG8_SCHED;
            PG8_STAGE(PG8_SB(0, 1), b2 + hstep, voffB);
            PG8_WAIT_V(6); PG8_BAR; PG8_MMA(1, 1, At, B1); PG8_BAR;
            PG8_LDB(B0, 1, 0); PG8_SCHED; PG8_LDA(At, 1, 0); PG8_STAGE(PG8_SA(0, 1), a2 + hstep, voffA);
            PG8_WAIT_L(8); PG8_BAR; PG8_WAIT_L(0); PG8_MMA(0, 0, At, B0); PG8_BAR; PG8_SCHED;
            PG8_LDB(B1, 1, 1); PG8_STAGE(PG8_SB(1, 0), b3, voffB);
            PG8_BAR; PG8_WAIT_L(0); PG8_MMA(0, 1, At, B1); PG8_BAR;
            PG8_LDA(At, 1, 1); PG8_STAGE(PG8_SA(1, 0), a3, voffA);
            PG8_BAR; PG8_WAIT_L(0); PG8_MMA(1, 0, At, B0); PG8_BAR; PG8_SCHED;
            PG8_STAGE(PG8_SB(1, 1), b3 + hstep, voffB);
            PG8_WAIT_V(6); PG8_BAR; PG8_MMA(1, 1, At, B1); PG8_BAR;
            }
        }
        if constexpr (ALIGN_EPI) { if (wr == 0) PG8_BAR; }
        if constexpr (!Epi::AFTER_DRAIN) { E(acc, cur, wr, wc, fr, fq); S.done(cur); }
        if (!has_next) break;
#pragma unroll
        for (int a = 0; a < 2; ++a)
#pragma unroll
            for (int b = 0; b < 2; ++b)
#pragma unroll
                for (int m = 0; m < 4; ++m)
#pragma unroll
                    for (int n = 0; n < 2; ++n) acc[a][b][m][n] = (f32x4){0.f, 0.f, 0.f, 0.f};
        cur = nxt; cA = nA; cB = nB; ++ui;
        if constexpr (ALIGN_EPI) { if (wr == 1) PG8_BAR; }
    }
    PG8_WAIT_V(0);
    if constexpr (!ALIGN_EPI) { if (wr == 0) PG8_BAR; }
    PG8_BAR;
    if constexpr (Epi::AFTER_DRAIN) { E.fused(acc, cur, wr, wc, fr, fq, lds, wid, lane); S.done(cur); }
#undef PG8_SA
#undef PG8_SB
#undef PG8_STAGE
#undef PG8_LDA
#undef PG8_LDB
#undef PG8_MMA
#undef PG8_WAIT_V
#undef PG8_WAIT_L
#undef PG8_BAR
#undef PG8_SCHED
}
}

#include <hip/hip_bf16.h>
namespace fox {
constexpr int D = 128, PITCH = 1024, OPITCH = 2048;
constexpr float THR2 = 11.5f, LOG2E_ = 1.4426950408889634f;
constexpr bool WSKIP = false;
constexpr int NW = 8, QBLK = 32, KVBLK = 64, QB = NW * QBLK;
constexpr int SHM_V = KVBLK * D * 2, SHM_K = KVBLK * D * 2;
constexpr int LDS_BYTES = 2 * SHM_V + 2 * SHM_K + NW * 64 * 4;

using bf16 = __hip_bfloat16;
typedef short bf16x8 __attribute__((ext_vector_type(8)));
typedef short s16x4 __attribute__((ext_vector_type(4)));
typedef float f32x16 __attribute__((ext_vector_type(16)));
typedef float f32x4 __attribute__((ext_vector_type(4)));
typedef unsigned u32x4 __attribute__((ext_vector_type(4)));
template <class A, class Bt> struct same_t { static constexpr bool v = false; };
template <class A> struct same_t<A, A> { static constexpr bool v = true; };

#define KSWZ(row, colB) ((row) * 256 + ((colB) ^ (((row) & 7) << 4)))
#define SBAR() __builtin_amdgcn_sched_barrier(0)
__device__ __forceinline__ int v_st(int k, int c) { const int kk = (k & ~0xC) | ((k & 4) << 1) | ((k & 8) >> 1); return ((kk >> 3) * 4 + (c >> 5)) * 512 + ((kk & 7) * 32 + (c & 31)) * 2; }
__device__ __forceinline__ int v_rd_base(int lane) { return ((lane & 3) << 3) | (((lane >> 2) & 3) << 6) | (((lane >> 4) & 1) << 5) | (((lane >> 5) & 1) << 8); }
constexpr int v_rd_off(int d0, int ks, int half) { return d0 * 512 + ks * 4096 + half * 2048; }
__device__ __forceinline__ int crow(int r, int hi) { return (r & 3) + 8 * (r >> 2) + 4 * hi; }
__device__ __forceinline__ unsigned cvtpk(float lo, float hi) {
    unsigned r; asm volatile("v_cvt_pk_bf16_f32 %0, %1, %2" : "=v"(r) : "v"(lo), "v"(hi)); return r;
}
__device__ __forceinline__ bf16x8 pack8(f32x4 a, f32x4 b) {
    u32x4 w = {cvtpk(a[0], a[1]), cvtpk(a[2], a[3]), cvtpk(b[0], b[1]), cvtpk(b[2], b[3])};
    return *reinterpret_cast<bf16x8*>(&w);
}
template <class T> __device__ __forceinline__ bf16x8 load8(const T* p) {
    if constexpr (same_t<T, float>::v) { return pack8(*(const f32x4*)p, *(const f32x4*)(p + 4)); }
    else { return *reinterpret_cast<const bf16x8*>(p); }
}
__device__ __forceinline__ void mask_tile(f32x16& p0, f32x16& p1, int dq, unsigned W) {
    const float NEG = -__builtin_inff();
#pragma unroll
    for (int r = 0; r < 16; ++r) {
        const int c = (r & 3) + 8 * (r >> 2);
        if ((unsigned)(dq - c) >= W) p0[r] = NEG;
        if ((unsigned)(dq - c - 32) >= W) p1[r] = NEG;
    }
}
__device__ __forceinline__ void partialSM(f32x16& p0, f32x16& p1, float& m_reg, float& mn, float& alpha, const __attribute__((address_space(3))) float* cbt) {
    SBAR();
#pragma unroll
    for (int g = 0; g < 4; ++g) { const f32x4 b0 = *(const __attribute__((address_space(3))) f32x4*)(cbt + 8 * g), b1 = *(const __attribute__((address_space(3))) f32x4*)(cbt + 32 + 8 * g);
        p0[4 * g] += b0[0]; p0[4 * g + 1] += b0[1]; p0[4 * g + 2] += b0[2]; p0[4 * g + 3] += b0[3];
        p1[4 * g] += b1[0]; p1[4 * g + 1] += b1[1]; p1[4 * g + 2] += b1[2]; p1[4 * g + 3] += b1[3]; }
    float pmax = p0[0]; for (int r = 1; r < 16; ++r) pmax = fmaxf(pmax, p0[r]); for (int r = 0; r < 16; ++r) pmax = fmaxf(pmax, p1[r]);
    { auto rr = __builtin_amdgcn_permlane32_swap(__float_as_uint(pmax), __float_as_uint(pmax), false, false);
      pmax = fmaxf(__uint_as_float(rr[0]), __uint_as_float(rr[1])); }
    if (__builtin_expect(__all((pmax - m_reg) <= THR2), 1)) { mn = m_reg; alpha = 1.f; }
    else { mn = fmaxf(m_reg, pmax); alpha = __builtin_amdgcn_exp2f(m_reg - mn); m_reg = mn; }
    for (int r = 0; r < 16; ++r) p0[r] = p0[r] - mn; for (int r = 0; r < 16; ++r) p1[r] = p1[r] - mn;
    for (int r = 0; r < 16; ++r) p0[r] = __builtin_amdgcn_exp2f(p0[r]);
}
__device__ __forceinline__ void finishSM(f32x16& p0, f32x16& p1, float alpha, float& l_reg, bf16x8& pa0, bf16x8& pa1, bf16x8& pa2, bf16x8& pa3) {
    for (int r = 0; r < 16; ++r) p1[r] = __builtin_amdgcn_exp2f(p1[r]);
    float ps = 0; for (int r = 0; r < 16; ++r) ps += p0[r]; for (int r = 0; r < 16; ++r) ps += p1[r];
    { auto rr = __builtin_amdgcn_permlane32_swap(__float_as_uint(ps), __float_as_uint(ps), false, false);
      ps = __uint_as_float(rr[0]) + __uint_as_float(rr[1]); }
    l_reg = l_reg * alpha + ps;
#define PK4(P, B_, OUT) do { unsigned a0 = cvtpk(P[B_+0], P[B_+1]), a1 = cvtpk(P[B_+2], P[B_+3]);                          \
        unsigned b0 = cvtpk(P[B_+4], P[B_+5]), b1 = cvtpk(P[B_+6], P[B_+7]);                                             \
        auto r0 = __builtin_amdgcn_permlane32_swap(a0, b0, false, false); auto r1 = __builtin_amdgcn_permlane32_swap(a1, b1, false, false); \
        u32x4 w = {r0[0], r1[0], r0[1], r1[1]}; OUT = *reinterpret_cast<bf16x8*>(&w); } while (0)
    PK4(p0, 0, pa0); PK4(p0, 8, pa1); PK4(p1, 0, pa2); PK4(p1, 8, pa3);
#undef PK4
}
template <int KB, bool SK>
__device__ __forceinline__ void qkt(f32x16& p0, f32x16& p1, const char* K_lds, int r32, int hi, const bf16x8* qr, bool act) {
    if (SK && !act) { const float NEG = -__builtin_inff();
#pragma unroll
        for (int r = 0; r < 16; ++r) { p0[r] = NEG; p1[r] = NEG; } return; }
    p0 = f32x16{}; p1 = f32x16{};
    const char* kb[4];
#pragma unroll
    for (int dd = 0; dd < 4; ++dd) kb[dd] = K_lds + KB * SHM_K + KSWZ(r32, (dd * 16 + hi * 8) * 2);
#pragma unroll
    for (int d0 = 0; d0 < 8; ++d0) { const char* a = kb[d0 & 3] + (d0 >> 2) * 128;
        bf16x8 b0 = *reinterpret_cast<const bf16x8*>(a);
        bf16x8 b1 = *reinterpret_cast<const bf16x8*>(a + 32 * 256);
        p0 = __builtin_amdgcn_mfma_f32_32x32x16_bf16(b0, qr[d0], p0, 0, 0, 0);
        p1 = __builtin_amdgcn_mfma_f32_32x32x16_bf16(b1, qr[d0], p1, 0, 0, 0); }
}
template <int VB, bool SK>
__device__ __forceinline__ void pv_tile(f32x16* o, int vb0, bf16x8 pa0, bf16x8 pa1, bf16x8 pa2, bf16x8 pa3, bool act) {
    if (SK && !act) return;
#define TRRD(dst, off) asm volatile("ds_read_b64_tr_b16 %0, %1 offset:%2" : "=&v"(dst) : "v"(vb0), "i"(off) : "memory")
#define PV_D0(d0) do { s16x4 l0, l1, l2, l3, h0, h1, h2, h3; constexpr int b_ = VB * SHM_V + v_rd_off(d0, 0, 0);     \
        TRRD(l0, b_); TRRD(h0, b_ + 2048); TRRD(l1, b_ + 4096); TRRD(h1, b_ + 6144); TRRD(l2, b_ + 8192); TRRD(h2, b_ + 10240); TRRD(l3, b_ + 12288); TRRD(h3, b_ + 14336); \
        asm volatile("s_waitcnt lgkmcnt(0)" ::: "memory"); SBAR();                 \
        o[d0] = __builtin_amdgcn_mfma_f32_32x32x16_bf16(pa0, (bf16x8){l0[0], l0[1], l0[2], l0[3], h0[0], h0[1], h0[2], h0[3]}, o[d0], 0, 0, 0);   \
        o[d0] = __builtin_amdgcn_mfma_f32_32x32x16_bf16(pa1, (bf16x8){l1[0], l1[1], l1[2], l1[3], h1[0], h1[1], h1[2], h1[3]}, o[d0], 0, 0, 0);   \
        o[d0] = __builtin_amdgcn_mfma_f32_32x32x16_bf16(pa2, (bf16x8){l2[0], l2[1], l2[2], l2[3], h2[0], h2[1], h2[2], h2[3]}, o[d0], 0, 0, 0);   \
        o[d0] = __builtin_amdgcn_mfma_f32_32x32x16_bf16(pa3, (bf16x8){l3[0], l3[1], l3[2], l3[3], h3[0], h3[1], h3[2], h3[3]}, o[d0], 0, 0, 0); } while (0)
    PV_D0(0); PV_D0(1); PV_D0(2); PV_D0(3);
#undef PV_D0
#undef TRRD
}

template <class TIn, class TOut> struct BlockRef { const TIn* Q; const TIn* K; const TIn* V; TOut* O; const float* C; int P0; int JLO; };
template <class TIn> struct Seam {
    bf16x8 qr[8];
    bf16x8 st_v0, st_v1, st_k0, st_k1; f32x4 sf0, sf1, sf2, sf3;
    f32x4 tq[16];
};
__device__ __forceinline__ int swa_jlo(int P0, int W) { const int lowk = P0 - W + 1; return lowk > 0 ? lowk / KVBLK : 0; }
#define ROW(p, k0, rr) ((p) + (size_t)((k0) + (rr)) * PITCH + sc)
#define VMW() asm volatile("s_waitcnt vmcnt(0)" ::: "memory")
#define VMWN(n) asm volatile("s_waitcnt vmcnt(%0)" :: "i"(n) : "memory")
#define SLOAD_H(Kp, Vp, k0) do { S.st_v0 = load8<TIn>(ROW(Vp, k0, sr)); S.st_v1 = load8<TIn>(ROW(Vp, k0, 32 + sr));              \
                         S.st_k0 = load8<TIn>(ROW(Kp, k0, sr)); S.st_k1 = load8<TIn>(ROW(Kp, k0, 32 + sr)); } while (0)
#define SWRITE_HK(bf) do { *(bf16x8*)(K_lds + (bf) * SHM_K + kws) = S.st_k0; *(bf16x8*)(K_lds + (bf) * SHM_K + kws + 32 * 256) = S.st_k1; } while (0)
#define SWRITE_HV(bf) do { *(bf16x8*)(V_lds + (bf) * SHM_V + vst0) = S.st_v0; *(bf16x8*)(V_lds + (bf) * SHM_V + vst1) = S.st_v1; } while (0)
#define SWRITE_H(bf) do { SWRITE_HV(bf); SWRITE_HK(bf); } while (0)
#define SLOAD_F(p, k0) do { S.sf0 = *(const f32x4*)ROW(p, k0, sr); S.sf1 = *(const f32x4*)(ROW(p, k0, sr) + 4);                \
                            S.sf2 = *(const f32x4*)ROW(p, k0, 32 + sr); S.sf3 = *(const f32x4*)(ROW(p, k0, 32 + sr) + 4); } while (0)
#define SWRITE_KF(bf) do { *(bf16x8*)(K_lds + (bf) * SHM_K + kws) = pack8(S.sf0, S.sf1); *(bf16x8*)(K_lds + (bf) * SHM_K + kws + 32 * 256) = pack8(S.sf2, S.sf3); } while (0)
#define SWRITE_VF(bf) do { *(bf16x8*)(V_lds + (bf) * SHM_V + vst0) = pack8(S.sf0, S.sf1); *(bf16x8*)(V_lds + (bf) * SHM_V + vst1) = pack8(S.sf2, S.sf3); } while (0)
template <class TIn, class TOut>
__device__ __forceinline__ void causal_swa_prime(const BlockRef<TIn, TOut>& cur, int W, char* lds, Seam<TIn>& S) {
    constexpr bool F32 = same_t<TIn, float>::v;
    const int tid = threadIdx.x, wid = __builtin_amdgcn_readfirstlane(tid >> 6), lane = tid & 63, r32 = lane & 31, hi = lane >> 5;
    const int sr = tid >> 4, sc = (tid & 15) * 8, kws = KSWZ(sr, sc * 2); char* K_lds = lds + 2 * SHM_V;
    const int kb0 = cur.JLO * KVBLK;
    for (int d0 = 0; d0 < 8; ++d0) S.qr[d0] = load8<TIn>(cur.Q + (size_t)(wid * QBLK + r32) * PITCH + d0 * 16 + hi * 8);
    if constexpr (F32) { SLOAD_F((const float*)cur.K, kb0); VMW(); SWRITE_KF(0); SBAR(); SLOAD_F((const float*)cur.V, kb0); }
    else { SLOAD_H(cur.K, cur.V, kb0); VMW(); SWRITE_HK(0); }
    __syncthreads();
}
template <class TIn, class TOut>
__device__ __forceinline__ void causal_swa_block(const BlockRef<TIn, TOut>& cur, const BlockRef<TIn, TOut>& nxt, int skv, int W, char* lds, Seam<TIn>& S) {
    constexpr bool F32 = same_t<TIn, float>::v;
    const int tid = threadIdx.x, wid = __builtin_amdgcn_readfirstlane(tid >> 6), lane = tid & 63, r32 = lane & 31, hi = lane >> 5;
    const int j_lo = cur.JLO;
    int j_hi = (cur.P0 + QB - 1) / KVBLK + 1; if (j_hi > skv / KVBLK) j_hi = skv / KVBLK;
    const int NT = j_hi - j_lo;
    const int kbn = nxt.JLO * KVBLK;
    const int qlo = cur.P0 + wid * QBLK, qm = qlo + r32 - 4 * hi;
    char* V_lds = lds; char* K_lds = lds + 2 * SHM_V;
    float* ws = (float*)(lds + 2 * SHM_V + 2 * SHM_K) + wid * 64; float* li_l = ws, * al_l = ws + 32;
    __attribute__((address_space(3))) float* cb = (__attribute__((address_space(3))) float*)(lds + LDS_BYTES);
    { const float cref = cur.C[cur.P0]; const int nk = j_hi * KVBLK; int tq = tid * 4; asm volatile("" : "+v"(tq));
      for (int k = j_lo * KVBLK + tq; k < nk; k += 2048) { const f32x4 c4 = *(const f32x4*)(cur.C + k); *(__attribute__((address_space(3))) f32x4*)(cb + k) = (f32x4){(cref - c4[0]) * LOG2E_, (cref - c4[1]) * LOG2E_, (cref - c4[2]) * LOG2E_, (cref - c4[3]) * LOG2E_}; } }
    __syncthreads();
    const __attribute__((address_space(3))) float* cbh = cb + 4 * hi;
    float m_reg = -1e30f, l_reg = 0; f32x16 o[4] = {};
    const int sr = tid >> 4, sc = (tid & 15) * 8, vst0 = v_st(sr, sc), vst1 = v_st(32 + sr, sc), kws = KSWZ(sr, sc * 2);
    const int vb0 = (int)(uintptr_t)V_lds + v_rd_base(lane);
    const TIn* Kh = cur.K; const TIn* Vh = cur.V;
#define RESC(a) do { if (__any((a) < 1.f)) { if (hi == 0) al_l[r32] = (a); asm volatile("s_waitcnt lgkmcnt(0)" ::: "memory");              \
                     for (int d_ = 0; d_ < 4; ++d_) for (int r = 0; r < 16; ++r) o[d_][r] *= al_l[crow(r, hi)]; } } while (0)
#define KBASE(t) ((j_lo + (t)) * KVBLK)
#define ACT(t) (KBASE(t) <= qlo + QBLK - 1 && KBASE(t) + KVBLK - 1 >= qlo - W + 1)
#define MASKT(P0_, P1_, t) do { const int kb_ = KBASE(t); if ((!SK || ACT(t)) && (kb_ + KVBLK - 1 > qlo || kb_ <= qlo + QBLK - 1 - W)) mask_tile(P0_, P1_, qm - kb_, (unsigned)W); } while (0)
    constexpr int NQL = F32 ? 16 : 8;
    constexpr bool SK = WSKIP && !F32;
#define SEAM_K0() do { VMWN(NQL); if constexpr (F32) { SWRITE_KF(0); SBAR(); SLOAD_F((const float*)nxt.V, kbn); } else { SWRITE_HK(0); } SBAR(); } while (0)
    f32x16 pA0, pA1, pB0, pB1; float mnA, mnB, alA, alB; bf16x8 pa0, pa1, pa2, pa3;
    if constexpr (F32) { VMW(); SWRITE_VF(0); SBAR(); } else { SWRITE_HV(0); SBAR(); }
    if (NT > 1) { if constexpr (F32) SLOAD_F((const float*)Kh, KBASE(1)); else SLOAD_H(Kh, Vh, KBASE(1)); }
    SBAR(); qkt<0, SK>(pA0, pA1, K_lds, r32, hi, S.qr, ACT(0));
    if constexpr (F32) { if (NT > 1) { VMW(); SWRITE_KF(1); SBAR(); SLOAD_F((const float*)Vh, KBASE(1)); } }
    MASKT(pA0, pA1, 0); partialSM(pA0, pA1, m_reg, mnA, alA, cbh + KBASE(0));
    if (NT > 1) { VMW(); if constexpr (F32) { SWRITE_VF(1); SBAR(); if (NT > 2) SLOAD_F((const float*)Kh, KBASE(2)); } else SWRITE_H(1); }
    __syncthreads();
#define HALF_STEP(PX0, PX1, mnX, alX, PY0, PY1, alY, t, KB, VB, SB) do {                                                      \
        SBAR(); qkt<KB, SK>(PX0, PX1, K_lds, r32, hi, S.qr, ACT(t));                                             \
        finishSM(PY0, PY1, alY, l_reg, pa0, pa1, pa2, pa3); SBAR();                                                           \
        if ((t) + 1 < NT) { if constexpr (F32) { VMW(); SWRITE_KF(SB); SBAR(); SLOAD_F((const float*)Vh, KBASE((t) + 1)); }  \
                            else { SLOAD_H(Kh, Vh, KBASE((t) + 1)); } SBAR(); }                                               \
        pv_tile<VB, SK>(o, vb0, pa0, pa1, pa2, pa3, ACT((t) - 1)); MASKT(PX0, PX1, (t)); partialSM(PX0, PX1, m_reg, mnX, alX, cbh + KBASE(t));                                        \
        __syncthreads();                                                                                                      \
        if ((t) + 1 < NT) { VMW(); if constexpr (F32) { SWRITE_VF(SB); SBAR(); if ((t) + 2 < NT) SLOAD_F((const float*)Kh, KBASE((t) + 2)); } \
                            else { SWRITE_H(SB); } }                                                                          \
        RESC(alX); __syncthreads(); } while (0)
    for (int t = 1; t + 1 < NT; t += 2) {
        HALF_STEP(pB0, pB1, mnB, alB, pA0, pA1, alA, t, 1, 0, 0);
        HALF_STEP(pA0, pA1, mnA, alA, pB0, pB1, alB, t + 1, 0, 1, 1);
    }
    const bool even = (NT & 1) == 0;
    if (even) { SBAR(); qkt<1, SK>(pB0, pB1, K_lds, r32, hi, S.qr, ACT(NT - 1)); SBAR(); }
#define QROW(e) (nxt.Q + (size_t)(wid * QBLK + r32) * PITCH + ((e) >> 1) * 16 + hi * 8 + ((e) & 1) * 4)
    if constexpr (F32) { SLOAD_F((const float*)nxt.K, kbn); SBAR();
#pragma unroll
        for (int e = 0; e < 8; ++e) S.tq[e] = *(const f32x4*)QROW(e); }
    else { SLOAD_H(nxt.K, nxt.V, kbn); SBAR();
#pragma unroll
        for (int d0 = 0; d0 < 8; ++d0) S.qr[d0] = load8<TIn>(nxt.Q + (size_t)(wid * QBLK + r32) * PITCH + d0 * 16 + hi * 8); }
    SBAR();
    finishSM(pA0, pA1, alA, l_reg, pa0, pa1, pa2, pa3); SBAR();
    if constexpr (F32) {
#pragma unroll
        for (int e = 8; e < 16; ++e) S.tq[e] = *(const f32x4*)QROW(e); SBAR(); }
#undef QROW
    pv_tile<0, SK>(o, vb0, pa0, pa1, pa2, pa3, ACT(even ? NT - 2 : NT - 1));
    if (even) { MASKT(pB0, pB1, NT - 1); partialSM(pB0, pB1, m_reg, mnB, alB, cbh + KBASE(NT - 1)); __syncthreads(); RESC(alB);
        finishSM(pB0, pB1, alB, l_reg, pa0, pa1, pa2, pa3); SBAR(); pv_tile<1, SK>(o, vb0, pa0, pa1, pa2, pa3, ACT(NT - 1)); }
    SBAR(); SEAM_K0();
    if (hi == 0) li_l[r32] = l_reg; asm volatile("s_waitcnt lgkmcnt(0)" ::: "memory");
    float rli[16];
#pragma unroll
    for (int r = 0; r < 16; ++r) rli[r] = __builtin_amdgcn_rcpf(li_l[crow(r, hi)]);
    TOut* Ow = cur.O + (size_t)(wid * QBLK) * OPITCH;
#pragma unroll
    for (int r = 0; r < 16; ++r) { const int orow = crow(r, hi);
#pragma unroll
        for (int d0 = 0; d0 < 4; ++d0) { const float v = o[d0][r] * rli[r];
            if constexpr (same_t<TOut, float>::v) { Ow[(size_t)orow * OPITCH + d0 * 32 + r32] = v; }
            else { const float vn = __shfl_xor(v, 1);
                   if ((r32 & 1) == 0) *(unsigned*)(Ow + (size_t)orow * OPITCH + d0 * 32 + r32) = cvtpk(v, vn); } } }
    if constexpr (F32) {
#pragma unroll
        for (int d0 = 0; d0 < 8; ++d0) S.qr[d0] = pack8(S.tq[2 * d0], S.tq[2 * d0 + 1]); }
    __syncthreads();
#undef RESC
#undef KBASE
#undef ACT
#undef MASKT
#undef SEAM_K0
#undef HALF_STEP
}
#undef ROW
#undef VMW
#undef VMWN
#undef SLOAD_H
#undef SWRITE_HK
#undef SWRITE_HV
#undef SWRITE_H
#undef SLOAD_F
#undef SWRITE_KF
#undef SWRITE_VF

constexpr int FOX_LDS_BYTES = LDS_BYTES + 8192 * 4;
struct AttnT { const bf16* BQ; const bf16* BK; const bf16* BV; bf16* OB; const float* CUM; const unsigned* KMAX; };
__device__ __forceinline__ BlockRef<bf16, bf16> fox_ref(const AttnT& T, int L_, int pass, int jlo) {
    constexpr int NQB = 8192 / QB;
    const int h = L_ % 8, qb = NQB - 1 - L_ / 8; BlockRef<bf16, bf16> r; (void)pass;
    r.Q = T.BQ + (size_t)qb * QB * PITCH + h * D; r.O = T.OB + (size_t)qb * QB * OPITCH + h * D; r.K = T.BK + h * D; r.V = T.BV + h * D; r.C = T.CUM + (size_t)h * 8192; r.P0 = qb * QB; r.JLO = jlo; return r;
}
constexpr float PRUNE_T2 = 40.f;
__device__ __forceinline__ int fox_jlo(const AttnT& T, int L_, int pass, char* lds) {
    constexpr int NQB = 8192 / QB;
    int tid = threadIdx.x; asm volatile("" : "+v"(tid));
    const int lane = tid & 63, wid = tid >> 6; (void)pass;
    const int h = L_ % 8, qb = NQB - 1 - L_ / 8, P0 = qb * QB;
    float* red = (float*)(lds + LDS_BYTES + 8192 * 4);
    { const bf16* qp = T.BQ + (size_t)(P0 + (tid >> 1)) * PITCH + h * D + (tid & 1) * 64; float s = 0.f;
#pragma unroll
      for (int i = 0; i < 8; ++i) { const u32x4 v = *(const u32x4*)(qp + 8 * i);
#pragma unroll
          for (int j = 0; j < 4; ++j) s += fabsf(__uint_as_float(v[j] << 16)) + fabsf(__uint_as_float(v[j] & 0xffff0000u)); }
      s += __shfl_xor(s, 1);
#pragma unroll
      for (int o = 2; o < 64; o <<= 1) s = fmaxf(s, __shfl_xor(s, o));
      if (lane == 0) red[wid] = s; }
    __syncthreads();
    float q1 = red[0];
#pragma unroll
    for (int i = 1; i < 8; ++i) q1 = fmaxf(q1, red[i]);
    const float B2 = q1 * __uint_as_float(T.KMAX[h]) * 1.01f;
    const float* C = T.CUM + (size_t)h * 8192; const float cref = C[P0];
    const int ntb = P0 / KVBLK;
    bool skip = false;
    if (tid < ntb) skip = (cref - C[tid * KVBLK + KVBLK - 1]) * LOG2E_ + 2.f * B2 < -PRUNE_T2;
    const int cnt = __popcll(__ballot(skip));
    __syncthreads();
    if (lane == 0) red[wid] = (float)cnt;
    __syncthreads();
    int jlo = 0;
#pragma unroll
    for (int i = 0; i < 8; ++i) jlo += (int)red[i];
    __syncthreads();
    return __builtin_amdgcn_readfirstlane(jlo);
}
__device__ __forceinline__ void attn_phase(char* lds, const AttnT T, int first, int stride) {
    constexpr int NQB = 8192 / QB, TOTAL = NQB * 8;
    int SKV_ = 8192, W = 8192; asm volatile("" : "+s"(SKV_), "+s"(W));
    int L = first; if (L >= TOTAL) return;
    int pass = 0;
    BlockRef<bf16, bf16> cur = fox_ref(T, L, 0, fox_jlo(T, L, 0, lds));
    Seam<bf16> Sm;
    causal_swa_prime<bf16, bf16>(cur, W, lds, Sm);
    for (;;) {
        const bool more_pass = false, more_item = L + stride < TOTAL, last = !more_pass && !more_item;
        int passn = pass + 1, Ln = L;
        if (!more_pass) { passn = 0; Ln = more_item ? L + stride : L; }
        BlockRef<bf16, bf16> nxt = cur;
        if (!last) { const int jn = fox_jlo(T, Ln, passn, lds); nxt = fox_ref(T, Ln, passn, jn); }
        causal_swa_block<bf16, bf16>(cur, nxt, SKV_, W, lds, Sm);
        if (last) break;
        cur = nxt; pass = passn; L = Ln;
    }
}
#undef KSWZ
#undef SBAR
}

namespace hg {
typedef short bf16x8 __attribute__((ext_vector_type(8)));
typedef float f32x4 __attribute__((ext_vector_type(4)));
typedef unsigned u32x4 __attribute__((ext_vector_type(4)));
typedef unsigned short bf16;
#define HLAS __attribute__((address_space(3)))
constexpr int PQ = 136, PS = 72;
constexpr int L_B = 0;
constexpr int L_QT = 34816;
constexpr int L_Q0 = L_QT + 17408;
constexpr int L_KT = L_Q0 + 17408;
constexpr int L_VT = L_KT + 43520;
constexpr int L_P = L_VT + 18432;
constexpr int L_RED = L_P + 9216;
constexpr int L_END = L_RED + 512 + 2048;
static_assert(L_END <= 147328, "hgrn LDS map");
__device__ __forceinline__ float bfl(unsigned w) { return __uint_as_float(w << 16); }
__device__ __forceinline__ float bfh(unsigned w) { return __uint_as_float(w & 0xffff0000u); }
__device__ __forceinline__ unsigned pkbf(float lo, float hi) { return pg8::cvt_pk_bf16(lo, hi); }
struct T { const bf16 *AQ, *AK, *AI, *AG; const float* ALF; bf16* LT; float* DV; bf16* OA; const float* nw; };

__device__ __forceinline__ void load_b_issue(const float* ALF, int t0, int hcol, int tid, float (&loc)[16]) {
    const int k = tid & 127, seg = tid >> 7;
    const float* p = ALF + (size_t)(t0 + 16 * seg) * 1024 + hcol + k;
#pragma unroll
    for (int i = 0; i < 16; ++i) loc[i] = p[(size_t)i * 1024];
}
__device__ __forceinline__ void load_b_finish(HLAS unsigned char* lds, int tid, float (&loc)[16]) {
    HLAS float* B = (HLAS float*)(lds + L_B); HLAS float* tot = (HLAS float*)(lds + L_RED + 512);
    const int k = tid & 127, seg = tid >> 7;
    float run = 0.f;
#pragma unroll
    for (int i = 0; i < 16; ++i) { run += loc[i]; loc[i] = run; }
    tot[seg * 128 + k] = run;
    __syncthreads();
    float pre = 0.f;
#pragma unroll
    for (int s2 = 0; s2 < 3; ++s2) { const float v = tot[s2 * 128 + k]; pre += (s2 < seg) ? v : 0.f; }
#pragma unroll
    for (int i = 0; i < 16; ++i) B[(16 * seg + i) * 128 + k] = pre + loc[i];
    __syncthreads();
}
__device__ __forceinline__ void store_vt(HLAS unsigned char* lds, int tid, const u32x4 (&vv)[2]) {
    HLAS bf16* VT = (HLAS bf16*)(lds + L_VT);
#pragma unroll
    for (int it = 0; it < 2; ++it) { const int item = tid + 512 * it, s = item >> 4, k8 = (item & 15) * 8;
        const int sx = s ^ (((k8 >> 3) & 7) << 3);
#pragma unroll
        for (int j = 0; j < 4; ++j) { VT[(k8 + 2 * j) * PS + sx] = (bf16)(vv[it][j] & 0xffffu); VT[(k8 + 2 * j + 1) * PS + sx] = (bf16)(vv[it][j] >> 16); } }
}
__device__ __forceinline__ void passA_unit(HLAS unsigned char* lds, const T& P, int c, int h) {
    const int tid = threadIdx.x, lane = tid & 63, w = __builtin_amdgcn_readfirstlane(tid >> 6), t0 = c * 64, hcol = h * 128;
    float loc[16]; u32x4 kkv[2], vv[2];
    load_b_issue(P.ALF, t0, hcol, tid, loc);
#pragma unroll
    for (int it = 0; it < 2; ++it) { const int item = tid + 512 * it, s = item >> 4, k8 = (item & 15) * 8;
        kkv[it] = *(const u32x4*)(P.AK + (size_t)(t0 + s) * 1024 + hcol + k8); vv[it] = *(const u32x4*)(P.AI + (size_t)(t0 + s) * 1024 + hcol + k8); }
    load_b_finish(lds, tid, loc);
    HLAS float* B = (HLAS float*)(lds + L_B); HLAS bf16* KdT = (HLAS bf16*)(lds + L_KT); HLAS bf16* VT = (HLAS bf16*)(lds + L_VT);
#pragma unroll
    for (int it = 0; it < 2; ++it) { const int item = tid + 512 * it, s = item >> 4, k8 = (item & 15) * 8;
        const u32x4 kk = kkv[it];
        const f32x4 l0 = *(const HLAS f32x4*)(B + 63 * 128 + k8), l1 = *(const HLAS f32x4*)(B + 63 * 128 + k8 + 4);
        const f32x4 s0 = *(const HLAS f32x4*)(B + s * 128 + k8), s1 = *(const HLAS f32x4*)(B + s * 128 + k8 + 4);
        float kd[8];
        kd[0] = bfl(kk[0]) * __expf(l0[0] - s0[0]); kd[1] = bfh(kk[0]) * __expf(l0[1] - s0[1]); kd[2] = bfl(kk[1]) * __expf(l0[2] - s0[2]); kd[3] = bfh(kk[1]) * __expf(l0[3] - s0[3]);
        kd[4] = bfl(kk[2]) * __expf(l1[0] - s1[0]); kd[5] = bfh(kk[2]) * __expf(l1[1] - s1[1]); kd[6] = bfl(kk[3]) * __expf(l1[2] - s1[2]); kd[7] = bfh(kk[3]) * __expf(l1[3] - s1[3]);
        const int sx = s ^ (((k8 >> 3) & 7) << 3);
#pragma unroll
        for (int j = 0; j < 4; ++j) { const unsigned pw = pkbf(kd[2 * j], kd[2 * j + 1]); KdT[(k8 + 2 * j) * PS + sx] = (bf16)(pw & 0xffffu); KdT[(k8 + 2 * j + 1) * PS + sx] = (bf16)(pw >> 16); } }
    store_vt(lds, tid, vv);
    if (tid < 128) P.DV[(size_t)(c * 8 + h) * 128 + tid] = __expf(B[63 * 128 + tid]);
    __syncthreads();
    const int fr = lane & 15, fq = lane >> 4;
    bf16x8 a[2];
#pragma unroll
    for (int ks = 0; ks < 2; ++ks) a[ks] = *(const HLAS bf16x8*)(VT + (16 * w + fr) * PS + ((32 * ks + 8 * fq) ^ (((2 * w + (fr >> 3)) & 7) << 3)));
    bf16* out = P.LT + ((size_t)(c * 8 + h) * 128 + 16 * w + 4 * fq) * 128 + fr;
#pragma unroll
    for (int kt = 0; kt < 8; ++kt) { f32x4 acc = {0.f, 0.f, 0.f, 0.f};
#pragma unroll
        for (int ks = 0; ks < 2; ++ks) { const bf16x8 b = *(const HLAS bf16x8*)(KdT + (16 * kt + fr) * PS + ((32 * ks + 8 * fq) ^ (((2 * kt + (fr >> 3)) & 7) << 3))); acc = __builtin_amdgcn_mfma_f32_16x16x32_bf16(a[ks], b, acc, 0, 0, 0); }
#pragma unroll
        for (int r = 0; r < 4; ++r) out[(size_t)r * 128 + 16 * kt] = (bf16)(pkbf(acc[r], 0.f) & 0xffffu); }
    __syncthreads();
}
__device__ __forceinline__ void scan_all(const T& P, int gtid, int gthreads) {
    for (int e = gtid; e < 8 * 128 * 128; e += gthreads) {
        const int h = e >> 14, k = e & 127; bf16* p = P.LT + e; const float* d = P.DV + h * 128 + k;
        float s = 0.f;
        for (int c0 = 0; c0 < 128; c0 += 32) { float L[32], dd[32];
#pragma unroll
            for (int i = 0; i < 32; ++i) { L[i] = __uint_as_float((unsigned)p[(size_t)(c0 + i) * 131072] << 16); dd[i] = d[(size_t)(c0 + i) * 1024]; }
#pragma unroll
            for (int i = 0; i < 32; ++i) { p[(size_t)(c0 + i) * 131072] = (bf16)(pkbf(s, 0.f) & 0xffffu); s = dd[i] * s + L[i]; } }
    }
}
__device__ __forceinline__ void passC_unit(HLAS unsigned char* lds, const T& P, int c, int h) {
    const int tid = threadIdx.x, lane = tid & 63, w = __builtin_amdgcn_readfirstlane(tid >> 6), t0 = c * 64, hcol = h * 128;
    const int fr = lane & 15, fq = lane >> 4;
    float loc[16]; u32x4 qqv[2], kkv[2], vv[2], stv[4]; bf16 gg[4][4];
    load_b_issue(P.ALF, t0, hcol, tid, loc);
#pragma unroll
    for (int it = 0; it < 2; ++it) { const int item = tid + 512 * it, t = item >> 4, k8 = (item & 15) * 8; const size_t o_ = (size_t)(t0 + t) * 1024 + hcol + k8;
        qqv[it] = *(const u32x4*)(P.AQ + o_); kkv[it] = *(const u32x4*)(P.AK + o_); vv[it] = *(const u32x4*)(P.AI + o_); }
    { const bf16* src = P.LT + (size_t)(c * 8 + h) * 16384;
#pragma unroll
      for (int it = 0; it < 4; ++it) { const int item = tid + 512 * it, v = item >> 4, k8 = (item & 15) * 8; stv[it] = *(const u32x4*)(src + v * 128 + k8); } }
#pragma unroll
    for (int i = 0; i < 4; ++i)
#pragma unroll
        for (int r = 0; r < 4; ++r) gg[i][r] = P.AG[(size_t)(t0 + 16 * (w >> 1) + 4 * fq + r) * 1024 + hcol + 16 * ((w & 1) * 4 + i) + fr];
    load_b_finish(lds, tid, loc);
    HLAS float* B = (HLAS float*)(lds + L_B); HLAS bf16* QT = (HLAS bf16*)(lds + L_QT); HLAS bf16* Q0 = (HLAS bf16*)(lds + L_Q0); HLAS bf16* KT = (HLAS bf16*)(lds + L_KT);
    HLAS bf16* VT = (HLAS bf16*)(lds + L_VT); HLAS bf16* PP = (HLAS bf16*)(lds + L_P); HLAS bf16* ST = (HLAS bf16*)(lds + L_B); HLAS float* red = (HLAS float*)(lds + L_RED);
#pragma unroll
    for (int it = 0; it < 2; ++it) { const int item = tid + 512 * it, t = item >> 4, k8 = (item & 15) * 8, J = t >> 4;
        const u32x4 qq = qqv[it], kk = kkv[it];
        float bt[8], q[8], kf[8];
        { const f32x4 x0 = *(const HLAS f32x4*)(B + t * 128 + k8), x1 = *(const HLAS f32x4*)(B + t * 128 + k8 + 4);
#pragma unroll
          for (int j = 0; j < 4; ++j) { bt[j] = x0[j]; bt[4 + j] = x1[j]; q[2 * j] = bfl(qq[j]); q[2 * j + 1] = bfh(qq[j]); kf[2 * j] = bfl(kk[j]); kf[2 * j + 1] = bfh(kk[j]); } }
        { float e0[8]; u32x4 o;
#pragma unroll
          for (int j = 0; j < 8; ++j) e0[j] = q[j] * __expf(bt[j]);
          o[0] = pkbf(e0[0], e0[1]); o[1] = pkbf(e0[2], e0[3]); o[2] = pkbf(e0[4], e0[5]); o[3] = pkbf(e0[6], e0[7]);
          *(HLAS u32x4*)(Q0 + t * PQ + k8) = o; }
        for (int I = J; I < 4; ++I) {
            const f32x4 r0 = *(const HLAS f32x4*)(B + (16 * I) * 128 + k8), r1 = *(const HLAS f32x4*)(B + (16 * I) * 128 + k8 + 4);
            float br[8];
#pragma unroll
            for (int j = 0; j < 4; ++j) { br[j] = r0[j]; br[4 + j] = r1[j]; }
            float e1[8]; u32x4 o;
#pragma unroll
            for (int j = 0; j < 8; ++j) e1[j] = kf[j] * __expf(br[j] - bt[j]);
            o[0] = pkbf(e1[0], e1[1]); o[1] = pkbf(e1[2], e1[3]); o[2] = pkbf(e1[4], e1[5]); o[3] = pkbf(e1[6], e1[7]);
            const int off = (I == 0) ? 0 : (I == 1) ? 16 : (I == 2) ? 48 : 96;
            *(HLAS u32x4*)(KT + (off + t) * PQ + k8) = o;
            if (I == J) {
#pragma unroll
                for (int j = 0; j < 8; ++j) e1[j] = q[j] * __expf(bt[j] - br[j]);
                o[0] = pkbf(e1[0], e1[1]); o[1] = pkbf(e1[2], e1[3]); o[2] = pkbf(e1[4], e1[5]); o[3] = pkbf(e1[6], e1[7]);
                *(HLAS u32x4*)(QT + t * PQ + k8) = o; }
        } }
    store_vt(lds, tid, vv);
    __syncthreads();
#pragma unroll
    for (int it = 0; it < 4; ++it) { const int item = tid + 512 * it, v = item >> 4, k8 = (item & 15) * 8; *(HLAS u32x4*)(ST + v * PQ + k8) = stv[it]; }
    for (int idx = w; idx < 10; idx += 8) {
        const int I = (idx >= 6) ? 3 : (idx >= 3) ? 2 : (idx >= 1) ? 1 : 0, J = idx - ((I * (I + 1)) >> 1), off = (I == 0) ? 0 : (I == 1) ? 16 : (I == 2) ? 48 : 96;
        f32x4 acc = {0.f, 0.f, 0.f, 0.f};
#pragma unroll
        for (int ks = 0; ks < 4; ++ks) { const bf16x8 a = *(const HLAS bf16x8*)(QT + (16 * I + fr) * PQ + 32 * ks + 8 * fq), b = *(const HLAS bf16x8*)(KT + (off + 16 * J + fr) * PQ + 32 * ks + 8 * fq);
            acc = __builtin_amdgcn_mfma_f32_16x16x32_bf16(a, b, acc, 0, 0, 0); }
#pragma unroll
        for (int r = 0; r < 4; ++r) { const float v = (I == J && fr > 4 * fq + r) ? 0.f : acc[r]; PP[(16 * I + 4 * fq + r) * PS + 16 * J + fr] = (bf16)(pkbf(v, 0.f) & 0xffffu); } }
    if (w >= 2) { const int z = w - 2, I = (z < 3) ? 0 : (z < 5) ? 1 : 2, J = (z < 3) ? z + 1 : (z < 5) ? z - 1 : 3;
#pragma unroll
        for (int r = 0; r < 4; ++r) PP[(16 * I + 4 * fq + r) * PS + 16 * J + fr] = (bf16)0; }
    __syncthreads();
    { const int I = w >> 1, vh = w & 1;
      f32x4 acc[4];
#pragma unroll
      for (int i = 0; i < 4; ++i) { const int vt = vh * 4 + i; f32x4 a4 = {0.f, 0.f, 0.f, 0.f};
#pragma unroll
          for (int ks = 0; ks < 2; ++ks) { const bf16x8 a = *(const HLAS bf16x8*)(PP + (16 * I + fr) * PS + 32 * ks + 8 * fq), b = *(const HLAS bf16x8*)(VT + (16 * vt + fr) * PS + ((32 * ks + 8 * fq) ^ (((2 * vt + (fr >> 3)) & 7) << 3)));
              a4 = __builtin_amdgcn_mfma_f32_16x16x32_bf16(a, b, a4, 0, 0, 0); }
#pragma unroll
          for (int ks = 0; ks < 4; ++ks) { const bf16x8 a = *(const HLAS bf16x8*)(Q0 + (16 * I + fr) * PQ + 32 * ks + 8 * fq), b = *(const HLAS bf16x8*)(ST + (16 * vt + fr) * PQ + 32 * ks + 8 * fq);
              a4 = __builtin_amdgcn_mfma_f32_16x16x32_bf16(a, b, a4, 0, 0, 0); }
          acc[i] = a4; }
      float ss[4];
#pragma unroll
      for (int r = 0; r < 4; ++r) { float s = 0.f;
#pragma unroll
          for (int i = 0; i < 4; ++i) s += acc[i][r] * acc[i][r];
          s += __shfl_xor(s, 1); s += __shfl_xor(s, 2); s += __shfl_xor(s, 4); s += __shfl_xor(s, 8); ss[r] = s; }
      if (fr == 0) {
#pragma unroll
          for (int r = 0; r < 4; ++r) red[(I * 2 + vh) * 16 + 4 * fq + r] = ss[r]; }
      __syncthreads();
#pragma unroll
      for (int r = 0; r < 4; ++r) { const float tot = red[(I * 2) * 16 + 4 * fq + r] + red[(I * 2 + 1) * 16 + 4 * fq + r]; ss[r] = rsqrtf(tot * (1.f / 128.f) + 1e-6f); }
#pragma unroll
      for (int i = 0; i < 4; ++i) { const int v = 16 * (vh * 4 + i) + fr; const float nwv = P.nw[v];
#pragma unroll
          for (int r = 0; r < 4; ++r) { const size_t o_ = (size_t)(t0 + 16 * I + 4 * fq + r) * 1024 + hcol + v;
              const float g = __uint_as_float((unsigned)gg[i][r] << 16);
              P.OA[(size_t)(t0 + 16 * I + 4 * fq + r) * 2048 + hcol + v] = (bf16)(pkbf(acc[i][r] * ss[r] * nwv * (g / (1.f + __expf(-g))), 0.f) & 0xffffu); } }
    }
    __syncthreads();
}
#undef HLAS
}


#define GAS __attribute__((address_space(1)))
#define LAS __attribute__((address_space(3)))
typedef unsigned short bf16;
typedef unsigned v4u __attribute__((ext_vector_type(4)));
typedef float f32x4 __attribute__((ext_vector_type(4)));
constexpr int NWAVES = 8;
constexpr size_t MiB = 1u << 20;
constexpr size_t WS_BAR = 65536, BAR_BYTES = 16384;
constexpr size_t WS_LB = 0;
constexpr size_t WS_WUA = 1 * MiB, WS_WUB = 5 * MiB, WS_WO = 9 * MiB, WS_WFI = 17 * MiB, WS_WFD = 61 * MiB;
constexpr size_t WS_WIN = 83 * MiB;
constexpr size_t WS_OA = 83 * MiB, WS_OB = 99 * MiB, WS_DV = 115 * MiB;
constexpr size_t WS_H1 = 127 * MiB;
constexpr size_t WS_PROJ = 159 * MiB;
constexpr size_t WS_ALF = 271 * MiB;
constexpr size_t WS_T = 159 * MiB;
constexpr size_t WS_HID = 223 * MiB;
constexpr size_t WS_END = 311 * MiB;
static_assert(WS_ALF + 32 * MiB <= WS_END && WS_HID + 88 * MiB <= WS_END, "ws map");
constexpr size_t WS_LS2 = 304 * MiB, WS_CUM2 = 305 * MiB;

__device__ __forceinline__ unsigned f2bf(float f) { unsigned u = __builtin_bit_cast(unsigned, f); return (u + 0x7fffu + ((u >> 16) & 1u)) >> 16; }
__device__ __forceinline__ unsigned pk2(float lo, float hi) { return f2bf(lo) | (f2bf(hi) << 16); }
__device__ __forceinline__ float bf2f(bf16 u) { return __uint_as_float((unsigned)u << 16); }
__device__ __forceinline__ float wave_sum(float v) {
#pragma unroll
    for (int o = 1; o < 64; o <<= 1) v += __shfl_xor(v, o);
    return v;
}
#define LDS_WAIT() asm volatile("s_waitcnt lgkmcnt(0)" ::: "memory")

typedef GAS unsigned gu32;
#define RLX_AGENT __ATOMIC_RELAXED, __HIP_MEMORY_SCOPE_AGENT
struct Args { const float* in[14]; float* out; unsigned char* ws; int ph_lo, ph_hi; };

struct TrItem { const float* src; bf16* dst; };
__device__ __forceinline__ void tr_load(const TrItem& t, int ldw, int lane, f32x4 (&a)[8], f32x4 (&b)[8]) {
    const int r = lane >> 4, c = lane & 15;
#pragma unroll
    for (int i = 0; i < 8; ++i) { const float* p = t.src + (size_t)(8 * i + 2 * r) * ldw + 4 * c; a[i] = __builtin_nontemporal_load((const f32x4*)p); b[i] = __builtin_nontemporal_load((const f32x4*)(p + ldw)); }
}
__device__ __forceinline__ void tr_store(const TrItem& t, int DP, int lane, LAS unsigned* scr, const f32x4 (&a)[8], const f32x4 (&b)[8]) {
    const int r = lane >> 4, c = lane & 15;
#pragma unroll
    for (int i = 0; i < 8; ++i) { const int kp = (4 * i + r) ^ (4 * (c & 7));
#pragma unroll
        for (int j = 0; j < 4; ++j) scr[(4 * c + j) * 32 + kp] = pg8::cvt_pk_bf16(a[i][j], b[i][j]); }
    LDS_WAIT(); asm volatile("" ::: "memory");
#pragma unroll
    for (int it = 0; it < 8; ++it) { const int n = 8 * it + (lane >> 3), g = lane & 7;
        const v4u o = *(const LAS v4u*)(scr + n * 32 + ((4 * g) ^ (4 * ((n >> 2) & 7))));
        *(v4u*)(t.dst + (size_t)n * DP + 8 * g) = o; }
    LDS_WAIT(); asm volatile("" ::: "memory");
}
__device__ __forceinline__ TrItem tr_item(const float* W, int ldw, int DP, int ncols, bf16* WT, int row_off, int mode, int it) {
    const int nblk = ncols / 64, kb = it / nblk, nb = it % nblk, n0 = 64 * nb;
    const int drow0 = mode ? ((n0 >> 7) * 256 + (n0 & 127) + row_off) : (row_off + n0);
    TrItem t; t.src = W + (size_t)(64 * kb) * ldw + n0; t.dst = WT + (size_t)drow0 * DP + 64 * kb; return t;
}
__device__ __forceinline__ void p0_matrix(const float* W, int ldw, int K, int ncols, bf16* WT, int row_off, int mode, LAS unsigned* scr, int lane, int gw, int NGW, int DP = 0) {
    if (DP == 0) DP = K;
    const int nitems = (K / 64) * (ncols / 64);
    int it = gw; if (it >= nitems) return;
    f32x4 a0[8], b0[8], a1[8], b1[8];
    TrItem t0 = tr_item(W, ldw, DP, ncols, WT, row_off, mode, it), t1 = t0;
    tr_load(t0, ldw, lane, a0, b0);
    for (;;) {
        const int it1 = it + NGW, it2 = it1 + NGW;
        if (it1 < nitems) { t1 = tr_item(W, ldw, DP, ncols, WT, row_off, mode, it1); tr_load(t1, ldw, lane, a1, b1); }
        tr_store(t0, DP, lane, scr, a0, b0);
        if (it1 >= nitems) break;
        if (it2 < nitems) { t0 = tr_item(W, ldw, DP, ncols, WT, row_off, mode, it2); tr_load(t0, ldw, lane, a0, b0); }
        tr_store(t1, DP, lane, scr, a1, b1);
        if (it2 >= nitems) break;
        it = it2;
    }
}

struct Frame {
    LAS unsigned char* lds; int tid, lane, wave, G;
    const float *x, *w_in, *b_fox, *lbl, *hnw, *w_up_a, *w_up_b, *w_o, *n_mix_pre, *n_mix_post, *n_ffn_pre, *n_ffn_post, *w_ffn_in, *w_ffn_down;
    float* out; unsigned char* ws;
};

__device__ __forceinline__ void p0_prologue(Frame& F) {
    LAS unsigned* scr = (LAS unsigned*)(F.lds + F.wave * 16384);
    const int gw = blockIdx.x * NWAVES + F.wave, NGW = F.G * NWAVES;
    if (blockIdx.x == 0) { float* LB = (float*)(F.ws + WS_LB); for (int c = F.tid; c < AW; c += 512) LB[c] = 1.f / (1.f + expf(F.lbl[AW + c] - F.lbl[c])); }
    LAS float* wfT = (LAS float*)F.lds;
    for (int k = F.tid; k < DM; k += 512) { const f32x4 a4 = *(const f32x4*)(F.w_in + (size_t)k * NIN + 7168), b4 = *(const f32x4*)(F.w_in + (size_t)k * NIN + 7172);
        wfT[0 * DM + k] = a4.x; wfT[1 * DM + k] = a4.y; wfT[2 * DM + k] = a4.z; wfT[3 * DM + k] = a4.w; wfT[4 * DM + k] = b4.x; wfT[5 * DM + k] = b4.y; wfT[6 * DM + k] = b4.z; wfT[7 * DM + k] = b4.w; }
    __syncthreads();
    {
        bf16* H1 = (bf16*)(F.ws + WS_H1); float* LS = (float*)(F.ws + WS_LS2);
        f32x4 wn[8], va[8], vb[8];
#pragma unroll
        for (int j = 0; j < 8; ++j) wn[j] = ((const f32x4*)F.n_mix_pre + F.lane)[64 * j];
#define P0_LOAD(m_, v_) do { const f32x4* xr_ = (const f32x4*)(F.x + (size_t)(m_) * DM) + F.lane; _Pragma("unroll") for (int j = 0; j < 8; ++j) v_[j] = __builtin_nontemporal_load(xr_ + 64 * j); } while (0)
#define P0_ROW(m_, v) do { \
            asm volatile("" ::: "memory");                                      \
            float s = 0.f; \
            _Pragma("unroll") for (int j = 0; j < 8; ++j) s += (v[j].x * v[j].x + v[j].y * v[j].y) + (v[j].z * v[j].z + v[j].w * v[j].w); \
            const float rstd = rsqrtf(wave_sum(s) * (1.f / DM) + EPS); \
            float fd[8] = {0.f, 0.f, 0.f, 0.f, 0.f, 0.f, 0.f, 0.f}; \
            unsigned long long* o8 = (unsigned long long*)(H1 + (size_t)(m_) * DM) + F.lane; \
            _Pragma("unroll") for (int j = 0; j < 8; ++j) { v[j] = v[j] * rstd * wn[j]; \
                o8[64 * j] = (unsigned long long)pk2(v[j].x, v[j].y) | ((unsigned long long)pk2(v[j].z, v[j].w) << 32); \
                _Pragma("unroll") for (int e = 0; e < 8; ++e) { const f32x4 wv = *(const LAS f32x4*)(wfT + e * DM + 256 * j + 4 * F.lane); fd[e] += (v[j].x * wv.x + v[j].y * wv.y) + (v[j].z * wv.z + v[j].w * wv.w); } } \
            _Pragma("unroll") for (int e = 0; e < 8; ++e) fd[e] = wave_sum(fd[e]); \
            if (F.lane < 8) { float z = fd[0]; \
                _Pragma("unroll") for (int e = 1; e < 8; ++e) z = (F.lane == e) ? fd[e] : z; \
                z += F.b_fox[F.lane]; \
                LS[(size_t)(m_) * 8 + F.lane] = fminf(z, 0.f) - log1pf(expf(-fabsf(z))); } } while (0)
        int m = gw;
        if (m < S) { P0_LOAD(m, va);
            for (;;) { const int m1 = m + NGW, m2 = m1 + NGW;
                if (m1 < S) P0_LOAD(m1, vb);
                P0_ROW(m, va);
                if (m1 >= S) break;
                if (m2 < S) P0_LOAD(m2, va);
                P0_ROW(m1, vb);
                if (m2 >= S) break;
                m = m2; } }
#undef P0_LOAD
#undef P0_ROW
    }
    __syncthreads();
    p0_matrix(F.w_in, NIN, DM, 7168, (bf16*)(F.ws + WS_WIN), 0, 0, scr, F.lane, gw, NGW);
    p0_matrix(F.w_in + 7176, NIN, DM, 4096, (bf16*)(F.ws + WS_WIN), 7168, 0, scr, F.lane, gw, NGW);
}
__device__ __forceinline__ void late_weights(Frame& F, int my, int nidle) {
    LAS unsigned* scr = (LAS unsigned*)(F.lds + F.wave * 16384);
    const int gw = my * NWAVES + F.wave, NGW = nidle * NWAVES;
    p0_matrix(F.w_up_a, DM, AW, DM, (bf16*)(F.ws + WS_WUA), 0, 0, scr, F.lane, gw, NGW, 2 * AW);
    p0_matrix(F.w_up_b, DM, AW, DM, (bf16*)(F.ws + WS_WUA) + AW, 0, 0, scr, F.lane, gw, NGW, 2 * AW);
    p0_matrix(F.w_o, DM, DM, DM, (bf16*)(F.ws + WS_WO), 0, 0, scr, F.lane, gw, NGW);
    p0_matrix(F.w_ffn_in, 2 * DFF, DM, DFF, (bf16*)(F.ws + WS_WFI), 0, 1, scr, F.lane, gw, NGW);
    p0_matrix(F.w_ffn_in + DFF, 2 * DFF, DM, DFF, (bf16*)(F.ws + WS_WFI), 128, 1, scr, F.lane, gw, NGW);
}
__device__ __forceinline__ void cum_scan(Frame& F) {
    const float* LS = (const float*)(F.ws + WS_LS2); float* CUM = (float*)(F.ws + WS_CUM2);
    const int h = F.wave, lane = F.lane;
    double carry = 0.0;
    for (int c0 = 0; c0 < S / 64; c0 += 8) {
        float v[8];
#pragma unroll
        for (int i = 0; i < 8; ++i) v[i] = LS[(size_t)((c0 + i) * 64 + lane) * 8 + h];
#pragma unroll
        for (int i = 0; i < 8; ++i) {
            double x = (double)v[i];
#pragma unroll
            for (int o = 1; o < 64; o <<= 1) { const double y = __shfl_up(x, o); x += (lane >= o) ? y : 0.0; }
            CUM[(size_t)h * S + (c0 + i) * 64 + lane] = (float)(carry + x);
            carry += __shfl(x, 63);
        }
    }
}
#define BF4(tw) ((f32x4){__uint_as_float((unsigned)(tw) << 16), __uint_as_float((unsigned)(tw) & 0xffff0000u), __uint_as_float((unsigned)((tw) >> 32) << 16), __uint_as_float((unsigned)((tw) >> 32) & 0xffff0000u)})
__device__ __forceinline__ void r1_load(Frame& F, int m, f32x4 (&v)[8], f32x4 (&xv)[8]) {
    const unsigned long long* tr = (const unsigned long long*)((const bf16*)(F.ws + WS_T) + (size_t)m * DM) + F.lane; const f32x4* xr = (const f32x4*)(F.x + (size_t)m * DM) + F.lane;
#pragma unroll
    for (int j = 0; j < 8; ++j) { const unsigned long long tw = tr[64 * j]; v[j] = BF4(tw); xv[j] = __builtin_nontemporal_load(xr + 64 * j); }
}
__device__ __forceinline__ void r1_finish(Frame& F, int m, f32x4 (&v)[8], const f32x4 (&xv)[8], const f32x4 (&wa)[8], const f32x4 (&wb)[8]) {
    float s = 0.f;
#pragma unroll
    for (int j = 0; j < 8; ++j) s += (v[j].x * v[j].x + v[j].y * v[j].y) + (v[j].z * v[j].z + v[j].w * v[j].w);
    const float rstd = rsqrtf(wave_sum(s) * (1.f / DM) + EPS); float s2 = 0.f;
#pragma unroll
    for (int j = 0; j < 8; ++j) { v[j] = xv[j] + v[j] * rstd * wa[j]; s2 += (v[j].x * v[j].x + v[j].y * v[j].y) + (v[j].z * v[j].z + v[j].w * v[j].w); }
    f32x4* orow = (f32x4*)(F.out + (size_t)m * DM) + F.lane;
#pragma unroll
    for (int j = 0; j < 8; ++j) orow[64 * j] = v[j];
    const float rstd2 = rsqrtf(wave_sum(s2) * (1.f / DM) + EPS);
    unsigned long long* o8 = (unsigned long long*)((bf16*)(F.ws + WS_H1) + (size_t)m * DM) + F.lane;
#pragma unroll
    for (int j = 0; j < 8; ++j) { const f32x4 h = v[j] * rstd2 * wb[j]; o8[64 * j] = (unsigned long long)pk2(h.x, h.y) | ((unsigned long long)pk2(h.z, h.w) << 32); }
}
__device__ __forceinline__ void rowpass1(Frame& F, int gw, int NGW, int mend) {
    int m = gw; if (m >= mend) return;
    f32x4 wa[8], wb[8], v0[8], x0[8], v1[8], x1[8];
#pragma unroll
    for (int j = 0; j < 8; ++j) { wa[j] = ((const f32x4*)F.n_mix_post + F.lane)[64 * j]; wb[j] = ((const f32x4*)F.n_ffn_pre + F.lane)[64 * j]; }
    r1_load(F, m, v0, x0);
    for (;;) {
        const int m1 = m + NGW, m2 = m1 + NGW;
        if (m1 < mend) r1_load(F, m1, v1, x1);
        r1_finish(F, m, v0, x0, wa, wb);
        if (m1 >= mend) break;
        if (m2 < mend) r1_load(F, m2, v0, x0);
        r1_finish(F, m1, v1, x1, wa, wb);
        if (m2 >= mend) break;
        m = m2;
    }
}
__device__ __forceinline__ void r2_load(Frame& F, int m, f32x4 (&v)[8], f32x4 (&xv)[8]) {
    const unsigned long long* tr = (const unsigned long long*)((const bf16*)(F.ws + WS_T) + (size_t)m * DM) + F.lane; const f32x4* orow = (const f32x4*)(F.out + (size_t)m * DM) + F.lane;
#pragma unroll
    for (int j = 0; j < 8; ++j) { const unsigned long long tw = tr[64 * j]; v[j] = BF4(tw); xv[j] = orow[64 * j]; }
}
__device__ __forceinline__ void r2_finish(Frame& F, int m, const f32x4 (&v)[8], const f32x4 (&xv)[8], const f32x4 (&wa)[8]) {
    float s = 0.f;
#pragma unroll
    for (int j = 0; j < 8; ++j) s += (v[j].x * v[j].x + v[j].y * v[j].y) + (v[j].z * v[j].z + v[j].w * v[j].w);
    const float rstd = rsqrtf(wave_sum(s) * (1.f / DM) + EPS);
    f32x4* orow = (f32x4*)(F.out + (size_t)m * DM) + F.lane;
#pragma unroll
    for (int j = 0; j < 8; ++j) orow[64 * j] = xv[j] + v[j] * rstd * wa[j];
}
__device__ __forceinline__ void rowpass2(Frame& F, int gw, int NGW, int mend) {
    int m = gw; if (m >= mend) return;
    f32x4 wa[8], v0[8], x0[8], v1[8], x1[8];
#pragma unroll
    for (int j = 0; j < 8; ++j) wa[j] = ((const f32x4*)F.n_ffn_post + F.lane)[64 * j];
    r2_load(F, m, v0, x0);
    for (;;) {
        const int m1 = m + NGW, m2 = m1 + NGW;
        if (m1 < mend) r2_load(F, m1, v1, x1);
        r2_finish(F, m, v0, x0, wa);
        if (m1 >= mend) break;
        if (m2 < mend) r2_load(F, m2, v0, x0);
        r2_finish(F, m1, v1, x1, wa);
        if (m2 >= mend) break;
        m = m2;
    }
}
#undef BF4

#define XB_TMO      128
#define XB_XCNT(j)  (256  + 64 * (j))
#define XB_XSUB(j)  (1280 + 64 * (j))
#define XB_XGEN(j)  (2304 + 64 * (j))
#define XB_TOP      3328
#define XB_TOPGEN   3392
#define XCD_BAR_WORDS 3456
#define XB_SPIN_CAP (1u << 18)

__device__ __forceinline__ unsigned xb_ld(unsigned* p)              { return __hip_atomic_load(p, __ATOMIC_RELAXED, __HIP_MEMORY_SCOPE_AGENT); }
__device__ __forceinline__ unsigned xb_add(unsigned* p, unsigned v) { return __hip_atomic_fetch_add(p, v, __ATOMIC_RELAXED, __HIP_MEMORY_SCOPE_AGENT); }
__device__ __forceinline__ unsigned xb_xcc_id() { return (unsigned)__builtin_amdgcn_s_getreg((3 << 11) | 20) & 0xFu; }
#define XB_SPIN(cond, bar) do { unsigned _sp = 0; while (cond) { __builtin_amdgcn_s_sleep(1); \
    if ((++_sp & 255u) == 0u) { if (xb_ld(&(bar)[XB_TMO])) break; if (_sp > XB_SPIN_CAP) { atomicAdd(&(bar)[XB_TMO], 1u); break; } } } } while (0)

struct XcdBarrier {
    unsigned* bar; unsigned x;
    volatile LAS unsigned* st;
};

__device__ __forceinline__ XcdBarrier xcd_barrier_post(unsigned* bar, volatile LAS unsigned* st) {
    XcdBarrier b; b.bar = bar; b.x = xb_xcc_id(); b.st = st;
    if (threadIdx.x == 0) (void)xb_add(&bar[XB_XCNT(b.x)], 1u);
    return b;
}
__device__ __forceinline__ void xcd_barrier_complete(unsigned* bar, unsigned x, unsigned& nloc, unsigned& nx) {
    const unsigned G = gridDim.x * gridDim.y * gridDim.z;
    unsigned sum, cnt, mine, sp = 0u;
    for (;;) {
        sum = 0u; cnt = 0u; mine = 0u;
#pragma unroll
        for (unsigned j = 0; j < 16; ++j) { const unsigned c = xb_ld(&bar[XB_XCNT(j)]); sum += c; cnt += (c > 0u) ? 1u : 0u; mine = (j == x) ? c : mine; }
        if (sum == G) break;
        __builtin_amdgcn_s_sleep(1);
        if ((++sp & 255u) == 0u) { if (xb_ld(&bar[XB_TMO])) break; if (sp > XB_SPIN_CAP) { atomicAdd(&bar[XB_TMO], 1u); break; } }
    }
    nloc = mine > 0u ? mine : 1u; nx = cnt > 0u ? cnt : 1u;
}

__device__ __forceinline__ void xcd_barrier(const XcdBarrier& b) {
    asm volatile("s_waitcnt vmcnt(0)" ::: "memory");
    __syncthreads();
    if (threadIdx.x == 0) {
        unsigned* bar = b.bar;
        __builtin_amdgcn_s_waitcnt(0);
        unsigned nloc = b.st[0], nx = b.st[1];
        if (nloc == 0u) { xcd_barrier_complete(bar, b.x, nloc, nx); b.st[0] = nloc; b.st[1] = nx; }
        const unsigned old = xb_add(&bar[XB_XSUB(b.x)], 1u);
        const unsigned gen = old / nloc;
        if (old + 1u == (gen + 1u) * nloc) {
            __builtin_amdgcn_fence(__ATOMIC_RELEASE, "agent");
            asm volatile("s_waitcnt vmcnt(0)" ::: "memory");
            const unsigned og = xb_add(&bar[XB_TOP], 1u);
            const unsigned tg = og / nx;
            if (og + 1u == (tg + 1u) * nx) xb_add(&bar[XB_TOPGEN], 1u);
            else XB_SPIN(xb_ld(&bar[XB_TOPGEN]) == tg, bar);
            __builtin_amdgcn_fence(__ATOMIC_ACQUIRE, "agent");
            xb_add(&bar[XB_XGEN(b.x)], 1u);
            asm volatile("s_waitcnt vmcnt(0)" ::: "memory");
        } else {
            XB_SPIN(xb_ld(&bar[XB_XGEN(b.x)]) == gen, bar);
            __builtin_amdgcn_fence(__ATOMIC_ACQUIRE, "agent");
            asm volatile("s_waitcnt vmcnt(0)" ::: "memory");
        }
    }
    __syncthreads();
}

constexpr int LDS_BYTES = 147456;
enum { PH_PRO = 0, PH_GEMM1 = 1, PH_MIX = 2, PH_SCAN = 3, PH_HOUT = 4, PH_UPA = 5, PH_WO = 6, PH_ROW1 = 7, PH_FFI = 8, PH_FFD = 9, PH_ROW2 = 10, PH_N = 11 };
__global__ void __launch_bounds__(NWAVES * 64, 2) mega(Args a) {
    extern __shared__ __attribute__((aligned(16))) unsigned char lds[];
    Frame F;
    F.lds = (LAS unsigned char*)lds; F.tid = threadIdx.x; F.lane = F.tid & 63; F.wave = __builtin_amdgcn_readfirstlane(F.tid >> 6); F.G = gridDim.x;
    F.x = a.in[0]; F.w_in = a.in[1]; F.b_fox = a.in[2]; F.lbl = a.in[3]; F.hnw = a.in[4]; F.w_up_a = a.in[5]; F.w_up_b = a.in[6]; F.w_o = a.in[7];
    F.n_mix_pre = a.in[8]; F.n_mix_post = a.in[9]; F.n_ffn_pre = a.in[10]; F.n_ffn_post = a.in[11]; F.w_ffn_in = a.in[12]; F.w_ffn_down = a.in[13];
    F.out = a.out; F.ws = a.ws;
    unsigned char* ws = a.ws;
    const int lo = a.ph_lo, hi = a.ph_hi;
#define IN(k) (lo <= (k) && (k) < hi)
#define REFRESH() do { int t_ = threadIdx.x; asm volatile("" : "+v"(t_)); F.tid = t_; F.lane = t_ & 63; F.wave = __builtin_amdgcn_readfirstlane(t_ >> 6); } while (0)
    if (a.ph_lo < 0) cg::this_grid().sync();
    volatile LAS unsigned* MISC = (volatile LAS unsigned*)(F.lds + 147328);
    if (threadIdx.x < 32) MISC[threadIdx.x] = 0u;
    __syncthreads();
    XcdBarrier bar; bar.bar = (unsigned*)(a.ws + WS_BAR); bar.x = 0; bar.st = nullptr;
    const bool fused = (hi - lo) > 1;
    if (fused) bar = xcd_barrier_post((unsigned*)(a.ws + WS_BAR), MISC + 8);
#define SEAM(k) do { if (IN(k) && IN((k) + 1)) xcd_barrier(bar); } while (0)
    pg8::bf16_t* H1 = (pg8::bf16_t*)(ws + WS_H1);
    if (IN(PH_PRO)) { REFRESH(); p0_prologue(F); }
    SEAM(PH_PRO);
    if (IN(PH_GEMM1)) {
        const int rounds = (32 * 44 + F.G - 1) / F.G, GC = (32 * 44 + rounds - 1) / rounds, nconv = F.G - GC;
        if ((int)blockIdx.x == F.G - 1) { REFRESH(); cum_scan(F); __syncthreads(); }
        if ((int)blockIdx.x < GC) {
            pg8::Gemm g{H1, (const pg8::bf16_t*)(ws + WS_WIN), S, 11264, DM}; pg8::StaticOrder So; So.init(S, 11264, GC, (int)blockIdx.x);
            pg8::EpiProj E{(pg8::bf16_t*)(ws + WS_PROJ), (float*)(ws + WS_ALF), (pg8::bf16_t*)a.out, (const float*)(ws + WS_LB), (unsigned*)(ws + WS_BAR + 15360)};
            pg8::gemm_phase<pg8::EpiProj, pg8::StaticOrder, true, true>(F.lds, g, So, E);
            if (nconv == 0) { REFRESH(); late_weights(F, (int)blockIdx.x, F.G); }
        } else { REFRESH(); late_weights(F, (int)blockIdx.x - GC, nconv); }
    }
    SEAM(PH_GEMM1);
    const hg::T HT{(const hg::bf16*)(ws + WS_PROJ), (const hg::bf16*)(ws + WS_PROJ) + (size_t)S * 1024, (const hg::bf16*)(ws + WS_PROJ) + (size_t)2 * S * 1024, (const hg::bf16*)(ws + WS_PROJ) + (size_t)3 * S * 1024,
                   (const float*)(ws + WS_ALF), (hg::bf16*)(ws + WS_H1), (float*)(ws + WS_DV), (hg::bf16*)(ws + WS_OA), a.in[4]};
    if (IN(PH_MIX)) {
        { const fox::bf16* PR = (const fox::bf16*)(ws + WS_PROJ);
          const fox::AttnT AT{PR + (size_t)4 * S * 1024, PR + (size_t)5 * S * 1024, PR + (size_t)6 * S * 1024, (fox::bf16*)(ws + WS_OA) + AW, (const float*)(ws + WS_CUM2), (const unsigned*)(ws + WS_BAR + 15360)};
          fox::attn_phase((char*)lds, AT, (int)blockIdx.x, (int)gridDim.x); }
        __syncthreads();
        for (int u = (int)blockIdx.x; u < 1024; u += (int)gridDim.x) hg::passA_unit(F.lds, HT, u >> 3, u & 7);
    }
    SEAM(PH_MIX);
    if (IN(PH_SCAN)) hg::scan_all(HT, (int)(blockIdx.x * 512 + threadIdx.x), (int)(gridDim.x * 512));
    SEAM(PH_SCAN);
    if (IN(PH_HOUT)) { for (int u = (int)blockIdx.x; u < 1024; u += (int)gridDim.x) hg::passC_unit(F.lds, HT, u >> 3, u & 7); }
    SEAM(PH_HOUT);
    if (IN(PH_UPA)) {
        pg8::Gemm g{(const pg8::bf16_t*)(ws + WS_OA), (const pg8::bf16_t*)(ws + WS_WUA), S, DM, DM}; pg8::StaticOrder So; So.init(S, DM, F.G, (int)blockIdx.x);
        pg8::EpiUp E{(const pg8::bf16_t*)a.out, (const pg8::bf16_t*)a.out + (size_t)S * DM, H1};
        pg8::gemm_phase<pg8::EpiUp, pg8::StaticOrder, true, true>(F.lds, g, So, E);
    }
    SEAM(PH_UPA);
    if (IN(PH_WO)) {
        pg8::Gemm g{H1, (const pg8::bf16_t*)(ws + WS_WO), S, DM, DM}; pg8::StaticOrder So; So.init(S, DM, F.G, (int)blockIdx.x);
        pg8::EpiT16 E{(pg8::bf16_t*)(ws + WS_T)};
        pg8::gemm_phase<pg8::EpiT16, pg8::StaticOrder, true, true>(F.lds, g, So, E);
    }
    SEAM(PH_WO);
    if (IN(PH_ROW1)) { REFRESH(); rowpass1(F, blockIdx.x * NWAVES + F.wave, F.G * NWAVES, S); }
    SEAM(PH_ROW1);
    if (IN(PH_FFI)) {
        pg8::Gemm g{H1, (const pg8::bf16_t*)(ws + WS_WFI), S, 2 * DFF, DM}; pg8::StaticOrder So; So.init(S, 2 * DFF, F.G, (int)blockIdx.x);
        pg8::EpiSwiglu E{(pg8::bf16_t*)(ws + WS_HID)};
        pg8::gemm_phase<pg8::EpiSwiglu, pg8::StaticOrder, true, true>(F.lds, g, So, E);
        { const int rem = (32 * 44) % F.G, my = rem ? (int)blockIdx.x - rem : (int)blockIdx.x;
          if (my >= 0) { REFRESH(); LAS unsigned* scr = (LAS unsigned*)(F.lds + F.wave * 16384);
              p0_matrix(F.w_ffn_down, DM, DFF, DM, (bf16*)(F.ws + WS_WFD), 0, 0, scr, F.lane, my * NWAVES + F.wave, (rem ? F.G - rem : F.G) * NWAVES); } }
    }
    SEAM(PH_FFI);
    if (IN(PH_FFD)) {
        pg8::Gemm g{(const pg8::bf16_t*)(ws + WS_HID), (const pg8::bf16_t*)(ws + WS_WFD), S, DM, DFF}; pg8::StaticOrder So; So.init(S, DM, F.G, (int)blockIdx.x);
        pg8::EpiT16 E{(pg8::bf16_t*)(ws + WS_T)};
        pg8::gemm_phase<pg8::EpiT16, pg8::StaticOrder, true, true>(F.lds, g, So, E);
    }
    SEAM(PH_FFD);
    if (IN(PH_ROW2)) { REFRESH(); rowpass2(F, blockIdx.x * NWAVES + F.wave, F.G * NWAVES, S); }
#undef IN
#undef SEAM
}

extern "C" void kernel_launch(void* const* d_in, const int* in_sizes, int n_in, void* d_out, int out_size, void* d_ws, size_t ws_size, hipStream_t stream) {
    static int grid = 0;
    if (grid == 0) {
        if (n_in != 14 || out_size != S * DM || ws_size < WS_END) { fprintf(stderr, "kernel_launch: unexpected shapes (n_in %d out %d ws %zu)\n", n_in, out_size, ws_size); grid = -1; return; }
        if (hipFuncSetAttribute((const void*)mega, hipFuncAttributeMaxDynamicSharedMemorySize, LDS_BYTES) != hipSuccess) { fprintf(stderr, "hipFuncSetAttribute failed\n"); grid = -1; return; }
        int dev = 0, cus = 0, per_cu = 0;
        hipGetDevice(&dev); hipDeviceGetAttribute(&cus, hipDeviceAttributeMultiprocessorCount, dev);
        hipOccupancyMaxActiveBlocksPerMultiprocessor(&per_cu, (const void*)mega, NWAVES * 64, LDS_BYTES);
        (void)hipGetLastError();
        if (per_cu < 1) { fprintf(stderr, "occupancy query says %d\n", per_cu); }
        grid = cus;
    }
    if (grid < 0) return;
    Args a{};
    for (int i = 0; i < 14; ++i) a.in[i] = (const float*)d_in[i];
    a.out = (float*)d_out; a.ws = (unsigned char*)d_ws;
    unsigned char* ws = (unsigned char*)d_ws;
    (void)hipMemsetAsync(ws + WS_BAR, 0, BAR_BYTES, stream);
    a.ph_lo = 0; a.ph_hi = PH_N;
    void* kargs[] = {&a};
    hipError_t e = hipLaunchCooperativeKernel((const void*)mega, dim3(grid), dim3(NWAVES * 64), kargs, LDS_BYTES, stream);
    if (e != hipSuccess) fprintf(stderr, "cooperative launch failed: %s (grid %d)\n", hipGetErrorString(e), grid);
}
```

```cpp
#include <hip/hip_runtime.h>
#include <hip/hip_cooperative_groups.h>
#include <cstdio>
#include <cstdint>
namespace cg = cooperative_groups;

constexpr int S = 8192, DM = 2048, AW = 1024, NIN = 11272, DFF = 5632;
constexpr float EPS = 1e-6f;
constexpr float QSCALE = 0.08838834764831845f * 1.4426950408889634f;
constexpr float LOG2E = 1.4426950408889634f;

namespace pg8 {
#define PG8_LAS __attribute__((address_space(3)))
typedef unsigned short bf16_t;
typedef short bf16x8 __attribute__((ext_vector_type(8)));
typedef float f32x4 __attribute__((ext_vector_type(4)));
typedef unsigned u32x4 __attribute__((ext_vector_type(4)));
constexpr int BM = 256, BK = 64, HALF = 128, HTB = HALF * BK * 2  , STAGE_BYTES = 8 * HTB, NXCD = 8, WGM = 8;

__host__ __device__ __forceinline__ int lds_byte(int r, int c) { const int st = (r >> 4) * 2 + (c >> 5), rr = r & 15, cc = c & 31, ob = rr * 64 + cc * 2; return st * 1024 + (ob ^ (((ob >> 9) & 1) << 5)); }
__host__ __device__ __forceinline__ void stage_rc(int b, int& R, int& C) { const int st = b / 1024, sb = b % 1024, swz = sb ^ (((sb >> 9) & 1) << 5); R = (st >> 1) * 16 + swz / 64; C = (st & 1) * 32 + (swz % 64) / 2; }
__host__ __device__ __forceinline__ int perm32(int rho) { const int n = rho >> 4, i = rho & 15; return 8 * (i >> 2) + 4 * n + (i & 3); }

struct Unit { int pm, pn; };
struct Gemm { const bf16_t* A; const bf16_t* Bt; int M, N, K; };

struct StaticOrder {
    int nM, nN, nwg, G, c;
    __host__ __device__ void init(int M, int N, int G_, int c_) { nM = M / BM; nN = N / BM; nwg = nM * nN; G = G_; c = c_; }
    __host__ __device__ bool next(int i, Unit& u) const {
        const long L = (long)i * G + c; if (L >= nwg) return false;
        int wgid = (int)L; { const int q = nwg / NXCD, r = nwg % NXCD, xcd = wgid % NXCD, off = wgid / NXCD; wgid = (xcd < r ? xcd * (q + 1) : r * (q + 1) + (xcd - r) * q) + off; }
        const int nig = WGM * nN, gid = wgid / nig, fm = gid * WGM, gsz = (nM - fm) < WGM ? (nM - fm) : WGM;
        u.pm = fm + ((wgid % nig) % gsz); u.pn = (wgid % nig) / gsz; return true;
    }
    __device__ __forceinline__ void a_ready(const Unit&) const {}
    __device__ __forceinline__ void done(const Unit&) const {}
};

typedef float f32x2_cv __attribute__((ext_vector_type(2))); typedef __bf16 bf16x2_cv __attribute__((ext_vector_type(2)));
__device__ __forceinline__ unsigned cvt_pk_bf16(float lo, float hi) { f32x2_cv v = {lo, hi}; bf16x2_cv b = __builtin_convertvector(v, bf16x2_cv); return __builtin_bit_cast(unsigned, b); }
typedef unsigned u32x2 __attribute__((ext_vector_type(2)));
__device__ __forceinline__ float bf_lo(unsigned w) { return __uint_as_float(w << 16); }
__device__ __forceinline__ float bf_hi(unsigned w) { return __uint_as_float(w & 0xffff0000u); }
__device__ __forceinline__ float sigmoidf_(float z) { return 1.f / (1.f + __expf(-z)); }

struct EpiProj {
    static constexpr bool PERM = true, AFTER_DRAIN = false, HAS_MID = false;
    bf16_t* proj; float* alf; bf16_t* gab; const float* lb; unsigned* kmax;
    template <int MODE>
    __device__ __forceinline__ void tile(const f32x4 (&acc)[2][2][4][2], bf16_t* base, int ldc, int row0, int col0) const {
        float lbv[2][8];
        if (MODE == 1) {
#pragma unroll
            for (int bj = 0; bj < 2; ++bj)
#pragma unroll
                for (int j = 0; j < 8; ++j) lbv[bj][j] = lb[col0 + bj * HALF + j];
        }
#pragma unroll
        for (int ai = 0; ai < 2; ++ai)
#pragma unroll
            for (int m = 0; m < 4; ++m) {
                const size_t ro = (size_t)(row0 + ai * HALF + m * 16) * ldc + col0;
#pragma unroll
                for (int bj = 0; bj < 2; ++bj) {
                    float v[8];
#pragma unroll
                    for (int j = 0; j < 4; ++j) { v[j] = acc[ai][bj][m][0][j]; v[4 + j] = acc[ai][bj][m][1][j]; }
                    if (MODE == 1) {
                        float lf[8];
#pragma unroll
                        for (int j = 0; j < 8; ++j) {
                            const float z = v[j], l = lbv[bj][j];
                            const float t = __expf(-z), sg = __builtin_amdgcn_rcpf(1.f + t), sn = (t > 3.0e38f) ? 1.f : t * sg;
                            lf[j] = __logf(l + (1.f - l) * sg); v[j] = (1.f - l) * sn;
                        }
                        float* ap = alf + ro + bj * HALF;
                        *(f32x4*)ap = (f32x4){lf[0], lf[1], lf[2], lf[3]}; *(f32x4*)(ap + 4) = (f32x4){lf[4], lf[5], lf[6], lf[7]};
                    } else if (MODE == 2) {
#pragma unroll
                        for (int j = 0; j < 8; ++j) v[j] *= QSCALE;
                    } else if (MODE == 3) {
#pragma unroll
                        for (int j = 0; j < 8; ++j) v[j] = __builtin_amdgcn_rcpf(1.f + __expf(-v[j]));
                    }
                    u32x4 w; w.x = cvt_pk_bf16(v[0], v[1]); w.y = cvt_pk_bf16(v[2], v[3]); w.z = cvt_pk_bf16(v[4], v[5]); w.w = cvt_pk_bf16(v[6], v[7]);
                    *(u32x4*)(base + ro + bj * HALF) = w;
                }
            }
    }
    __device__ __forceinline__ void operator()(const f32x4 (&acc)[2][2][4][2], const Unit& u, int wr, int wc, int fr, int fq) const {
        const int pn = u.pn; const int row0 = u.pm * BM + wr * 64 + fr;
        if (pn < 28) {
            const int grp = pn >> 2; bf16_t* base = proj + (size_t)grp * ((size_t)S * 1024); const int col0 = (pn & 3) * 256 + wc * 32 + 8 * fq;
            if (grp == 1) tile<1>(acc, base, 1024, row0, col0); else if (grp == 4) tile<2>(acc, base, 1024, row0, col0); else tile<0>(acc, base, 1024, row0, col0);
            if (grp == 5) {
                float mx[2] = {0.f, 0.f};
#pragma unroll
                for (int ai = 0; ai < 2; ++ai)
#pragma unroll
                    for (int bj = 0; bj < 2; ++bj)
#pragma unroll
                        for (int m = 0; m < 4; ++m)
#pragma unroll
                            for (int n = 0; n < 2; ++n)
#pragma unroll
                                for (int j = 0; j < 4; ++j) mx[bj] = fmaxf(mx[bj], fabsf(acc[ai][bj][m][n][j]));
#pragma unroll
                for (int bj = 0; bj < 2; ++bj) {
#pragma unroll
                    for (int o = 1; o < 64; o <<= 1) mx[bj] = fmaxf(mx[bj], __shfl_xor(mx[bj], o));
                    if ((fr | (fq << 4)) == 0) __hip_atomic_fetch_max(kmax + 2 * (pn & 3) + bj, __float_as_uint(mx[bj]), __ATOMIC_RELAXED, __HIP_MEMORY_SCOPE_AGENT);
                }
            }
        } else {
            const int col0 = (pn - 28) * HALF + wc * 32 + 8 * fq; bf16_t* rbuf = gab; bf16_t* sbuf = gab + (size_t)S * 2048;
#pragma unroll
            for (int ai = 0; ai < 2; ++ai)
#pragma unroll
                for (int m = 0; m < 4; ++m) { const size_t ro = (size_t)(row0 + ai * HALF + m * 16) * 2048 + col0;
                    float r[8], sb[8];
#pragma unroll
                    for (int j = 0; j < 8; ++j) { const float ga_ = acc[ai][0][m][j >> 2][j & 3], gb_ = acc[ai][1][m][j >> 2][j & 3];
                        const float ta = __expf(-ga_), tb = fminf(__expf(-gb_), 1e30f);
                        sb[j] = __builtin_amdgcn_rcpf(1.f + tb); r[j] = (1.f + tb) * __builtin_amdgcn_rcpf(1.f + ta); }
                    u32x4 w; w.x = cvt_pk_bf16(r[0], r[1]); w.y = cvt_pk_bf16(r[2], r[3]); w.z = cvt_pk_bf16(r[4], r[5]); w.w = cvt_pk_bf16(r[6], r[7]);
                    *(u32x4*)(rbuf + ro) = w;
                    w.x = cvt_pk_bf16(sb[0], sb[1]); w.y = cvt_pk_bf16(sb[2], sb[3]); w.z = cvt_pk_bf16(sb[4], sb[5]); w.w = cvt_pk_bf16(sb[6], sb[7]);
                    *(u32x4*)(sbuf + ro) = w; }
        }
    }
};
struct EpiUp {
    static constexpr bool PERM = true, AFTER_DRAIN = false, HAS_MID = true;
    const bf16_t* ga; const bf16_t* gb; bf16_t* mg;
    __device__ __forceinline__ void mid(f32x4 (&acc)[2][2][4][2], const Unit& u, int wr, int wc, int fr, int fq) const {
        asm volatile("" : "+v"(fr), "+v"(fq));
        const int row0 = u.pm * BM + wr * 64 + fr, col0 = u.pn * BM + wc * 32 + 8 * fq;
        u32x4 av[2][4][2];
#pragma unroll
        for (int ai = 0; ai < 2; ++ai)
#pragma unroll
            for (int m = 0; m < 4; ++m)
#pragma unroll
                for (int bj = 0; bj < 2; ++bj) av[ai][m][bj] = *(const u32x4*)(ga + (size_t)(row0 + ai * HALF + m * 16) * DM + col0 + bj * HALF);
#pragma unroll
        for (int ai = 0; ai < 2; ++ai)
#pragma unroll
            for (int m = 0; m < 4; ++m)
#pragma unroll
                for (int bj = 0; bj < 2; ++bj)
#pragma unroll
                    for (int q = 0; q < 4; ++q) { const unsigned aw = av[ai][m][bj][q];
                        acc[ai][bj][m][q >> 1][2 * (q & 1)] *= bf_lo(aw); acc[ai][bj][m][q >> 1][2 * (q & 1) + 1] *= bf_hi(aw); }
        asm volatile("" ::: "memory");
    }
    __device__ __forceinline__ void operator()(const f32x4 (&acc)[2][2][4][2], const Unit& u, int wr, int wc, int fr, int fq) const {
        const int row0 = u.pm * BM + wr * 64 + fr, col0 = u.pn * BM + wc * 32 + 8 * fq;
#pragma unroll
        for (int ai = 0; ai < 2; ++ai) {
            u32x4 gv[4][2];
#pragma unroll
            for (int m = 0; m < 4; ++m)
#pragma unroll
                for (int bj = 0; bj < 2; ++bj) gv[m][bj] = *(const u32x4*)(gb + (size_t)(row0 + ai * HALF + m * 16) * DM + col0 + bj * HALF);
#pragma unroll
            for (int m = 0; m < 4; ++m)
#pragma unroll
                for (int bj = 0; bj < 2; ++bj) { const size_t ro = (size_t)(row0 + ai * HALF + m * 16) * DM + col0 + bj * HALF;
                    const u32x4 gq = gv[m][bj];
                    float v[8];
#pragma unroll
                    for (int j = 0; j < 4; ++j) { v[j] = acc[ai][bj][m][0][j]; v[4 + j] = acc[ai][bj][m][1][j]; }
                    v[0] *= bf_lo(gq.x); v[1] *= bf_hi(gq.x); v[2] *= bf_lo(gq.y); v[3] *= bf_hi(gq.y); v[4] *= bf_lo(gq.z); v[5] *= bf_hi(gq.z); v[6] *= bf_lo(gq.w); v[7] *= bf_hi(gq.w);
                    u32x4 w; w.x = cvt_pk_bf16(v[0], v[1]); w.y = cvt_pk_bf16(v[2], v[3]); w.z = cvt_pk_bf16(v[4], v[5]); w.w = cvt_pk_bf16(v[6], v[7]);
                    *(u32x4*)(mg + ro) = w; }
        }
    }
};
struct EpiT16 {
    static constexpr bool PERM = true, AFTER_DRAIN = false, HAS_MID = false;
    bf16_t* O;
    __device__ __forceinline__ void operator()(const f32x4 (&acc)[2][2][4][2], const Unit& u, int wr, int wc, int fr, int fq) const {
        const int row0 = u.pm * BM + wr * 64 + fr, col0 = u.pn * BM + wc * 32 + 8 * fq;
#pragma unroll
        for (int ai = 0; ai < 2; ++ai)
#pragma unroll
            for (int m = 0; m < 4; ++m)
#pragma unroll
                for (int bj = 0; bj < 2; ++bj) { const f32x4 v0 = acc[ai][bj][m][0], v1 = acc[ai][bj][m][1];
                    u32x4 w; w.x = cvt_pk_bf16(v0[0], v0[1]); w.y = cvt_pk_bf16(v0[2], v0[3]); w.z = cvt_pk_bf16(v1[0], v1[1]); w.w = cvt_pk_bf16(v1[2], v1[3]);
                    *(u32x4*)(O + (size_t)(row0 + ai * HALF + m * 16) * DM + col0 + bj * HALF) = w; }
    }
};
struct EpiF32 {
    static constexpr bool PERM = false, AFTER_DRAIN = false, HAS_MID = false;
    float* O; int ldc;
    __device__ __forceinline__ void operator()(const f32x4 (&acc)[2][2][4][2], const Unit& u, int wr, int wc, int fr, int fq) const {
        const int row0 = u.pm * BM + wr * 64 + fr, col0 = u.pn * BM + wc * 32 + 4 * fq;
#pragma unroll
        for (int ai = 0; ai < 2; ++ai)
#pragma unroll
            for (int m = 0; m < 4; ++m) {
                float* rp = O + (size_t)(row0 + ai * HALF + m * 16) * ldc + col0;
#pragma unroll
                for (int bj = 0; bj < 2; ++bj)
#pragma unroll
                    for (int n = 0; n < 2; ++n) *(f32x4*)(rp + bj * HALF + n * 16) = acc[ai][bj][m][n];
            }
    }
};
struct EpiSwiglu {
    static constexpr bool PERM = true, AFTER_DRAIN = false, HAS_MID = false;
    bf16_t* hid;
    __device__ __forceinline__ void operator()(const f32x4 (&acc)[2][2][4][2], const Unit& u, int wr, int wc, int fr, int fq) const {
        const int row0 = u.pm * BM + wr * 64 + fr, col0 = u.pn * HALF + wc * 32 + 8 * fq;
#pragma unroll
        for (int ai = 0; ai < 2; ++ai)
#pragma unroll
            for (int m = 0; m < 4; ++m) {
                float v[8];
#pragma unroll
                for (int j = 0; j < 4; ++j) { const float g0 = acc[ai][0][m][0][j], g1 = acc[ai][0][m][1][j];
                    v[j] = g0 / (1.f + __expf(-g0)) * acc[ai][1][m][0][j]; v[4 + j] = g1 / (1.f + __expf(-g1)) * acc[ai][1][m][1][j]; }
                u32x4 w; w.x = cvt_pk_bf16(v[0], v[1]); w.y = cvt_pk_bf16(v[2], v[3]); w.z = cvt_pk_bf16(v[4], v[5]); w.w = cvt_pk_bf16(v[6], v[7]);
                *(u32x4*)(hid + (size_t)(row0 + ai * HALF + m * 16) * DFF + col0) = w;
            }
    }
};

template <class Epi, class Sched, bool ALIGN_EPI = false, bool SP2 = false>
__device__ __forceinline__ void gemm_phase(PG8_LAS unsigned char* lds, const Gemm g, const Sched& S, const Epi& E) {
    const int tid = threadIdx.x, wid = __builtin_amdgcn_readfirstlane(tid >> 6), lane = tid & 63, wr = wid >> 2, wc = wid & 3, fr = lane & 15, fq = lane >> 4;
    const int K = g.K, nt = K / BK;
    unsigned voffA[2], voffB[2];
#pragma unroll
    for (int i = 0; i < 2; ++i) { int R, C; stage_rc(tid * 16 + i * 8192, R, C); const int Rb = Epi::PERM ? ((R & ~31) + perm32(R & 31)) : R;
        voffA[i] = (unsigned)(R * K + C) * 2u; voffB[i] = (unsigned)(Rb * K + C) * 2u; }
    const size_t kstep = (size_t)(BK * 2);
    const size_t hstep = (size_t)HALF * K * 2;
    const size_t tstep = 2 * hstep;
    const unsigned ldsw = (unsigned)wid * 1024u;
    const int aoff = lds_byte(wr * 64 + fr, fq * 8), boff = lds_byte(wc * 32 + fr, fq * 8);
#define PG8_SA(b, h) (((b) * 2 + (h)) * HTB)
#define PG8_SB(b, h) ((4 + (b) * 2 + (h)) * HTB)
#define PG8_STAGE(bufoff, gbase, voff) do { _Pragma("unroll") for (int _i = 0; _i < 2; ++_i) \
        __builtin_amdgcn_global_load_lds((const unsigned*)((const char*)(gbase) + (voff)[_i]), (PG8_LAS unsigned*)(lds + (bufoff) + ldsw + _i * 8192), 16, 0, 0); } while (0)
#define PG8_LDA(dst, b, h) do { _Pragma("unroll") for (int m = 0; m < 4; ++m) _Pragma("unroll") for (int k = 0; k < 2; ++k) dst[m][k] = *(const PG8_LAS bf16x8*)(lds + PG8_SA(b, h) + aoff + m * 2048 + k * 1024); } while (0)
#define PG8_LDB(dst, b, h) do { _Pragma("unroll") for (int n = 0; n < 2; ++n) _Pragma("unroll") for (int k = 0; k < 2; ++k) dst[n][k] = *(const PG8_LAS bf16x8*)(lds + PG8_SB(b, h) + boff + n * 2048 + k * 1024); } while (0)
#define PG8_MMA(ai, bj, At, Bt) do { __builtin_amdgcn_s_setprio(1); _Pragma("unroll") for (int m = 0; m < 4; ++m) _Pragma("unroll") for (int n = 0; n < 2; ++n) _Pragma("unroll") for (int k = 0; k < 2; ++k) \
        acc[ai][bj][m][n] = __builtin_amdgcn_mfma_f32_16x16x32_bf16(Bt[n][k], At[m][k], acc[ai][bj][m][n], 0, 0, 0); __builtin_amdgcn_s_setprio(0); } while (0)
#define PG8_WAIT_V(n) asm volatile("s_waitcnt vmcnt(" #n ")" ::: "memory")
#define PG8_WAIT_L(n) asm volatile("s_waitcnt lgkmcnt(" #n ")" ::: "memory")
#define PG8_BAR __builtin_amdgcn_s_barrier()
#define PG8_SCHED __builtin_amdgcn_sched_barrier(0)
    Unit cur, nxt; int ui = 0;
    if (!S.next(0, cur)) return;
    f32x4 acc[2][2][4][2];
#pragma unroll
    for (int a = 0; a < 2; ++a)
#pragma unroll
        for (int b = 0; b < 2; ++b)
#pragma unroll
            for (int m = 0; m < 4; ++m)
#pragma unroll
                for (int n = 0; n < 2; ++n) acc[a][b][m][n] = (f32x4){0.f, 0.f, 0.f, 0.f};
    bf16x8 At[4][2], B0[2][2], B1[2][2];
    const char* cA = (const char*)g.A + (size_t)cur.pm * tstep; const char* cB = (const char*)g.Bt + (size_t)cur.pn * tstep;
    S.a_ready(cur);
    if constexpr (SP2) {
        PG8_STAGE(PG8_SB(0, 0), cB, voffB); PG8_STAGE(PG8_SB(0, 1), cB + hstep, voffB); PG8_STAGE(PG8_SA(0, 0), cA, voffA); PG8_STAGE(PG8_SA(0, 1), cA + hstep, voffA);
        if (wr == 1) PG8_BAR;
        PG8_WAIT_V(2); PG8_BAR;
        PG8_STAGE(PG8_SB(1, 0), cB + kstep, voffB); PG8_STAGE(PG8_SA(1, 0), cA + kstep, voffA); PG8_STAGE(PG8_SB(1, 1), cB + hstep + kstep, voffB);
        PG8_WAIT_V(6); PG8_BAR;
    } else {
        PG8_STAGE(PG8_SB(0, 0), cB, voffB); PG8_STAGE(PG8_SA(0, 0), cA, voffA); PG8_STAGE(PG8_SB(0, 1), cB + hstep, voffB); PG8_STAGE(PG8_SA(0, 1), cA + hstep, voffA);
        if (wr == 1) PG8_BAR;
        PG8_WAIT_V(4); PG8_BAR;
        PG8_STAGE(PG8_SB(1, 0), cB + kstep, voffB); PG8_STAGE(PG8_SA(1, 0), cA + kstep, voffA); PG8_STAGE(PG8_SB(1, 1), cB + hstep + kstep, voffB);
        PG8_WAIT_V(6); PG8_BAR;
    }
    for (;;) {
        const bool has_next = S.next(ui + 1, nxt);
        const char* nA = has_next ? (const char*)g.A + (size_t)nxt.pm * tstep : cA; const char* nB = has_next ? (const char*)g.Bt + (size_t)nxt.pn * tstep : cB;
        for (int t = 0; t < nt; t += 2) {
            if constexpr (Epi::HAS_MID) { if (t == (nt >> 1)) E.mid(acc, cur, wr, wc, fr, fq); }
            const bool last = (t == nt - 2);
            const char* a1 = cA + (size_t)(t + 1) * kstep;
            const char* a2 = last ? nA : cA + (size_t)(t + 2) * kstep; const char* b2 = last ? nB : cB + (size_t)(t + 2) * kstep;
            const char* a3 = a2 + kstep; const char* b3 = b2 + kstep;
            if (last && has_next) S.a_ready(nxt);
            if constexpr (SP2) {
            PG8_LDB(B0, 0, 0); PG8_LDB(B1, 0, 1); PG8_SCHED; PG8_LDA(At, 0, 0); PG8_STAGE(PG8_SA(1, 1), a1 + hstep, voffA);
            PG8_WAIT_V(8); PG8_WAIT_L(0); PG8_BAR; PG8_MMA(0, 0, At, B0); PG8_MMA(0, 1, At, B1); PG8_BAR; PG8_SCHED;
            PG8_LDA(At, 0, 1); PG8_STAGE(PG8_SB(0, 0), b2, voffB); PG8_STAGE(PG8_SB(0, 1), b2 + hstep, voffB); PG8_STAGE(PG8_SA(0, 0), a2, voffA);
            PG8_WAIT_V(8); PG8_WAIT_L(0); PG8_BAR; PG8_MMA(1, 0, At, B0); PG8_MMA(1, 1, At, B1); PG8_BAR; PG8_SCHED;
            PG8_LDB(B0, 1, 0); PG8_LDB(B1, 1, 1); PG8_SCHED; PG8_LDA(At, 1, 0); PG8_STAGE(PG8_SA(0, 1), a2 + hstep, voffA);
            PG8_WAIT_V(8); PG8_WAIT_L(0); PG8_BAR; PG8_MMA(0, 0, At, B0); PG8_MMA(0, 1, At, B1); PG8_BAR; PG8_SCHED;
            PG8_LDA(At, 1, 1); PG8_STAGE(PG8_SB(1, 0), b3, voffB); PG8_STAGE(PG8_SB(1, 1), b3 + hstep, voffB); PG8_STAGE(PG8_SA(1, 0), a3, voffA);
            PG8_WAIT_V(8); PG8_WAIT_L(0); PG8_BAR; PG8_MMA(1, 0, At, B0); PG8_MMA(1, 1, At, B1); PG8_BAR; PG8_SCHED;
            } else {
            PG8_LDB(B0, 0, 0); PG8_SCHED; PG8_LDA(At, 0, 0); PG8_STAGE(PG8_SA(1, 1), a1 + hstep, voffA);
            PG8_WAIT_L(8); PG8_BAR; PG8_WAIT_L(0); PG8_MMA(0, 0, At, B0); PG8_BAR; PG8_SCHED;
            PG8_LDB(B1, 0, 1); PG8_STAGE(PG8_SB(0, 0), b2, voffB);
            PG8_BAR; PG8_WAIT_L(0); PG8_MMA(0, 1, At, B1); PG8_BAR;
            PG8_LDA(At, 0, 1); PG8_STAGE(PG8_SA(0, 0), a2, voffA);
            PG8_BAR; PG8_WAIT_L(0); PG8_MMA(1, 0, At, B0); PG8_BAR; PG8_SCHED;
            PG8_STAGE(PG8_SB(0, 1), b2 + hstep, voffB);
            PG8_WAIT_V(6); PG8_BAR; PG8_MMA(1, 1, At, B1); PG8_BAR;
            PG8_LDB(B0, 1, 0); PG8_SCHED; PG8_LDA(At, 1, 0); PG8_STAGE(PG8_SA(0, 1), a2 + hstep, voffA);
            PG8_WAIT_L(8); PG8_BAR; PG8_WAIT_L(0); PG8_MMA(0, 0, At, B0); PG8_BAR; PG8_SCHED;
            PG8_LDB(B1, 1, 1); PG8_STAGE(PG8_SB(1, 0), b3, voffB);
            PG8_BAR; PG8_WAIT_L(0); PG8_MMA(0, 1, At, B1); PG8_BAR;
            PG8_LDA(At, 1, 1); PG8_STAGE(PG8_SA(1, 0), a3, voffA);
            PG8_BAR; PG8_WAIT_L(0); PG8_MMA(1, 0, At, B0); PG8_BAR; PG8_SCHED;
            PG8_STAGE(PG8_SB(1, 1), b3 + hstep, voffB);
            PG8_WAIT_V(6); PG8_BAR; PG8_MMA(1, 1, At, B1); PG8_BAR;
            }
        }
        if constexpr (ALIGN_EPI) { if (wr == 0) PG8_BAR; }
        if constexpr (!Epi::AFTER_DRAIN) { E(acc, cur, wr, wc, fr, fq); S.done(cur); }
        if (!has_next) break;
#pragma unroll
        for (int a = 0; a < 2; ++a)
#pragma unroll
            for (int b = 0; b < 2; ++b)
#pragma unroll
                for (int m = 0; m < 4; ++m)
#pragma unroll
                    for (int n = 0; n < 2; ++n) acc[a][b][m][n] = (f32x4){0.f, 0.f, 0.f, 0.f};
        cur = nxt; cA = nA; cB = nB; ++ui;
        if constexpr (ALIGN_EPI) { if (wr == 1) PG8_BAR; }
    }
    PG8_WAIT_V(0);
    if constexpr (!ALIGN_EPI) { if (wr == 0) PG8_BAR; }
    PG8_BAR;
    if constexpr (Epi::AFTER_DRAIN) { E.fused(acc, cur, wr, wc, fr, fq, lds, wid, lane); S.done(cur); }
#undef PG8_SA
#undef PG8_SB
#undef PG8_STAGE
#undef PG8_LDA
#undef PG8_LDB
#undef PG8_MMA
#undef PG8_WAIT_V
#undef PG8_WAIT_L
#undef PG8_BAR
#undef PG8_SCHED
}
}

#include <hip/hip_bf16.h>
namespace fox {
constexpr int D = 128, PITCH = 1024, OPITCH = 2048;
constexpr float THR2 = 11.5f, LOG2E_ = 1.4426950408889634f;
constexpr bool WSKIP = false;
constexpr int NW = 8, QBLK = 32, KVBLK = 64, QB = NW * QBLK;
constexpr int SHM_V = KVBLK * D * 2, SHM_K = KVBLK * D * 2;
constexpr int LDS_BYTES = 2 * SHM_V + 2 * SHM_K + NW * 64 * 4;

using bf16 = __hip_bfloat16;
typedef short bf16x8 __attribute__((ext_vector_type(8)));
typedef short s16x4 __attribute__((ext_vector_type(4)));
typedef float f32x16 __attribute__((ext_vector_type(16)));
typedef float f32x4 __attribute__((ext_vector_type(4)));
typedef unsigned u32x4 __attribute__((ext_vector_type(4)));
template <class A, class Bt> struct same_t { static constexpr bool v = false; };
template <class A> struct same_t<A, A> { static constexpr bool v = true; };

#define KSWZ(row, colB) ((row) * 256 + ((colB) ^ (((row) & 7) << 4)))
#define SBAR() __builtin_amdgcn_sched_barrier(0)
__device__ __forceinline__ int v_st(int k, int c) { const int kk = (k & ~0xC) | ((k & 4) << 1) | ((k & 8) >> 1); return ((kk >> 3) * 4 + (c >> 5)) * 512 + ((kk & 7) * 32 + (c & 31)) * 2; }
__device__ __forceinline__ int v_rd_base(int lane) { return ((lane & 3) << 3) | (((lane >> 2) & 3) << 6) | (((lane >> 4) & 1) << 5) | (((lane >> 5) & 1) << 8); }
constexpr int v_rd_off(int d0, int ks, int half) { return d0 * 512 + ks * 4096 + half * 2048; }
__device__ __forceinline__ int crow(int r, int hi) { return (r & 3) + 8 * (r >> 2) + 4 * hi; }
__device__ __forceinline__ unsigned cvtpk(float lo, float hi) {
    unsigned r; asm volatile("v_cvt_pk_bf16_f32 %0, %1, %2" : "=v"(r) : "v"(lo), "v"(hi)); return r;
}
__device__ __forceinline__ bf16x8 pack8(f32x4 a, f32x4 b) {
    u32x4 w = {cvtpk(a[0], a[1]), cvtpk(a[2], a[3]), cvtpk(b[0], b[1]), cvtpk(b[2], b[3])};
    return *reinterpret_cast<bf16x8*>(&w);
}
template <class T> __device__ __forceinline__ bf16x8 load8(const T* p) {
    if constexpr (same_t<T, float>::v) { return pack8(*(const f32x4*)p, *(const f32x4*)(p + 4)); }
    else { return *reinterpret_cast<const bf16x8*>(p); }
}
__device__ __forceinline__ void mask_tile(f32x16& p0, f32x16& p1, int dq, unsigned W) {
    const float NEG = -__builtin_inff();
#pragma unroll
    for (int r = 0; r < 16; ++r) {
        const int c = (r & 3) + 8 * (r >> 2);
        if ((unsigned)(dq - c) >= W) p0[r] = NEG;
        if ((unsigned)(dq - c - 32) >= W) p1[r] = NEG;
    }
}
__device__ __forceinline__ void partialSM(f32x16& p0, f32x16& p1, float& m_reg, float& mn, float& alpha, const __attribute__((address_space(3))) float* cbt) {
    SBAR();
#pragma unroll
    for (int g = 0; g < 4; ++g) { const f32x4 b0 = *(const __attribute__((address_space(3))) f32x4*)(cbt + 8 * g), b1 = *(const __attribute__((address_space(3))) f32x4*)(cbt + 32 + 8 * g);
        p0[4 * g] += b0[0]; p0[4 * g + 1] += b0[1]; p0[4 * g + 2] += b0[2]; p0[4 * g + 3] += b0[3];
        p1[4 * g] += b1[0]; p1[4 * g + 1] += b1[1]; p1[4 * g + 2] += b1[2]; p1[4 * g + 3] += b1[3]; }
    float pmax = p0[0]; for (int r = 1; r < 16; ++r) pmax = fmaxf(pmax, p0[r]); for (int r = 0; r < 16; ++r) pmax = fmaxf(pmax, p1[r]);
    { auto rr = __builtin_amdgcn_permlane32_swap(__float_as_uint(pmax), __float_as_uint(pmax), false, false);
      pmax = fmaxf(__uint_as_float(rr[0]), __uint_as_float(rr[1])); }
    if (__builtin_expect(__all((pmax - m_reg) <= THR2), 1)) { mn = m_reg; alpha = 1.f; }
    else { mn = fmaxf(m_reg, pmax); alpha = __builtin_amdgcn_exp2f(m_reg - mn); m_reg = mn; }
    for (int r = 0; r < 16; ++r) p0[r] = p0[r] - mn; for (int r = 0; r < 16; ++r) p1[r] = p1[r] - mn;
    for (int r = 0; r < 16; ++r) p0[r] = __builtin_amdgcn_exp2f(p0[r]);
}
__device__ __forceinline__ void finishSM(f32x16& p0, f32x16& p1, float alpha, float& l_reg, bf16x8& pa0, bf16x8& pa1, bf16x8& pa2, bf16x8& pa3) {
    for (int r = 0; r < 16; ++r) p1[r] = __builtin_amdgcn_exp2f(p1[r]);
    float ps = 0; for (int r = 0; r < 16; ++r) ps += p0[r]; for (int r = 0; r < 16; ++r) ps += p1[r];
    { auto rr = __builtin_amdgcn_permlane32_swap(__float_as_uint(ps), __float_as_uint(ps), false, false);
      ps = __uint_as_float(rr[0]) + __uint_as_float(rr[1]); }
    l_reg = l_reg * alpha + ps;
#define PK4(P, B_, OUT) do { unsigned a0 = cvtpk(P[B_+0], P[B_+1]), a1 = cvtpk(P[B_+2], P[B_+3]);                          \
        unsigned b0 = cvtpk(P[B_+4], P[B_+5]), b1 = cvtpk(P[B_+6], P[B_+7]);                                             \
        auto r0 = __builtin_amdgcn_permlane32_swap(a0, b0, false, false); auto r1 = __builtin_amdgcn_permlane32_swap(a1, b1, false, false); \
        u32x4 w = {r0[0], r1[0], r0[1], r1[1]}; OUT = *reinterpret_cast<bf16x8*>(&w); } while (0)
    PK4(p0, 0, pa0); PK4(p0, 8, pa1); PK4(p1, 0, pa2); PK4(p1, 8, pa3);
#undef PK4
}
template <int KB, bool SK>
__device__ __forceinline__ void qkt(f32x16& p0, f32x16& p1, const char* K_lds, int r32, int hi, const bf16x8* qr, bool act) {
    if (SK && !act) { const float NEG = -__builtin_inff();
#pragma unroll
        for (int r = 0; r < 16; ++r) { p0[r] = NEG; p1[r] = NEG; } return; }
    p0 = f32x16{}; p1 = f32x16{};
    const char* kb[4];
#pragma unroll
    for (int dd = 0; dd < 4; ++dd) kb[dd] = K_lds + KB * SHM_K + KSWZ(r32, (dd * 16 + hi * 8) * 2);
#pragma unroll
    for (int d0 = 0; d0 < 8; ++d0) { const char* a = kb[d0 & 3] + (d0 >> 2) * 128;
        bf16x8 b0 = *reinterpret_cast<const bf16x8*>(a);
        bf16x8 b1 = *reinterpret_cast<const bf16x8*>(a + 32 * 256);
        p0 = __builtin_amdgcn_mfma_f32_32x32x16_bf16(b0, qr[d0], p0, 0, 0, 0);
        p1 = __builtin_amdgcn_mfma_f32_32x32x16_bf16(b1, qr[d0], p1, 0, 0, 0); }
}
template <int VB, bool SK>
__device__ __forceinline__ void pv_tile(f32x16* o, int vb0, bf16x8 pa0, bf16x8 pa1, bf16x8 pa2, bf16x8 pa3, bool act) {
    if (SK && !act) return;
#define TRRD(dst, off) asm volatile("ds_read_b64_tr_b16 %0, %1 offset:%2" : "=&v"(dst) : "v"(vb0), "i"(off) : "memory")
#define PV_D0(d0) do { s16x4 l0, l1, l2, l3, h0, h1, h2, h3; constexpr int b_ = VB * SHM_V + v_rd_off(d0, 0, 0);     \
        TRRD(l0, b_); TRRD(h0, b_ + 2048); TRRD(l1, b_ + 4096); TRRD(h1, b_ + 6144); TRRD(l2, b_ + 8192); TRRD(h2, b_ + 10240); TRRD(l3, b_ + 12288); TRRD(h3, b_ + 14336); \
        asm volatile("s_waitcnt lgkmcnt(0)" ::: "memory"); SBAR();                 \
        o[d0] = __builtin_amdgcn_mfma_f32_32x32x16_bf16(pa0, (bf16x8){l0[0], l0[1], l0[2], l0[3], h0[0], h0[1], h0[2], h0[3]}, o[d0], 0, 0, 0);   \
        o[d0] = __builtin_amdgcn_mfma_f32_32x32x16_bf16(pa1, (bf16x8){l1[0], l1[1], l1[2], l1[3], h1[0], h1[1], h1[2], h1[3]}, o[d0], 0, 0, 0);   \
        o[d0] = __builtin_amdgcn_mfma_f32_32x32x16_bf16(pa2, (bf16x8){l2[0], l2[1], l2[2], l2[3], h2[0], h2[1], h2[2], h2[3]}, o[d0], 0, 0, 0);   \
        o[d0] = __builtin_amdgcn_mfma_f32_32x32x16_bf16(pa3, (bf16x8){l3[0], l3[1], l3[2], l3[3], h3[0], h3[1], h3[2], h3[3]}, o[d0], 0, 0, 0); } while (0)
    PV_D0(0); PV_D0(1); PV_D0(2); PV_D0(3);
#undef PV_D0
#undef TRRD
}

template <class TIn, class TOut> struct BlockRef { const TIn* Q; const TIn* K; const TIn* V; TOut* O; const float* C; int P0; int JLO; };
template <class TIn> struct Seam {
    bf16x8 qr[8];
    bf16x8 st_v0, st_v1, st_k0, st_k1; f32x4 sf0, sf1, sf2, sf3;
    f32x4 tq[16];
};
__device__ __forceinline__ int swa_jlo(int P0, int W) { const int lowk = P0 - W + 1; return lowk > 0 ? lowk / KVBLK : 0; }
#define ROW(p, k0, rr) ((p) + (size_t)((k0) + (rr)) * PITCH + sc)
#define VMW() asm volatile("s_waitcnt vmcnt(0)" ::: "memory")
#define VMWN(n) asm volatile("s_waitcnt vmcnt(%0)" :: "i"(n) : "memory")
#define SLOAD_H(Kp, Vp, k0) do { S.st_v0 = load8<TIn>(ROW(Vp, k0, sr)); S.st_v1 = load8<TIn>(ROW(Vp, k0, 32 + sr));              \
                         S.st_k0 = load8<TIn>(ROW(Kp, k0, sr)); S.st_k1 = load8<TIn>(ROW(Kp, k0, 32 + sr)); } while (0)
#define SWRITE_HK(bf) do { *(bf16x8*)(K_lds + (bf) * SHM_K + kws) = S.st_k0; *(bf16x8*)(K_lds + (bf) * SHM_K + kws + 32 * 256) = S.st_k1; } while (0)
#define SWRITE_HV(bf) do { *(bf16x8*)(V_lds + (bf) * SHM_V + vst0) = S.st_v0; *(bf16x8*)(V_lds + (bf) * SHM_V + vst1) = S.st_v1; } while (0)
#define SWRITE_H(bf) do { SWRITE_HV(bf); SWRITE_HK(bf); } while (0)
#define SLOAD_F(p, k0) do { S.sf0 = *(const f32x4*)ROW(p, k0, sr); S.sf1 = *(const f32x4*)(ROW(p, k0, sr) + 4);                \
                            S.sf2 = *(const f32x4*)ROW(p, k0, 32 + sr); S.sf3 = *(const f32x4*)(ROW(p, k0, 32 + sr) + 4); } while (0)
#define SWRITE_KF(bf) do { *(bf16x8*)(K_lds + (bf) * SHM_K + kws) = pack8(S.sf0, S.sf1); *(bf16x8*)(K_lds + (bf) * SHM_K + kws + 32 * 256) = pack8(S.sf2, S.sf3); } while (0)
#define SWRITE_VF(bf) do { *(bf16x8*)(V_lds + (bf) * SHM_V + vst0) = pack8(S.sf0, S.sf1); *(bf16x8*)(V_lds + (bf) * SHM_V + vst1) = pack8(S.sf2, S.sf3); } while (0)
template <class TIn, class TOut>
__device__ __forceinline__ void causal_swa_prime(const BlockRef<TIn, TOut>& cur, int W, char* lds, Seam<TIn>& S) {
    constexpr bool F32 = same_t<TIn, float>::v;
    const int tid = threadIdx.x, wid = __builtin_amdgcn_readfirstlane(tid >> 6), lane = tid & 63, r32 = lane & 31, hi = lane >> 5;
    const int sr = tid >> 4, sc = (tid & 15) * 8, kws = KSWZ(sr, sc * 2); char* K_lds = lds + 2 * SHM_V;
    const int kb0 = cur.JLO * KVBLK;
    for (int d0 = 0; d0 < 8; ++d0) S.qr[d0] = load8<TIn>(cur.Q + (size_t)(wid * QBLK + r32) * PITCH + d0 * 16 + hi * 8);
    if constexpr (F32) { SLOAD_F((const float*)cur.K, kb0); VMW(); SWRITE_KF(0); SBAR(); SLOAD_F((const float*)cur.V, kb0); }
    else { SLOAD_H(cur.K, cur.V, kb0); VMW(); SWRITE_HK(0); }
    __syncthreads();
}
template <class TIn, class TOut>
__device__ __forceinline__ void causal_swa_block(const BlockRef<TIn, TOut>& cur, const BlockRef<TIn, TOut>& nxt, int skv, int W, char* lds, Seam<TIn>& S) {
    constexpr bool F32 = same_t<TIn, float>::v;
    const int tid = threadIdx.x, wid = __builtin_amdgcn_readfirstlane(tid >> 6), lane = tid & 63, r32 = lane & 31, hi = lane >> 5;
    const int j_lo = cur.JLO;
    int j_hi = (cur.P0 + QB - 1) / KVBLK + 1; if (j_hi > skv / KVBLK) j_hi = skv / KVBLK;
    const int NT = j_hi - j_lo;
    const int kbn = nxt.JLO * KVBLK;
    const int qlo = cur.P0 + wid * QBLK, qm = qlo + r32 - 4 * hi;
    char* V_lds = lds; char* K_lds = lds + 2 * SHM_V;
    float* ws = (float*)(lds + 2 * SHM_V + 2 * SHM_K) + wid * 64; float* li_l = ws, * al_l = ws + 32;
    __attribute__((address_space(3))) float* cb = (__attribute__((address_space(3))) float*)(lds + LDS_BYTES);
    { const float cref = cur.C[cur.P0]; const int nk = j_hi * KVBLK; int tq = tid * 4; asm volatile("" : "+v"(tq));
      for (int k = j_lo * KVBLK + tq; k < nk; k += 2048) { const f32x4 c4 = *(const f32x4*)(cur.C + k); *(__attribute__((address_space(3))) f32x4*)(cb + k) = (f32x4){(cref - c4[0]) * LOG2E_, (cref - c4[1]) * LOG2E_, (cref - c4[2]) * LOG2E_, (cref - c4[3]) * LOG2E_}; } }
    __syncthreads();
    const __attribute__((address_space(3))) float* cbh = cb + 4 * hi;
    float m_reg = -1e30f, l_reg = 0; f32x16 o[4] = {};
    const int sr = tid >> 4, sc = (tid & 15) * 8, vst0 = v_st(sr, sc), vst1 = v_st(32 + sr, sc), kws = KSWZ(sr, sc * 2);
    const int vb0 = (int)(uintptr_t)V_lds + v_rd_base(lane);
    const TIn* Kh = cur.K; const TIn* Vh = cur.V;
#define RESC(a) do { if (__any((a) < 1.f)) { if (hi == 0) al_l[r32] = (a); asm volatile("s_waitcnt lgkmcnt(0)" ::: "memory");              \
                     for (int d_ = 0; d_ < 4; ++d_) for (int r = 0; r < 16; ++r) o[d_][r] *= al_l[crow(r, hi)]; } } while (0)
#define KBASE(t) ((j_lo + (t)) * KVBLK)
#define ACT(t) (KBASE(t) <= qlo + QBLK - 1 && KBASE(t) + KVBLK - 1 >= qlo - W + 1)
#define MASKT(P0_, P1_, t) do { const int kb_ = KBASE(t); if ((!SK || ACT(t)) && (kb_ + KVBLK - 1 > qlo || kb_ <= qlo + QBLK - 1 - W)) mask_tile(P0_, P1_, qm - kb_, (unsigned)W); } while (0)
    constexpr int NQL = F32 ? 16 : 8;
    constexpr bool SK = WSKIP && !F32;
#define SEAM_K0() do { VMWN(NQL); if constexpr (F32) { SWRITE_KF(0); SBAR(); SLOAD_F((const float*)nxt.V, kbn); } else { SWRITE_HK(0); } SBAR(); } while (0)
    f32x16 pA0, pA1, pB0, pB1; float mnA, mnB, alA, alB; bf16x8 pa0, pa1, pa2, pa3;
    if constexpr (F32) { VMW(); SWRITE_VF(0); SBAR(); } else { SWRITE_HV(0); SBAR(); }
    if (NT > 1) { if constexpr (F32) SLOAD_F((const float*)Kh, KBASE(1)); else SLOAD_H(Kh, Vh, KBASE(1)); }
    SBAR(); qkt<0, SK>(pA0, pA1, K_lds, r32, hi, S.qr, ACT(0));
    if constexpr (F32) { if (NT > 1) { VMW(); SWRITE_KF(1); SBAR(); SLOAD_F((const float*)Vh, KBASE(1)); } }
    MASKT(pA0, pA1, 0); partialSM(pA0, pA1, m_reg, mnA, alA, cbh + KBASE(0));
    if (NT > 1) { VMW(); if constexpr (F32) { SWRITE_VF(1); SBAR(); if (NT > 2) SLOAD_F((const float*)Kh, KBASE(2)); } else SWRITE_H(1); }
    __syncthreads();
#define HALF_STEP(PX0, PX1, mnX, alX, PY0, PY1, alY, t, KB, VB, SB) do {                                                      \
        SBAR(); qkt<KB, SK>(PX0, PX1, K_lds, r32, hi, S.qr, ACT(t));                                             \
        finishSM(PY0, PY1, alY, l_reg, pa0, pa1, pa2, pa3); SBAR();                                                           \
        if ((t) + 1 < NT) { if constexpr (F32) { VMW(); SWRITE_KF(SB); SBAR(); SLOAD_F((const float*)Vh, KBASE((t) + 1)); }  \
                            else { SLOAD_H(Kh, Vh, KBASE((t) + 1)); } SBAR(); }                                               \
        pv_tile<VB, SK>(o, vb0, pa0, pa1, pa2, pa3, ACT((t) - 1)); MASKT(PX0, PX1, (t)); partialSM(PX0, PX1, m_reg, mnX, alX, cbh + KBASE(t));                                        \
        __syncthreads();                                                                                                      \
        if ((t) + 1 < NT) { VMW(); if constexpr (F32) { SWRITE_VF(SB); SBAR(); if ((t) + 2 < NT) SLOAD_F((const float*)Kh, KBASE((t) + 2)); } \
                            else { SWRITE_H(SB); } }                                                                          \
        RESC(alX); __syncthreads(); } while (0)
    for (int t = 1; t + 1 < NT; t += 2) {
        HALF_STEP(pB0, pB1, mnB, alB, pA0, pA1, alA, t, 1, 0, 0);
        HALF_STEP(pA0, pA1, mnA, alA, pB0, pB1, alB, t + 1, 0, 1, 1);
    }
    const bool even = (NT & 1) == 0;
    if (even) { SBAR(); qkt<1, SK>(pB0, pB1, K_lds, r32, hi, S.qr, ACT(NT - 1)); SBAR(); }
#define QROW(e) (nxt.Q + (size_t)(wid * QBLK + r32) * PITCH + ((e) >> 1) * 16 + hi * 8 + ((e) & 1) * 4)
    if constexpr (F32) { SLOAD_F((const float*)nxt.K, kbn); SBAR();
#pragma unroll
        for (int e = 0; e < 8; ++e) S.tq[e] = *(const f32x4*)QROW(e); }
    else { SLOAD_H(nxt.K, nxt.V, kbn); SBAR();
#pragma unroll
        for (int d0 = 0; d0 < 8; ++d0) S.qr[d0] = load8<TIn>(nxt.Q + (size_t)(wid * QBLK + r32) * PITCH + d0 * 16 + hi * 8); }
    SBAR();
    finishSM(pA0, pA1, alA, l_reg, pa0, pa1, pa2, pa3); SBAR();
    if constexpr (F32) {
#pragma unroll
        for (int e = 8; e < 16; ++e) S.tq[e] = *(const f32x4*)QROW(e); SBAR(); }
#undef QROW
    pv_tile<0, SK>(o, vb0, pa0, pa1, pa2, pa3, ACT(even ? NT - 2 : NT - 1));
    if (even) { MASKT(pB0, pB1, NT - 1); partialSM(pB0, pB1, m_reg, mnB, alB, cbh + KBASE(NT - 1)); __syncthreads(); RESC(alB);
        finishSM(pB0, pB1, alB, l_reg, pa0, pa1, pa2, pa3); SBAR(); pv_tile<1, SK>(o, vb0, pa0, pa1, pa2, pa3, ACT(NT - 1)); }
    SBAR(); SEAM_K0();
    if (hi == 0) li_l[r32] = l_reg; asm volatile("s_waitcnt lgkmcnt(0)" ::: "memory");
    float rli[16];
#pragma unroll
    for (int r = 0; r < 16; ++r) rli[r] = __builtin_amdgcn_rcpf(li_l[crow(r, hi)]);
    TOut* Ow = cur.O + (size_t)(wid * QBLK) * OPITCH;
#pragma unroll
    for (int r = 0; r < 16; ++r) { const int orow = crow(r, hi);
#pragma unroll
        for (int d0 = 0; d0 < 4; ++d0) { const float v = o[d0][r] * rli[r];
            if constexpr (same_t<TOut, float>::v) { Ow[(size_t)orow * OPITCH + d0 * 32 + r32] = v; }
            else { const float vn = __shfl_xor(v, 1);
                   if ((r32 & 1) == 0) *(unsigned*)(Ow + (size_t)orow * OPITCH + d0 * 32 + r32) = cvtpk(v, vn); } } }
    if constexpr (F32) {
#pragma unroll
        for (int d0 = 0; d0 < 8; ++d0) S.qr[d0] = pack8(S.tq[2 * d0], S.tq[2 * d0 + 1]); }
    __syncthreads();
#undef RESC
#undef KBASE
#undef ACT
#undef MASKT
#undef SEAM_K0
#undef HALF_STEP
}
#undef ROW
#undef VMW
#undef VMWN
#undef SLOAD_H
#undef SWRITE_HK
#undef SWRITE_HV
#undef SWRITE_H
#undef SLOAD_F
#undef SWRITE_KF
#undef SWRITE_VF

constexpr int FOX_LDS_BYTES = LDS_BYTES + 8192 * 4;
struct AttnT { const bf16* BQ; const bf16* BK; const bf16* BV; bf16* OB; const float* CUM; const unsigned* KMAX; };
__device__ __forceinline__ BlockRef<bf16, bf16> fox_ref(const AttnT& T, int L_, int pass, int jlo) {
    constexpr int NQB = 8192 / QB;
    const int h = L_ % 8, qb = NQB - 1 - L_ / 8; BlockRef<bf16, bf16> r; (void)pass;
    r.Q = T.BQ + (size_t)qb * QB * PITCH + h * D; r.O = T.OB + (size_t)qb * QB * OPITCH + h * D; r.K = T.BK + h * D; r.V = T.BV + h * D; r.C = T.CUM + (size_t)h * 8192; r.P0 = qb * QB; r.JLO = jlo; return r;
}
constexpr float PRUNE_T2 = 40.f;
__device__ __forceinline__ int fox_jlo(const AttnT& T, int L_, int pass, char* lds) {
    constexpr int NQB = 8192 / QB;
    int tid = threadIdx.x; asm volatile("" : "+v"(tid));
    const int lane = tid & 63, wid = tid >> 6; (void)pass;
    const int h = L_ % 8, qb = NQB - 1 - L_ / 8, P0 = qb * QB;
    float* red = (float*)(lds + LDS_BYTES + 8192 * 4);
    { const bf16* qp = T.BQ + (size_t)(P0 + (tid >> 1)) * PITCH + h * D + (tid & 1) * 64; float s = 0.f;
#pragma unroll
      for (int i = 0; i < 8; ++i) { const u32x4 v = *(const u32x4*)(qp + 8 * i);
#pragma unroll
          for (int j = 0; j < 4; ++j) s += fabsf(__uint_as_float(v[j] << 16)) + fabsf(__uint_as_float(v[j] & 0xffff0000u)); }
      s += __shfl_xor(s, 1);
#pragma unroll
      for (int o = 2; o < 64; o <<= 1) s = fmaxf(s, __shfl_xor(s, o));
      if (lane == 0) red[wid] = s; }
    __syncthreads();
    float q1 = red[0];
#pragma unroll
    for (int i = 1; i < 8; ++i) q1 = fmaxf(q1, red[i]);
    const float B2 = q1 * __uint_as_float(T.KMAX[h]) * 1.01f;
    const float* C = T.CUM + (size_t)h * 8192; const float cref = C[P0];
    const int ntb = P0 / KVBLK;
    bool skip = false;
    if (tid < ntb) skip = (cref - C[tid * KVBLK + KVBLK - 1]) * LOG2E_ + 2.f * B2 < -PRUNE_T2;
    const int cnt = __popcll(__ballot(skip));
    __syncthreads();
    if (lane == 0) red[wid] = (float)cnt;
    __syncthreads();
    int jlo = 0;
#pragma unroll
    for (int i = 0; i < 8; ++i) jlo += (int)red[i];
    __syncthreads();
    return __builtin_amdgcn_readfirstlane(jlo);
}
__device__ __forceinline__ void attn_phase(char* lds, const AttnT T, int first, int stride) {
    constexpr int NQB = 8192 / QB, TOTAL = NQB * 8;
    int SKV_ = 8192, W = 8192; asm volatile("" : "+s"(SKV_), "+s"(W));
    int L = first; if (L >= TOTAL) return;
    int pass = 0;
    BlockRef<bf16, bf16> cur = fox_ref(T, L, 0, fox_jlo(T, L, 0, lds));
    Seam<bf16> Sm;
    causal_swa_prime<bf16, bf16>(cur, W, lds, Sm);
    for (;;) {
        const bool more_pass = false, more_item = L + stride < TOTAL, last = !more_pass && !more_item;
        int passn = pass + 1, Ln = L;
        if (!more_pass) { passn = 0; Ln = more_item ? L + stride : L; }
        BlockRef<bf16, bf16> nxt = cur;
        if (!last) { const int jn = fox_jlo(T, Ln, passn, lds); nxt = fox_ref(T, Ln, passn, jn); }
        causal_swa_block<bf16, bf16>(cur, nxt, SKV_, W, lds, Sm);
        if (last) break;
        cur = nxt; pass = passn; L = Ln;
    }
}
#undef KSWZ
#undef SBAR
}

namespace hg {
typedef short bf16x8 __attribute__((ext_vector_type(8)));
typedef float f32x4 __attribute__((ext_vector_type(4)));
typedef unsigned u32x4 __attribute__((ext_vector_type(4)));
typedef unsigned short bf16;
#define HLAS __attribute__((address_space(3)))
constexpr int PQ = 136, PS = 72;
constexpr int L_B = 0;
constexpr int L_QT = 34816;
constexpr int L_Q0 = L_QT + 17408;
constexpr int L_KT = L_Q0 + 17408;
constexpr int L_VT = L_KT + 43520;
constexpr int L_P = L_VT + 18432;
constexpr int L_RED = L_P + 9216;
constexpr int L_END = L_RED + 512 + 2048;
static_assert(L_END <= 147328, "hgrn LDS map");
__device__ __forceinline__ float bfl(unsigned w) { return __uint_as_float(w << 16); }
__device__ __forceinline__ float bfh(unsigned w) { return __uint_as_float(w & 0xffff0000u); }
__device__ __forceinline__ unsigned pkbf(float lo, float hi) { return pg8::cvt_pk_bf16(lo, hi); }
struct T { const bf16 *AQ, *AK, *AI, *AG; const float* ALF; bf16* LT; float* DV; bf16* OA; const float* nw; };

__device__ __forceinline__ void load_b_issue(const float* ALF, int t0, int hcol, int tid, float (&loc)[16]) {
    const int k = tid & 127, seg = tid >> 7;
    const float* p = ALF + (size_t)(t0 + 16 * seg) * 1024 + hcol + k;
#pragma unroll
    for (int i = 0; i < 16; ++i) loc[i] = p[(size_t)i * 1024];
}
__device__ __forceinline__ void load_b_finish(HLAS unsigned char* lds, int tid, float (&loc)[16]) {
    HLAS float* B = (HLAS float*)(lds + L_B); HLAS float* tot = (HLAS float*)(lds + L_RED + 512);
    const int k = tid & 127, seg = tid >> 7;
    float run = 0.f;
#pragma unroll
    for (int i = 0; i < 16; ++i) { run += loc[i]; loc[i] = run; }
    tot[seg * 128 + k] = run;
    __syncthreads();
    float pre = 0.f;
#pragma unroll
    for (int s2 = 0; s2 < 3; ++s2) { const float v = tot[s2 * 128 + k]; pre += (s2 < seg) ? v : 0.f; }
#pragma unroll
    for (int i = 0; i < 16; ++i) B[(16 * seg + i) * 128 + k] = pre + loc[i];
    __syncthreads();
}
__device__ __forceinline__ void store_vt(HLAS unsigned char* lds, int tid, const u32x4 (&vv)[2]) {
    HLAS bf16* VT = (HLAS bf16*)(lds + L_VT);
#pragma unroll
    for (int it = 0; it < 2; ++it) { const int item = tid + 512 * it, s = item >> 4, k8 = (item & 15) * 8;
        const int sx = s ^ (((k8 >> 3) & 7) << 3);
#pragma unroll
        for (int j = 0; j < 4; ++j) { VT[(k8 + 2 * j) * PS + sx] = (bf16)(vv[it][j] & 0xffffu); VT[(k8 + 2 * j + 1) * PS + sx] = (bf16)(vv[it][j] >> 16); } }
}
__device__ __forceinline__ void passA_unit(HLAS unsigned char* lds, const T& P, int c, int h) {
    const int tid = threadIdx.x, lane = tid & 63, w = __builtin_amdgcn_readfirstlane(tid >> 6), t0 = c * 64, hcol = h * 128;
    float loc[16]; u32x4 kkv[2], vv[2];
    load_b_issue(P.ALF, t0, hcol, tid, loc);
#pragma unroll
    for (int it = 0; it < 2; ++it) { const int item = tid + 512 * it, s = item >> 4, k8 = (item & 15) * 8;
        kkv[it] = *(const u32x4*)(P.AK + (size_t)(t0 + s) * 1024 + hcol + k8); vv[it] = *(const u32x4*)(P.AI + (size_t)(t0 + s) * 1024 + hcol + k8); }
    load_b_finish(lds, tid, loc);
    HLAS float* B = (HLAS float*)(lds + L_B); HLAS bf16* KdT = (HLAS bf16*)(lds + L_KT); HLAS bf16* VT = (HLAS bf16*)(lds + L_VT);
#pragma unroll
    for (int it = 0; it < 2; ++it) { const int item = tid + 512 * it, s = item >> 4, k8 = (item & 15) * 8;
        const u32x4 kk = kkv[it];
        const f32x4 l0 = *(const HLAS f32x4*)(B + 63 * 128 + k8), l1 = *(const HLAS f32x4*)(B + 63 * 128 + k8 + 4);
        const f32x4 s0 = *(const HLAS f32x4*)(B + s * 128 + k8), s1 = *(const HLAS f32x4*)(B + s * 128 + k8 + 4);
        float kd[8];
        kd[0] = bfl(kk[0]) * __expf(l0[0] - s0[0]); kd[1] = bfh(kk[0]) * __expf(l0[1] - s0[1]); kd[2] = bfl(kk[1]) * __expf(l0[2] - s0[2]); kd[3] = bfh(kk[1]) * __expf(l0[3] - s0[3]);
        kd[4] = bfl(kk[2]) * __expf(l1[0] - s1[0]); kd[5] = bfh(kk[2]) * __expf(l1[1] - s1[1]); kd[6] = bfl(kk[3]) * __expf(l1[2] - s1[2]); kd[7] = bfh(kk[3]) * __expf(l1[3] - s1[3]);
        const int sx = s ^ (((k8 >> 3) & 7) << 3);
#pragma unroll
        for (int j = 0; j < 4; ++j) { const unsigned pw = pkbf(kd[2 * j], kd[2 * j + 1]); KdT[(k8 + 2 * j) * PS + sx] = (bf16)(pw & 0xffffu); KdT[(k8 + 2 * j + 1) * PS + sx] = (bf16)(pw >> 16); } }
    store_vt(lds, tid, vv);
    if (tid < 128) P.DV[(size_t)(c * 8 + h) * 128 + tid] = __expf(B[63 * 128 + tid]);
    __syncthreads();
    const int fr = lane & 15, fq = lane >> 4;
    bf16x8 a[2];
#pragma unroll
    for (int ks = 0; ks < 2; ++ks) a[ks] = *(const HLAS bf16x8*)(VT + (16 * w + fr) * PS + ((32 * ks + 8 * fq) ^ (((2 * w + (fr >> 3)) & 7) << 3)));
    bf16* out = P.LT + ((size_t)(c * 8 + h) * 128 + 16 * w + 4 * fq) * 128 + fr;
#pragma unroll
    for (int kt = 0; kt < 8; ++kt) { f32x4 acc = {0.f, 0.f, 0.f, 0.f};
#pragma unroll
        for (int ks = 0; ks < 2; ++ks) { const bf16x8 b = *(const HLAS bf16x8*)(KdT + (16 * kt + fr) * PS + ((32 * ks + 8 * fq) ^ (((2 * kt + (fr >> 3)) & 7) << 3))); acc = __builtin_amdgcn_mfma_f32_16x16x32_bf16(a[ks], b, acc, 0, 0, 0); }
#pragma unroll
        for (int r = 0; r < 4; ++r) out[(size_t)r * 128 + 16 * kt] = (bf16)(pkbf(acc[r], 0.f) & 0xffffu); }
    __syncthreads();
}
__device__ __forceinline__ void scan_all(const T& P, int gtid, int gthreads) {
    for (int e = gtid; e < 8 * 128 * 128; e += gthreads) {
        const int h = e >> 14, k = e & 127; bf16* p = P.LT + e; const float* d = P.DV + h * 128 + k;
        float s = 0.f;
        for (int c0 = 0; c0 < 128; c0 += 32) { float L[32], dd[32];
#pragma unroll
            for (int i = 0; i < 32; ++i) { L[i] = __uint_as_float((unsigned)p[(size_t)(c0 + i) * 131072] << 16); dd[i] = d[(size_t)(c0 + i) * 1024]; }
#pragma unroll
            for (int i = 0; i < 32; ++i) { p[(size_t)(c0 + i) * 131072] = (bf16)(pkbf(s, 0.f) & 0xffffu); s = dd[i] * s + L[i]; } }
    }
}
__device__ __forceinline__ void passC_unit(HLAS unsigned char* lds, const T& P, int c, int h) {
    const int tid = threadIdx.x, lane = tid & 63, w = __builtin_amdgcn_readfirstlane(tid >> 6), t0 = c * 64, hcol = h * 128;
    const int fr = lane & 15, fq = lane >> 4;
    float loc[16]; u32x4 qqv[2], kkv[2], vv[2], stv[4]; bf16 gg[4][4];
    load_b_issue(P.ALF, t0, hcol, tid, loc);
#pragma unroll
    for (int it = 0; it < 2; ++it) { const int item = tid + 512 * it, t = item >> 4, k8 = (item & 15) * 8; const size_t o_ = (size_t)(t0 + t) * 1024 + hcol + k8;
        qqv[it] = *(const u32x4*)(P.AQ + o_); kkv[it] = *(const u32x4*)(P.AK + o_); vv[it] = *(const u32x4*)(P.AI + o_); }
    { const bf16* src = P.LT + (size_t)(c * 8 + h) * 16384;
#pragma unroll
      for (int it = 0; it < 4; ++it) { const int item = tid + 512 * it, v = item >> 4, k8 = (item & 15) * 8; stv[it] = *(const u32x4*)(src + v * 128 + k8); } }
#pragma unroll
    for (int i = 0; i < 4; ++i)
#pragma unroll
        for (int r = 0; r < 4; ++r) gg[i][r] = P.AG[(size_t)(t0 + 16 * (w >> 1) + 4 * fq + r) * 1024 + hcol + 16 * ((w & 1) * 4 + i) + fr];
    load_b_finish(lds, tid, loc);
    HLAS float* B = (HLAS float*)(lds + L_B); HLAS bf16* QT = (HLAS bf16*)(lds + L_QT); HLAS bf16* Q0 = (HLAS bf16*)(lds + L_Q0); HLAS bf16* KT = (HLAS bf16*)(lds + L_KT);
    HLAS bf16* VT = (HLAS bf16*)(lds + L_VT); HLAS bf16* PP = (HLAS bf16*)(lds + L_P); HLAS bf16* ST = (HLAS bf16*)(lds + L_B); HLAS float* red = (HLAS float*)(lds + L_RED);
#pragma unroll
    for (int it = 0; it < 2; ++it) { const int item = tid + 512 * it, t = item >> 4, k8 = (item & 15) * 8, J = t >> 4;
        const u32x4 qq = qqv[it], kk = kkv[it];
        float bt[8], q[8], kf[8];
        { const f32x4 x0 = *(const HLAS f32x4*)(B + t * 128 + k8), x1 = *(const HLAS f32x4*)(B + t * 128 + k8 + 4);
#pragma unroll
          for (int j = 0; j < 4; ++j) { bt[j] = x0[j]; bt[4 + j] = x1[j]; q[2 * j] = bfl(qq[j]); q[2 * j + 1] = bfh(qq[j]); kf[2 * j] = bfl(kk[j]); kf[2 * j + 1] = bfh(kk[j]); } }
        { float e0[8]; u32x4 o;
#pragma unroll
          for (int j = 0; j < 8; ++j) e0[j] = q[j] * __expf(bt[j]);
          o[0] = pkbf(e0[0], e0[1]); o[1] = pkbf(e0[2], e0[3]); o[2] = pkbf(e0[4], e0[5]); o[3] = pkbf(e0[6], e0[7]);
          *(HLAS u32x4*)(Q0 + t * PQ + k8) = o; }
        for (int I = J; I < 4; ++I) {
            const f32x4 r0 = *(const HLAS f32x4*)(B + (16 * I) * 128 + k8), r1 = *(const HLAS f32x4*)(B + (16 * I) * 128 + k8 + 4);
            float br[8];
#pragma unroll
            for (int j = 0; j < 4; ++j) { br[j] = r0[j]; br[4 + j] = r1[j]; }
            float e1[8]; u32x4 o;
#pragma unroll
            for (int j = 0; j < 8; ++j) e1[j] = kf[j] * __expf(br[j] - bt[j]);
            o[0] = pkbf(e1[0], e1[1]); o[1] = pkbf(e1[2], e1[3]); o[2] = pkbf(e1[4], e1[5]); o[3] = pkbf(e1[6], e1[7]);
            const int off = (I == 0) ? 0 : (I == 1) ? 16 : (I == 2) ? 48 : 96;
            *(HLAS u32x4*)(KT + (off + t) * PQ + k8) = o;
            if (I == J) {
#pragma unroll
                for (int j = 0; j < 8; ++j) e1[j] = q[j] * __expf(bt[j] - br[j]);
                o[0] = pkbf(e1[0], e1[1]); o[1] = pkbf(e1[2], e1[3]); o[2] = pkbf(e1[4], e1[5]); o[3] = pkbf(e1[6], e1[7]);
                *(HLAS u32x4*)(QT + t * PQ + k8) = o; }
        } }
    store_vt(lds, tid, vv);
    __syncthreads();
#pragma unroll
    for (int it = 0; it < 4; ++it) { const int item = tid + 512 * it, v = item >> 4, k8 = (item & 15) * 8; *(HLAS u32x4*)(ST + v * PQ + k8) = stv[it]; }
    for (int idx = w; idx < 10; idx += 8) {
        const int I = (idx >= 6) ? 3 : (idx >= 3) ? 2 : (idx >= 1) ? 1 : 0, J = idx - ((I * (I + 1)) >> 1), off = (I == 0) ? 0 : (I == 1) ? 16 : (I == 2) ? 48 : 96;
        f32x4 acc = {0.f, 0.f, 0.f, 0.f};
#pragma unroll
        for (int ks = 0; ks < 4; ++ks) { const bf16x8 a = *(const HLAS bf16x8*)(QT + (16 * I + fr) * PQ + 32 * ks + 8 * fq), b = *(const HLAS bf16x8*)(KT + (off + 16 * J + fr) * PQ + 32 * ks + 8 * fq);
            acc = __builtin_amdgcn_mfma_f32_16x16x32_bf16(a, b, acc, 0, 0, 0); }
#pragma unroll
        for (int r = 0; r < 4; ++r) { const float v = (I == J && fr > 4 * fq + r) ? 0.f : acc[r]; PP[(16 * I + 4 * fq + r) * PS + 16 * J + fr] = (bf16)(pkbf(v, 0.f) & 0xffffu); } }
    if (w >= 2) { const int z = w - 2, I = (z < 3) ? 0 : (z < 5) ? 1 : 2, J = (z < 3) ? z + 1 : (z < 5) ? z - 1 : 3;
#pragma unroll
        for (int r = 0; r < 4; ++r) PP[(16 * I + 4 * fq + r) * PS + 16 * J + fr] = (bf16)0; }
    __syncthreads();
    { const int I = w >> 1, vh = w & 1;
      f32x4 acc[4];
#pragma unroll
      for (int i = 0; i < 4; ++i) { const int vt = vh * 4 + i; f32x4 a4 = {0.f, 0.f, 0.f, 0.f};
#pragma unroll
          for (int ks = 0; ks < 2; ++ks) { const bf16x8 a = *(const HLAS bf16x8*)(PP + (16 * I + fr) * PS + 32 * ks + 8 * fq), b = *(const HLAS bf16x8*)(VT + (16 * vt + fr) * PS + ((32 * ks + 8 * fq) ^ (((2 * vt + (fr >> 3)) & 7) << 3)));
              a4 = __builtin_amdgcn_mfma_f32_16x16x32_bf16(a, b, a4, 0, 0, 0); }
#pragma unroll
          for (int ks = 0; ks < 4; ++ks) { const bf16x8 a = *(const HLAS bf16x8*)(Q0 + (16 * I + fr) * PQ + 32 * ks + 8 * fq), b = *(const HLAS bf16x8*)(ST + (16 * vt + fr) * PQ + 32 * ks + 8 * fq);
              a4 = __builtin_amdgcn_mfma_f32_16x16x32_bf16(a, b, a4, 0, 0, 0); }
          acc[i] = a4; }
      float ss[4];
#pragma unroll
      for (int r = 0; r < 4; ++r) { float s = 0.f;
#pragma unroll
          for (int i = 0; i < 4; ++i) s += acc[i][r] * acc[i][r];
          s += __shfl_xor(s, 1); s += __shfl_xor(s, 2); s += __shfl_xor(s, 4); s += __shfl_xor(s, 8); ss[r] = s; }
      if (fr == 0) {
#pragma unroll
          for (int r = 0; r < 4; ++r) red[(I * 2 + vh) * 16 + 4 * fq + r] = ss[r]; }
      __syncthreads();
#pragma unroll
      for (int r = 0; r < 4; ++r) { const float tot = red[(I * 2) * 16 + 4 * fq + r] + red[(I * 2 + 1) * 16 + 4 * fq + r]; ss[r] = rsqrtf(tot * (1.f / 128.f) + 1e-6f); }
#pragma unroll
      for (int i = 0; i < 4; ++i) { const int v = 16 * (vh * 4 + i) + fr; const float nwv = P.nw[v];
#pragma unroll
          for (int r = 0; r < 4; ++r) { const size_t o_ = (size_t)(t0 + 16 * I + 4 * fq + r) * 1024 + hcol + v;
              const float g = __uint_as_float((unsigned)gg[i][r] << 16);
              P.OA[(size_t)(t0 + 16 * I + 4 * fq + r) * 2048 + hcol + v] = (bf16)(pkbf(acc[i][r] * ss[r] * nwv * (g / (1.f + __expf(-g))), 0.f) & 0xffffu); } }
    }
    __syncthreads();
}
#undef HLAS
}


#define GAS __attribute__((address_space(1)))
#define LAS __attribute__((address_space(3)))
typedef unsigned short bf16;
typedef unsigned v4u __attribute__((ext_vector_type(4)));
typedef float f32x4 __attribute__((ext_vector_type(4)));
constexpr int NWAVES = 8;
constexpr size_t MiB = 1u << 20;
constexpr size_t WS_BAR = 65536, BAR_BYTES = 16384;
constexpr size_t WS_LB = 0;
constexpr size_t WS_WUA = 1 * MiB, WS_WUB = 5 * MiB, WS_WO = 9 * MiB, WS_WFI = 17 * MiB, WS_WFD = 61 * MiB;
constexpr size_t WS_WIN = 83 * MiB;
constexpr size_t WS_OA = 83 * MiB, WS_OB = 99 * MiB, WS_DV = 115 * MiB;
constexpr size_t WS_H1 = 127 * MiB;
constexpr size_t WS_PROJ = 159 * MiB;
constexpr size_t WS_ALF = 271 * MiB;
constexpr size_t WS_T = 159 * MiB;
constexpr size_t WS_HID = 223 * MiB;
constexpr size_t WS_END = 311 * MiB;
static_assert(WS_ALF + 32 * MiB <= WS_END && WS_HID + 88 * MiB <= WS_END, "ws map");
constexpr size_t WS_LS2 = 304 * MiB, WS_CUM2 = 305 * MiB;

__device__ __forceinline__ unsigned f2bf(float f) { unsigned u = __builtin_bit_cast(unsigned, f); return (u + 0x7fffu + ((u >> 16) & 1u)) >> 16; }
__device__ __forceinline__ unsigned pk2(float lo, float hi) { return f2bf(lo) | (f2bf(hi) << 16); }
__device__ __forceinline__ float bf2f(bf16 u) { return __uint_as_float((unsigned)u << 16); }
__device__ __forceinline__ float wave_sum(float v) {
#pragma unroll
    for (int o = 1; o < 64; o <<= 1) v += __shfl_xor(v, o);
    return v;
}
#define LDS_WAIT() asm volatile("s_waitcnt lgkmcnt(0)" ::: "memory")

typedef GAS unsigned gu32;
#define RLX_AGENT __ATOMIC_RELAXED, __HIP_MEMORY_SCOPE_AGENT
struct Args { const float* in[14]; float* out; unsigned char* ws; int ph_lo, ph_hi; };

struct TrItem { const float* src; bf16* dst; };
__device__ __forceinline__ void tr_load(const TrItem& t, int ldw, int lane, f32x4 (&a)[8], f32x4 (&b)[8]) {
    const int r = lane >> 4, c = lane & 15;
#pragma unroll
    for (int i = 0; i < 8; ++i) { const float* p = t.src + (size_t)(8 * i + 2 * r) * ldw + 4 * c; a[i] = __builtin_nontemporal_load((const f32x4*)p); b[i] = __builtin_nontemporal_load((const f32x4*)(p + ldw)); }
}
__device__ __forceinline__ void tr_store(const TrItem& t, int DP, int lane, LAS unsigned* scr, const f32x4 (&a)[8], const f32x4 (&b)[8]) {
    const int r = lane >> 4, c = lane & 15;
#pragma unroll
    for (int i = 0; i < 8; ++i) { const int kp = (4 * i + r) ^ (4 * (c & 7));
#pragma unroll
        for (int j = 0; j < 4; ++j) scr[(4 * c + j) * 32 + kp] = pg8::cvt_pk_bf16(a[i][j], b[i][j]); }
    LDS_WAIT(); asm volatile("" ::: "memory");
#pragma unroll
    for (int it = 0; it < 8; ++it) { const int n = 8 * it + (lane >> 3), g = lane & 7;
        const v4u o = *(const LAS v4u*)(scr + n * 32 + ((4 * g) ^ (4 * ((n >> 2) & 7))));
        *(v4u*)(t.dst + (size_t)n * DP + 8 * g) = o; }
    LDS_WAIT(); asm volatile("" ::: "memory");
}
__device__ __forceinline__ TrItem tr_item(const float* W, int ldw, int DP, int ncols, bf16* WT, int row_off, int mode, int it) {
    const int nblk = ncols / 64, kb = it / nblk, nb = it % nblk, n0 = 64 * nb;
    const int drow0 = mode ? ((n0 >> 7) * 256 + (n0 & 127) + row_off) : (row_off + n0);
    TrItem t; t.src = W + (size_t)(64 * kb) * ldw + n0; t.dst = WT + (size_t)drow0 * DP + 64 * kb; return t;
}
__device__ __forceinline__ void p0_matrix(const float* W, int ldw, int K, int ncols, bf16* WT, int row_off, int mode, LAS unsigned* scr, int lane, int gw, int NGW, int DP = 0) {
    if (DP == 0) DP = K;
    const int nitems = (K / 64) * (ncols / 64);
    int it = gw; if (it >= nitems) return;
    f32x4 a0[8], b0[8], a1[8], b1[8];
    TrItem t0 = tr_item(W, ldw, DP, ncols, WT, row_off, mode, it), t1 = t0;
    tr_load(t0, ldw, lane, a0, b0);
    for (;;) {
        const int it1 = it + NGW, it2 = it1 + NGW;
        if (it1 < nitems) { t1 = tr_item(W, ldw, DP, ncols, WT, row_off, mode, it1); tr_load(t1, ldw, lane, a1, b1); }
        tr_store(t0, DP, lane, scr, a0, b0);
        if (it1 >= nitems) break;
        if (it2 < nitems) { t0 = tr_item(W, ldw, DP, ncols, WT, row_off, mode, it2); tr_load(t0, ldw, lane, a0, b0); }
        tr_store(t1, DP, lane, scr, a1, b1);
        if (it2 >= nitems) break;
        it = it2;
    }
}

struct Frame {
    LAS unsigned char* lds; int tid, lane, wave, G;
    const float *x, *w_in, *b_fox, *lbl, *hnw, *w_up_a, *w_up_b, *w_o, *n_mix_pre, *n_mix_post, *n_ffn_pre, *n_ffn_post, *w_ffn_in, *w_ffn_down;
    float* out; unsigned char* ws;
};

__device__ __forceinline__ void p0_prologue(Frame& F) {
    LAS unsigned* scr = (LAS unsigned*)(F.lds + F.wave * 16384);
    const int gw = blockIdx.x * NWAVES + F.wave, NGW = F.G * NWAVES;
    if (blockIdx.x == 0) { float* LB = (float*)(F.ws + WS_LB); for (int c = F.tid; c < AW; c += 512) LB[c] = 1.f / (1.f + expf(F.lbl[AW + c] - F.lbl[c])); }
    LAS float* wfT = (LAS float*)F.lds;
    for (int k = F.tid; k < DM; k += 512) { const f32x4 a4 = *(const f32x4*)(F.w_in + (size_t)k * NIN + 7168), b4 = *(const f32x4*)(F.w_in + (size_t)k * NIN + 7172);
        wfT[0 * DM + k] = a4.x; wfT[1 * DM + k] = a4.y; wfT[2 * DM + k] = a4.z; wfT[3 * DM + k] = a4.w; wfT[4 * DM + k] = b4.x; wfT[5 * DM + k] = b4.y; wfT[6 * DM + k] = b4.z; wfT[7 * DM + k] = b4.w; }
    __syncthreads();
    {
        bf16* H1 = (bf16*)(F.ws + WS_H1); float* LS = (float*)(F.ws + WS_LS2);
        f32x4 wn[8], va[8], vb[8];
#pragma unroll
        for (int j = 0; j < 8; ++j) wn[j] = ((const f32x4*)F.n_mix_pre + F.lane)[64 * j];
#define P0_LOAD(m_, v_) do { const f32x4* xr_ = (const f32x4*)(F.x + (size_t)(m_) * DM) + F.lane; _Pragma("unroll") for (int j = 0; j < 8; ++j) v_[j] = __builtin_nontemporal_load(xr_ + 64 * j); } while (0)
#define P0_ROW(m_, v) do { \
            asm volatile("" ::: "memory");                                      \
            float s = 0.f; \
            _Pragma("unroll") for (int j = 0; j < 8; ++j) s += (v[j].x * v[j].x + v[j].y * v[j].y) + (v[j].z * v[j].z + v[j].w * v[j].w); \
            const float rstd = rsqrtf(wave_sum(s) * (1.f / DM) + EPS); \
            float fd[8] = {0.f, 0.f, 0.f, 0.f, 0.f, 0.f, 0.f, 0.f}; \
            unsigned long long* o8 = (unsigned long long*)(H1 + (size_t)(m_) * DM) + F.lane; \
            _Pragma("unroll") for (int j = 0; j < 8; ++j) { v[j] = v[j] * rstd * wn[j]; \
                o8[64 * j] = (unsigned long long)pk2(v[j].x, v[j].y) | ((unsigned long long)pk2(v[j].z, v[j].w) << 32); \
                _Pragma("unroll") for (int e = 0; e < 8; ++e) { const f32x4 wv = *(const LAS f32x4*)(wfT + e * DM + 256 * j + 4 * F.lane); fd[e] += (v[j].x * wv.x + v[j].y * wv.y) + (v[j].z * wv.z + v[j].w * wv.w); } } \
            _Pragma("unroll") for (int e = 0; e < 8; ++e) fd[e] = wave_sum(fd[e]); \
            if (F.lane < 8) { float z = fd[0]; \
                _Pragma("unroll") for (int e = 1; e < 8; ++e) z = (F.lane == e) ? fd[e] : z; \
                z += F.b_fox[F.lane]; \
                LS[(size_t)(m_) * 8 + F.lane] = fminf(z, 0.f) - log1pf(expf(-fabsf(z))); } } while (0)
        int m = gw;
        if (m < S) { P0_LOAD(m, va);
            for (;;) { const int m1 = m + NGW, m2 = m1 + NGW;
                if (m1 < S) P0_LOAD(m1, vb);
                P0_ROW(m, va);
                if (m1 >= S) break;
                if (m2 < S) P0_LOAD(m2, va);
                P0_ROW(m1, vb);
                if (m2 >= S) break;
                m = m2; } }
#undef P0_LOAD
#undef P0_ROW
    }
    __syncthreads();
    p0_matrix(F.w_in, NIN, DM, 7168, (bf16*)(F.ws + WS_WIN), 0, 0, scr, F.lane, gw, NGW);
    p0_matrix(F.w_in + 7176, NIN, DM, 2048, (bf16*)(F.ws + WS_WIN), 7168, 1, scr, F.lane, gw, NGW);
    p0_matrix(F.w_in + 7176 + DM, NIN, DM, 2048, (bf16*)(F.ws + WS_WIN), 7168 + 128, 1, scr, F.lane, gw, NGW);
}
__device__ __forceinline__ void late_weights(Frame& F, int my, int nidle) {
    LAS unsigned* scr = (LAS unsigned*)(F.lds + F.wave * 16384);
    const int gw = my * NWAVES + F.wave, NGW = nidle * NWAVES;
    p0_matrix(F.w_up_a, DM, AW, DM, (bf16*)(F.ws + WS_WUA), 0, 0, scr, F.lane, gw, NGW, 2 * AW);
    p0_matrix(F.w_up_b, DM, AW, DM, (bf16*)(F.ws + WS_WUA) + AW, 0, 0, scr, F.lane, gw, NGW, 2 * AW);
    p0_matrix(F.w_o, DM, DM, DM, (bf16*)(F.ws + WS_WO), 0, 0, scr, F.lane, gw, NGW);
    p0_matrix(F.w_ffn_in, 2 * DFF, DM, DFF, (bf16*)(F.ws + WS_WFI), 0, 1, scr, F.lane, gw, NGW);
    p0_matrix(F.w_ffn_in + DFF, 2 * DFF, DM, DFF, (bf16*)(F.ws + WS_WFI), 128, 1, scr, F.lane, gw, NGW);
}
__device__ __forceinline__ void cum_scan(Frame& F) {
    const float* LS = (const float*)(F.ws + WS_LS2); float* CUM = (float*)(F.ws + WS_CUM2);
    const int h = F.wave, lane = F.lane;
    double carry = 0.0;
    for (int c0 = 0; c0 < S / 64; c0 += 8) {
        float v[8];
#pragma unroll
        for (int i = 0; i < 8; ++i) v[i] = LS[(size_t)((c0 + i) * 64 + lane) * 8 + h];
#pragma unroll
        for (int i = 0; i < 8; ++i) {
            double x = (double)v[i];
#pragma unroll
            for (int o = 1; o < 64; o <<= 1) { const double y = __shfl_up(x, o); x += (lane >= o) ? y : 0.0; }
            CUM[(size_t)h * S + (c0 + i) * 64 + lane] = (float)(carry + x);
            carry += __shfl(x, 63);
        }
    }
}
#define BF4(tw) ((f32x4){__uint_as_float((unsigned)(tw) << 16), __uint_as_float((unsigned)(tw) & 0xffff0000u), __uint_as_float((unsigned)((tw) >> 32) << 16), __uint_as_float((unsigned)((tw) >> 32) & 0xffff0000u)})
__device__ __forceinline__ void r1_load(Frame& F, int m, f32x4 (&v)[8], f32x4 (&xv)[8]) {
    const unsigned long long* tr = (const unsigned long long*)((const bf16*)(F.ws + WS_T) + (size_t)m * DM) + F.lane; const f32x4* xr = (const f32x4*)(F.x + (size_t)m * DM) + F.lane;
#pragma unroll
    for (int j = 0; j < 8; ++j) { const unsigned long long tw = tr[64 * j]; v[j] = BF4(tw); xv[j] = __builtin_nontemporal_load(xr + 64 * j); }
}
__device__ __forceinline__ void r1_finish(Frame& F, int m, f32x4 (&v)[8], const f32x4 (&xv)[8], const f32x4 (&wa)[8], const f32x4 (&wb)[8]) {
    float s = 0.f;
#pragma unroll
    for (int j = 0; j < 8; ++j) s += (v[j].x * v[j].x + v[j].y * v[j].y) + (v[j].z * v[j].z + v[j].w * v[j].w);
    const float rstd = rsqrtf(wave_sum(s) * (1.f / DM) + EPS); float s2 = 0.f;
#pragma unroll
    for (int j = 0; j < 8; ++j) { v[j] = xv[j] + v[j] * rstd * wa[j]; s2 += (v[j].x * v[j].x + v[j].y * v[j].y) + (v[j].z * v[j].z + v[j].w * v[j].w); }
    f32x4* orow = (f32x4*)(F.out + (size_t)m * DM) + F.lane;
#pragma unroll
    for (int j = 0; j < 8; ++j) orow[64 * j] = v[j];
    const float rstd2 = rsqrtf(wave_sum(s2) * (1.f / DM) + EPS);
    unsigned long long* o8 = (unsigned long long*)((bf16*)(F.ws + WS_H1) + (size_t)m * DM) + F.lane;
#pragma unroll
    for (int j = 0; j < 8; ++j) { const f32x4 h = v[j] * rstd2 * wb[j]; o8[64 * j] = (unsigned long long)pk2(h.x, h.y) | ((unsigned long long)pk2(h.z, h.w) << 32); }
}
__device__ __forceinline__ void rowpass1(Frame& F, int gw, int NGW, int mend) {
    int m = gw; if (m >= mend) return;
    f32x4 wa[8], wb[8], v0[8], x0[8], v1[8], x1[8];
#pragma unroll
    for (int j = 0; j < 8; ++j) { wa[j] = ((const f32x4*)F.n_mix_post + F.lane)[64 * j]; wb[j] = ((const f32x4*)F.n_ffn_pre + F.lane)[64 * j]; }
    r1_load(F, m, v0, x0);
    for (;;) {
        const int m1 = m + NGW, m2 = m1 + NGW;
        if (m1 < mend) r1_load(F, m1, v1, x1);
        r1_finish(F, m, v0, x0, wa, wb);
        if (m1 >= mend) break;
        if (m2 < mend) r1_load(F, m2, v0, x0);
        r1_finish(F, m1, v1, x1, wa, wb);
        if (m2 >= mend) break;
        m = m2;
    }
}
__device__ __forceinline__ void r2_load(Frame& F, int m, f32x4 (&v)[8], f32x4 (&xv)[8]) {
    const unsigned long long* tr = (const unsigned long long*)((const bf16*)(F.ws + WS_T) + (size_t)m * DM) + F.lane; const f32x4* orow = (const f32x4*)(F.out + (size_t)m * DM) + F.lane;
#pragma unroll
    for (int j = 0; j < 8; ++j) { const unsigned long long tw = tr[64 * j]; v[j] = BF4(tw); xv[j] = orow[64 * j]; }
}
__device__ __forceinline__ void r2_finish(Frame& F, int m, const f32x4 (&v)[8], const f32x4 (&xv)[8], const f32x4 (&wa)[8]) {
    float s = 0.f;
#pragma unroll
    for (int j = 0; j < 8; ++j) s += (v[j].x * v[j].x + v[j].y * v[j].y) + (v[j].z * v[j].z + v[j].w * v[j].w);
    const float rstd = rsqrtf(wave_sum(s) * (1.f / DM) + EPS);
    f32x4* orow = (f32x4*)(F.out + (size_t)m * DM) + F.lane;
#pragma unroll
    for (int j = 0; j < 8; ++j) orow[64 * j] = xv[j] + v[j] * rstd * wa[j];
}
__device__ __forceinline__ void rowpass2(Frame& F, int gw, int NGW, int mend) {
    int m = gw; if (m >= mend) return;
    f32x4 wa[8], v0[8], x0[8], v1[8], x1[8];
#pragma unroll
    for (int j = 0; j < 8; ++j) wa[j] = ((const f32x4*)F.n_ffn_post + F.lane)[64 * j];
    r2_load(F, m, v0, x0);
    for (;;) {
        const int m1 = m + NGW, m2 = m1 + NGW;
        if (m1 < mend) r2_load(F, m1, v1, x1);
        r2_finish(F, m, v0, x0, wa);
        if (m1 >= mend) break;
        if (m2 < mend) r2_load(F, m2, v0, x0);
        r2_finish(F, m1, v1, x1, wa);
        if (m2 >= mend) break;
        m = m2;
    }
}
#undef BF4

#define XB_TMO      128
#define XB_XCNT(j)  (256  + 64 * (j))
#define XB_XSUB(j)  (1280 + 64 * (j))
#define XB_XGEN(j)  (2304 + 64 * (j))
#define XB_TOP      3328
#define XB_TOPGEN   3392
#define XCD_BAR_WORDS 3456
#define XB_SPIN_CAP (1u << 18)

__device__ __forceinline__ unsigned xb_ld(unsigned* p)              { return __hip_atomic_load(p, __ATOMIC_RELAXED, __HIP_MEMORY_SCOPE_AGENT); }
__device__ __forceinline__ unsigned xb_add(unsigned* p, unsigned v) { return __hip_atomic_fetch_add(p, v, __ATOMIC_RELAXED, __HIP_MEMORY_SCOPE_AGENT); }
__device__ __forceinline__ unsigned xb_xcc_id() { return (unsigned)__builtin_amdgcn_s_getreg((3 << 11) | 20) & 0xFu; }
#define XB_SPIN(cond, bar) do { unsigned _sp = 0; while (cond) { __builtin_amdgcn_s_sleep(1); \
    if ((++_sp & 255u) == 0u) { if (xb_ld(&(bar)[XB_TMO])) break; if (_sp > XB_SPIN_CAP) { atomicAdd(&(bar)[XB_TMO], 1u); break; } } } } while (0)

struct XcdBarrier {
    unsigned* bar; unsigned x;
    volatile LAS unsigned* st;
};

__device__ __forceinline__ XcdBarrier xcd_barrier_post(unsigned* bar, volatile LAS unsigned* st) {
    XcdBarrier b; b.bar = bar; b.x = xb_xcc_id(); b.st = st;
    if (threadIdx.x == 0) (void)xb_add(&bar[XB_XCNT(b.x)], 1u);
    return b;
}
__device__ __forceinline__ void xcd_barrier_complete(unsigned* bar, unsigned x, unsigned& nloc, unsigned& nx) {
    const unsigned G = gridDim.x * gridDim.y * gridDim.z;
    unsigned sum, cnt, mine, sp = 0u;
    for (;;) {
        sum = 0u; cnt = 0u; mine = 0u;
#pragma unroll
        for (unsigned j = 0; j < 16; ++j) { const unsigned c = xb_ld(&bar[XB_XCNT(j)]); sum += c; cnt += (c > 0u) ? 1u : 0u; mine = (j == x) ? c : mine; }
        if (sum == G) break;
        __builtin_amdgcn_s_sleep(1);
        if ((++sp & 255u) == 0u) { if (xb_ld(&bar[XB_TMO])) break; if (sp > XB_SPIN_CAP) { atomicAdd(&bar[XB_TMO], 1u); break; } }
    }
    nloc = mine > 0u ? mine : 1u; nx = cnt > 0u ? cnt : 1u;
}

__device__ __forceinline__ void xcd_barrier(const XcdBarrier& b) {
    asm volatile("s_waitcnt vmcnt(0)" ::: "memory");
    __syncthreads();
    if (threadIdx.x == 0) {
        unsigned* bar = b.bar;
        __builtin_amdgcn_s_waitcnt(0);
        unsigned nloc = b.st[0], nx = b.st[1];
        if (nloc == 0u) { xcd_barrier_complete(bar, b.x, nloc, nx); b.st[0] = nloc; b.st[1] = nx; }
        const unsigned old = xb_add(&bar[XB_XSUB(b.x)], 1u);
        const unsigned gen = old / nloc;
        if (old + 1u == (gen + 1u) * nloc) {
            __builtin_amdgcn_fence(__ATOMIC_RELEASE, "agent");
            asm volatile("s_waitcnt vmcnt(0)" ::: "memory");
            const unsigned og = xb_add(&bar[XB_TOP], 1u);
            const unsigned tg = og / nx;
            if (og + 1u == (tg + 1u) * nx) xb_add(&bar[XB_TOPGEN], 1u);
            else XB_SPIN(xb_ld(&bar[XB_TOPGEN]) == tg, bar);
            __builtin_amdgcn_fence(__ATOMIC_ACQUIRE, "agent");
            xb_add(&bar[XB_XGEN(b.x)], 1u);
            asm volatile("s_waitcnt vmcnt(0)" ::: "memory");
        } else {
            XB_SPIN(xb_ld(&bar[XB_XGEN(b.x)]) == gen, bar);
            __builtin_amdgcn_fence(__ATOMIC_ACQUIRE, "agent");
            asm volatile("s_waitcnt vmcnt(0)" ::: "memory");
        }
    }
    __syncthreads();
}

constexpr int LDS_BYTES = 147456;
enum { PH_PRO = 0, PH_GEMM1 = 1, PH_MIX = 2, PH_SCAN = 3, PH_HOUT = 4, PH_UPA = 5, PH_WO = 6, PH_ROW1 = 7, PH_FFI = 8, PH_FFD = 9, PH_ROW2 = 10, PH_N = 11 };
__global__ void __launch_bounds__(NWAVES * 64, 2) mega(Args a) {
    extern __shared__ __attribute__((aligned(16))) unsigned char lds[];
    Frame F;
    F.lds = (LAS unsigned char*)lds; F.tid = threadIdx.x; F.lane = F.tid & 63; F.wave = __builtin_amdgcn_readfirstlane(F.tid >> 6); F.G = gridDim.x;
    F.x = a.in[0]; F.w_in = a.in[1]; F.b_fox = a.in[2]; F.lbl = a.in[3]; F.hnw = a.in[4]; F.w_up_a = a.in[5]; F.w_up_b = a.in[6]; F.w_o = a.in[7];
    F.n_mix_pre = a.in[8]; F.n_mix_post = a.in[9]; F.n_ffn_pre = a.in[10]; F.n_ffn_post = a.in[11]; F.w_ffn_in = a.in[12]; F.w_ffn_down = a.in[13];
    F.out = a.out; F.ws = a.ws;
    unsigned char* ws = a.ws;
    const int lo = a.ph_lo, hi = a.ph_hi;
#define IN(k) (lo <= (k) && (k) < hi)
#define REFRESH() do { int t_ = threadIdx.x; asm volatile("" : "+v"(t_)); F.tid = t_; F.lane = t_ & 63; F.wave = __builtin_amdgcn_readfirstlane(t_ >> 6); } while (0)
    if (a.ph_lo < 0) cg::this_grid().sync();
    volatile LAS unsigned* MISC = (volatile LAS unsigned*)(F.lds + 147328);
    if (threadIdx.x < 32) MISC[threadIdx.x] = 0u;
    __syncthreads();
    XcdBarrier bar; bar.bar = (unsigned*)(a.ws + WS_BAR); bar.x = 0; bar.st = nullptr;
    const bool fused = (hi - lo) > 1;
    if (fused) bar = xcd_barrier_post((unsigned*)(a.ws + WS_BAR), MISC + 8);
#define SEAM(k) do { if (IN(k) && IN((k) + 1)) xcd_barrier(bar); } while (0)
    pg8::bf16_t* H1 = (pg8::bf16_t*)(ws + WS_H1);
    if (IN(PH_PRO)) { REFRESH(); p0_prologue(F); }
    SEAM(PH_PRO);
    if (IN(PH_GEMM1)) {
        const int rounds = (32 * 44 + F.G - 1) / F.G, GC = (32 * 44 + rounds - 1) / rounds, nconv = F.G - GC;
        if ((int)blockIdx.x == F.G - 1) { REFRESH(); cum_scan(F); __syncthreads(); }
        if ((int)blockIdx.x < GC) {
            pg8::Gemm g{H1, (const pg8::bf16_t*)(ws + WS_WIN), S, 11264, DM}; pg8::StaticOrder So; So.init(S, 11264, GC, (int)blockIdx.x);
            pg8::EpiProj E{(pg8::bf16_t*)(ws + WS_PROJ), (float*)(ws + WS_ALF), (pg8::bf16_t*)a.out, (const float*)(ws + WS_LB), (unsigned*)(ws + WS_BAR + 15360)};
            pg8::gemm_phase<pg8::EpiProj, pg8::StaticOrder, true, true>(F.lds, g, So, E);
            if (nconv == 0) { REFRESH(); late_weights(F, (int)blockIdx.x, F.G); }
        } else { REFRESH(); late_weights(F, (int)blockIdx.x - GC, nconv); }
    }
    SEAM(PH_GEMM1);
    const hg::T HT{(const hg::bf16*)(ws + WS_PROJ), (const hg::bf16*)(ws + WS_PROJ) + (size_t)S * 1024, (const hg::bf16*)(ws + WS_PROJ) + (size_t)2 * S * 1024, (const hg::bf16*)(ws + WS_PROJ) + (size_t)3 * S * 1024,
                   (const float*)(ws + WS_ALF), (hg::bf16*)(ws + WS_H1), (float*)(ws + WS_DV), (hg::bf16*)(ws + WS_OA), a.in[4]};
    if (IN(PH_MIX)) {
        { const fox::bf16* PR = (const fox::bf16*)(ws + WS_PROJ);
          const fox::AttnT AT{PR + (size_t)4 * S * 1024, PR + (size_t)5 * S * 1024, PR + (size_t)6 * S * 1024, (fox::bf16*)(ws + WS_OA) + AW, (const float*)(ws + WS_CUM2), (const unsigned*)(ws + WS_BAR + 15360)};
          fox::attn_phase((char*)lds, AT, (int)blockIdx.x, (int)gridDim.x); }
        __syncthreads();
        for (int u = (int)blockIdx.x; u < 1024; u += (int)gridDim.x) hg::passA_unit(F.lds, HT, u >> 3, u & 7);
    }
    SEAM(PH_MIX);
    if (IN(PH_SCAN)) hg::scan_all(HT, (int)(blockIdx.x * 512 + threadIdx.x), (int)(gridDim.x * 512));
    SEAM(PH_SCAN);
    if (IN(PH_HOUT)) { for (int u = (int)blockIdx.x; u < 1024; u += (int)gridDim.x) hg::passC_unit(F.lds, HT, u >> 3, u & 7); }
    SEAM(PH_HOUT);
    if (IN(PH_UPA)) {
        pg8::Gemm g{(const pg8::bf16_t*)(ws + WS_OA), (const pg8::bf16_t*)(ws + WS_WUA), S, DM, DM}; pg8::StaticOrder So; So.init(S, DM, F.G, (int)blockIdx.x);
        pg8::EpiUp E{(const pg8::bf16_t*)a.out, (const pg8::bf16_t*)a.out + (size_t)S * DM, H1};
        pg8::gemm_phase<pg8::EpiUp, pg8::StaticOrder, true, true>(F.lds, g, So, E);
    }
    SEAM(PH_UPA);
    if (IN(PH_WO)) {
        pg8::Gemm g{H1, (const pg8::bf16_t*)(ws + WS_WO), S, DM, DM}; pg8::StaticOrder So; So.init(S, DM, F.G, (int)blockIdx.x);
        pg8::EpiT16 E{(pg8::bf16_t*)(ws + WS_T)};
        pg8::gemm_phase<pg8::EpiT16, pg8::StaticOrder, true, true>(F.lds, g, So, E);
    }
    SEAM(PH_WO);
    if (IN(PH_ROW1)) { REFRESH(); rowpass1(F, blockIdx.x * NWAVES + F.wave, F.G * NWAVES, S); }
    SEAM(PH_ROW1);
    if (IN(PH_FFI)) {
        pg8::Gemm g{H1, (const pg8::bf16_t*)(ws + WS_WFI), S, 2 * DFF, DM}; pg8::StaticOrder So; So.init(S, 2 * DFF, F.G, (int)blockIdx.x);
        pg8::EpiSwiglu E{(pg8::bf16_t*)(ws + WS_HID)};
        pg8::gemm_phase<pg8::EpiSwiglu, pg8::StaticOrder, true, true>(F.lds, g, So, E);
        { const int rem = (32 * 44) % F.G, my = rem ? (int)blockIdx.x - rem : (int)blockIdx.x;
          if (my >= 0) { REFRESH(); LAS unsigned* scr = (LAS unsigned*)(F.lds + F.wave * 16384);
              p0_matrix(F.w_ffn_down, DM, DFF, DM, (bf16*)(F.ws + WS_WFD), 0, 0, scr, F.lane, my * NWAVES + F.wave, (rem ? F.G - rem : F.G) * NWAVES); } }
    }
    SEAM(PH_FFI);
    if (IN(PH_FFD)) {
        pg8::Gemm g{(const pg8::bf16_t*)(ws + WS_HID), (const pg8::bf16_t*)(ws + WS_WFD), S, DM, DFF}; pg8::StaticOrder So; So.init(S, DM, F.G, (int)blockIdx.x);
        pg8::EpiT16 E{(pg8::bf16_t*)(ws + WS_T)};
        pg8::gemm_phase<pg8::EpiT16, pg8::StaticOrder, true, true>(F.lds, g, So, E);
    }
    SEAM(PH_FFD);
    if (IN(PH_ROW2)) { REFRESH(); rowpass2(F, blockIdx.x * NWAVES + F.wave, F.G * NWAVES, S); }
#undef IN
#undef SEAM
}

extern "C" void kernel_launch(void* const* d_in, const int* in_sizes, int n_in, void* d_out, int out_size, void* d_ws, size_t ws_size, hipStream_t stream) {
    static int grid = 0;
    if (grid == 0) {
        if (n_in != 14 || out_size != S * DM || ws_size < WS_END) { fprintf(stderr, "kernel_launch: unexpected shapes (n_in %d out %d ws %zu)\n", n_in, out_size, ws_size); grid = -1; return; }
        if (hipFuncSetAttribute((const void*)mega, hipFuncAttributeMaxDynamicSharedMemorySize, LDS_BYTES) != hipSuccess) { fprintf(stderr, "hipFuncSetAttribute failed\n"); grid = -1; return; }
        int dev = 0, cus = 0, per_cu = 0;
        hipGetDevice(&dev); hipDeviceGetAttribute(&cus, hipDeviceAttributeMultiprocessorCount, dev);
        hipOccupancyMaxActiveBlocksPerMultiprocessor(&per_cu, (const void*)mega, NWAVES * 64, LDS_BYTES);
        (void)hipGetLastError();
        if (per_cu < 1) { fprintf(stderr, "occupancy query says %d\n", per_cu); }
        grid = cus;
    }
    if (grid < 0) return;
    Args a{};
    for (int i = 0; i < 14; ++i) a.in[i] = (const float*)d_in[i];
    a.out = (float*)d_out; a.ws = (unsigned char*)d_ws;
    unsigned char* ws = (unsigned char*)d_ws;
    (void)hipMemsetAsync(ws + WS_BAR, 0, BAR_BYTES, stream);
    a.ph_lo = 0; a.ph_hi = PH_N;
    void* kargs[] = {&a};
    hipError_t e = hipLaunchCooperativeKernel((const void*)mega, dim3(grid), dim3(NWAVES * 64), kargs, LDS_BYTES, stream);
    if (e != hipSuccess) fprintf(stderr, "cooperative launch failed: %s (grid %d)\n", hipGetErrorString(e), grid);
}
```

```cpp
#include <hip/hip_runtime.h>
#include <hip/hip_cooperative_groups.h>
#include <cstdio>
#include <cstdint>
namespace cg = cooperative_groups;

constexpr int S = 8192, DM = 2048, AW = 1024, NIN = 11272, DFF = 5632;
constexpr float EPS = 1e-6f;
constexpr float QSCALE = 0.08838834764831845f * 1.4426950408889634f;
constexpr float LOG2E = 1.4426950408889634f;

namespace pg8 {
#define PG8_LAS __attribute__((address_space(3)))
typedef unsigned short bf16_t;
typedef short bf16x8 __attribute__((ext_vector_type(8)));
typedef float f32x4 __attribute__((ext_vector_type(4)));
typedef unsigned u32x4 __attribute__((ext_vector_type(4)));
constexpr int BM = 256, BK = 64, HALF = 128, HTB = HALF * BK * 2  , STAGE_BYTES = 8 * HTB, NXCD = 8, WGM = 8;

__host__ __device__ __forceinline__ int lds_byte(int r, int c) { const int st = (r >> 4) * 2 + (c >> 5), rr = r & 15, cc = c & 31, ob = rr * 64 + cc * 2; return st * 1024 + (ob ^ (((ob >> 9) & 1) << 5)); }
__host__ __device__ __forceinline__ void stage_rc(int b, int& R, int& C) { const int st = b / 1024, sb = b % 1024, swz = sb ^ (((sb >> 9) & 1) << 5); R = (st >> 1) * 16 + swz / 64; C = (st & 1) * 32 + (swz % 64) / 2; }
__host__ __device__ __forceinline__ int perm32(int rho) { const int n = rho >> 4, i = rho & 15; return 8 * (i >> 2) + 4 * n + (i & 3); }

struct Unit { int pm, pn; };
struct Gemm { const bf16_t* A; const bf16_t* Bt; int M, N, K; };

struct StaticOrder {
    int nM, nN, nwg, G, c;
    __host__ __device__ void init(int M, int N, int G_, int c_) { nM = M / BM; nN = N / BM; nwg = nM * nN; G = G_; c = c_; }
    __host__ __device__ bool next(int i, Unit& u) const {
        const long L = (long)i * G + c; if (L >= nwg) return false;
        int wgid = (int)L; { const int q = nwg / NXCD, r = nwg % NXCD, xcd = wgid % NXCD, off = wgid / NXCD; wgid = (xcd < r ? xcd * (q + 1) : r * (q + 1) + (xcd - r) * q) + off; }
        const int nig = WGM * nN, gid = wgid / nig, fm = gid * WGM, gsz = (nM - fm) < WGM ? (nM - fm) : WGM;
        u.pm = fm + ((wgid % nig) % gsz); u.pn = (wgid % nig) / gsz; return true;
    }
    __device__ __forceinline__ void a_ready(const Unit&) const {}
    __device__ __forceinline__ void done(const Unit&) const {}
};

typedef float f32x2_cv __attribute__((ext_vector_type(2))); typedef __bf16 bf16x2_cv __attribute__((ext_vector_type(2)));
__device__ __forceinline__ unsigned cvt_pk_bf16(float lo, float hi) { f32x2_cv v = {lo, hi}; bf16x2_cv b = __builtin_convertvector(v, bf16x2_cv); return __builtin_bit_cast(unsigned, b); }
typedef unsigned u32x2 __attribute__((ext_vector_type(2)));
__device__ __forceinline__ float bf_lo(unsigned w) { return __uint_as_float(w << 16); }
__device__ __forceinline__ float bf_hi(unsigned w) { return __uint_as_float(w & 0xffff0000u); }
__device__ __forceinline__ float sigmoidf_(float z) { return 1.f / (1.f + __expf(-z)); }

struct EpiProj {
    static constexpr bool PERM = true, AFTER_DRAIN = false, HAS_MID = false;
    bf16_t* proj; float* alf; bf16_t* gab; const float* lb; unsigned* kmax;
    template <int MODE>
    __device__ __forceinline__ void tile(const f32x4 (&acc)[2][2][4][2], bf16_t* base, int ldc, int row0, int col0) const {
        float lbv[2][8];
        if (MODE == 1) {
#pragma unroll
            for (int bj = 0; bj < 2; ++bj)
#pragma unroll
                for (int j = 0; j < 8; ++j) lbv[bj][j] = lb[col0 + bj * HALF + j];
        }
#pragma unroll
        for (int ai = 0; ai < 2; ++ai)
#pragma unroll
            for (int m = 0; m < 4; ++m) {
                const size_t ro = (size_t)(row0 + ai * HALF + m * 16) * ldc + col0;
#pragma unroll
                for (int bj = 0; bj < 2; ++bj) {
                    float v[8];
#pragma unroll
                    for (int j = 0; j < 4; ++j) { v[j] = acc[ai][bj][m][0][j]; v[4 + j] = acc[ai][bj][m][1][j]; }
                    if (MODE == 1) {
                        float lf[8];
#pragma unroll
                        for (int j = 0; j < 8; ++j) {
                            const float z = v[j], l = lbv[bj][j];
                            const float t = __expf(-z), sg = __builtin_amdgcn_rcpf(1.f + t), sn = (t > 3.0e38f) ? 1.f : t * sg;
                            lf[j] = __logf(l + (1.f - l) * sg); v[j] = (1.f - l) * sn;
                        }
                        float* ap = alf + ro + bj * HALF;
                        *(f32x4*)ap = (f32x4){lf[0], lf[1], lf[2], lf[3]}; *(f32x4*)(ap + 4) = (f32x4){lf[4], lf[5], lf[6], lf[7]};
                    } else if (MODE == 2) {
#pragma unroll
                        for (int j = 0; j < 8; ++j) v[j] *= QSCALE;
                    } else if (MODE == 3) {
#pragma unroll
                        for (int j = 0; j < 8; ++j) v[j] = __builtin_amdgcn_rcpf(1.f + __expf(-v[j]));
                    }
                    u32x4 w; w.x = cvt_pk_bf16(v[0], v[1]); w.y = cvt_pk_bf16(v[2], v[3]); w.z = cvt_pk_bf16(v[4], v[5]); w.w = cvt_pk_bf16(v[6], v[7]);
                    *(u32x4*)(base + ro + bj * HALF) = w;
                }
            }
    }
    __device__ __forceinline__ void operator()(const f32x4 (&acc)[2][2][4][2], const Unit& u, int wr, int wc, int fr, int fq) const {
        const int pn = u.pn; const int row0 = u.pm * BM + wr * 64 + fr;
        if (pn < 28) {
            const int grp = pn >> 2; bf16_t* base = proj + (size_t)grp * ((size_t)S * 1024); const int col0 = (pn & 3) * 256 + wc * 32 + 8 * fq;
            if (grp == 1) tile<1>(acc, base, 1024, row0, col0); else if (grp == 4) tile<2>(acc, base, 1024, row0, col0); else tile<0>(acc, base, 1024, row0, col0);
            if (grp == 5) {
                float mx[2] = {0.f, 0.f};
#pragma unroll
                for (int ai = 0; ai < 2; ++ai)
#pragma unroll
                    for (int bj = 0; bj < 2; ++bj)
#pragma unroll
                        for (int m = 0; m < 4; ++m)
#pragma unroll
                            for (int n = 0; n < 2; ++n)
#pragma unroll
                                for (int j = 0; j < 4; ++j) mx[bj] = fmaxf(mx[bj], fabsf(acc[ai][bj][m][n][j]));
#pragma unroll
                for (int bj = 0; bj < 2; ++bj) {
#pragma unroll
                    for (int o = 1; o < 64; o <<= 1) mx[bj] = fmaxf(mx[bj], __shfl_xor(mx[bj], o));
                    if ((fr | (fq << 4)) == 0) __hip_atomic_fetch_max(kmax + 2 * (pn & 3) + bj, __float_as_uint(mx[bj]), __ATOMIC_RELAXED, __HIP_MEMORY_SCOPE_AGENT);
                }
            }
        } else {
            const int col0 = (pn - 28) * HALF + wc * 32 + 8 * fq; bf16_t* rbuf = gab; bf16_t* sbuf = gab + (size_t)S * 2048;
#pragma unroll
            for (int ai = 0; ai < 2; ++ai)
#pragma unroll
                for (int m = 0; m < 4; ++m) { const size_t ro = (size_t)(row0 + ai * HALF + m * 16) * 2048 + col0;
                    float r[8], sb[8];
#pragma unroll
                    for (int j = 0; j < 8; ++j) { const float ga_ = acc[ai][0][m][j >> 2][j & 3], gb_ = acc[ai][1][m][j >> 2][j & 3];
                        const float ta = __expf(-ga_), tb = fminf(__expf(-gb_), 1e30f);
                        sb[j] = __builtin_amdgcn_rcpf(1.f + tb); r[j] = (1.f + tb) * __builtin_amdgcn_rcpf(1.f + ta); }
                    u32x4 w; w.x = cvt_pk_bf16(r[0], r[1]); w.y = cvt_pk_bf16(r[2], r[3]); w.z = cvt_pk_bf16(r[4], r[5]); w.w = cvt_pk_bf16(r[6], r[7]);
                    *(u32x4*)(rbuf + ro) = w;
                    w.x = cvt_pk_bf16(sb[0], sb[1]); w.y = cvt_pk_bf16(sb[2], sb[3]); w.z = cvt_pk_bf16(sb[4], sb[5]); w.w = cvt_pk_bf16(sb[6], sb[7]);
                    *(u32x4*)(sbuf + ro) = w; }
        }
    }
};
struct EpiUp {
    static constexpr bool PERM = true, AFTER_DRAIN = false, HAS_MID = true;
    const bf16_t* ga; const bf16_t* gb; bf16_t* mg;
    __device__ __forceinline__ void mid(f32x4 (&acc)[2][2][4][2], const Unit& u, int wr, int wc, int fr, int fq) const {
        asm volatile("" : "+v"(fr), "+v"(fq));
        const int row0 = u.pm * BM + wr * 64 + fr, col0 = u.pn * BM + wc * 32 + 8 * fq;
        u32x4 av[2][4][2];
#pragma unroll
        for (int ai = 0; ai < 2; ++ai)
#pragma unroll
            for (int m = 0; m < 4; ++m)
#pragma unroll
                for (int bj = 0; bj < 2; ++bj) av[ai][m][bj] = *(const u32x4*)(ga + (size_t)(row0 + ai * HALF + m * 16) * DM + col0 + bj * HALF);
#pragma unroll
        for (int ai = 0; ai < 2; ++ai)
#pragma unroll
            for (int m = 0; m < 4; ++m)
#pragma unroll
                for (int bj = 0; bj < 2; ++bj)
#pragma unroll
                    for (int q = 0; q < 4; ++q) { const unsigned aw = av[ai][m][bj][q];
                        acc[ai][bj][m][q >> 1][2 * (q & 1)] *= bf_lo(aw); acc[ai][bj][m][q >> 1][2 * (q & 1) + 1] *= bf_hi(aw); }
        asm volatile("" ::: "memory");
    }
    __device__ __forceinline__ void operator()(const f32x4 (&acc)[2][2][4][2], const Unit& u, int wr, int wc, int fr, int fq) const {
        const int row0 = u.pm * BM + wr * 64 + fr, col0 = u.pn * BM + wc * 32 + 8 * fq;
#pragma unroll
        for (int ai = 0; ai < 2; ++ai) {
            u32x4 gv[4][2];
#pragma unroll
            for (int m = 0; m < 4; ++m)
#pragma unroll
                for (int bj = 0; bj < 2; ++bj) gv[m][bj] = *(const u32x4*)(gb + (size_t)(row0 + ai * HALF + m * 16) * DM + col0 + bj * HALF);
#pragma unroll
            for (int m = 0; m < 4; ++m)
#pragma unroll
                for (int bj = 0; bj < 2; ++bj) { const size_t ro = (size_t)(row0 + ai * HALF + m * 16) * DM + col0 + bj * HALF;
                    const u32x4 gq = gv[m][bj];
                    float v[8];
#pragma unroll
                    for (int j = 0; j < 4; ++j) { v[j] = acc[ai][bj][m][0][j]; v[4 + j] = acc[ai][bj][m][1][j]; }
                    v[0] *= bf_lo(gq.x); v[1] *= bf_hi(gq.x); v[2] *= bf_lo(gq.y); v[3] *= bf_hi(gq.y); v[4] *= bf_lo(gq.z); v[5] *= bf_hi(gq.z); v[6] *= bf_lo(gq.w); v[7] *= bf_hi(gq.w);
                    u32x4 w; w.x = cvt_pk_bf16(v[0], v[1]); w.y = cvt_pk_bf16(v[2], v[3]); w.z = cvt_pk_bf16(v[4], v[5]); w.w = cvt_pk_bf16(v[6], v[7]);
                    *(u32x4*)(mg + ro) = w; }
        }
    }
};
struct EpiT16 {
    static constexpr bool PERM = true, AFTER_DRAIN = false, HAS_MID = false;
    bf16_t* O;
    __device__ __forceinline__ void operator()(const f32x4 (&acc)[2][2][4][2], const Unit& u, int wr, int wc, int fr, int fq) const {
        const int row0 = u.pm * BM + wr * 64 + fr, col0 = u.pn * BM + wc * 32 + 8 * fq;
#pragma unroll
        for (int ai = 0; ai < 2; ++ai)
#pragma unroll
            for (int m = 0; m < 4; ++m)
#pragma unroll
                for (int bj = 0; bj < 2; ++bj) { const f32x4 v0 = acc[ai][bj][m][0], v1 = acc[ai][bj][m][1];
                    u32x4 w; w.x = cvt_pk_bf16(v0[0], v0[1]); w.y = cvt_pk_bf16(v0[2], v0[3]); w.z = cvt_pk_bf16(v1[0], v1[1]); w.w = cvt_pk_bf16(v1[2], v1[3]);
                    *(u32x4*)(O + (size_t)(row0 + ai * HALF + m * 16) * DM + col0 + bj * HALF) = w; }
    }
};
struct EpiF32 {
    static constexpr bool PERM = false, AFTER_DRAIN = false, HAS_MID = false;
    float* O; int ldc;
    __device__ __forceinline__ void operator()(const f32x4 (&acc)[2][2][4][2], const Unit& u, int wr, int wc, int fr, int fq) const {
        const int row0 = u.pm * BM + wr * 64 + fr, col0 = u.pn * BM + wc * 32 + 4 * fq;
#pragma unroll
        for (int ai = 0; ai < 2; ++ai)
#pragma unroll
            for (int m = 0; m < 4; ++m) {
                float* rp = O + (size_t)(row0 + ai * HALF + m * 16) * ldc + col0;
#pragma unroll
                for (int bj = 0; bj < 2; ++bj)
#pragma unroll
                    for (int n = 0; n < 2; ++n) *(f32x4*)(rp + bj * HALF + n * 16) = acc[ai][bj][m][n];
            }
    }
};
struct EpiSwiglu {
    static constexpr bool PERM = true, AFTER_DRAIN = false, HAS_MID = false;
    bf16_t* hid;
    __device__ __forceinline__ void operator()(const f32x4 (&acc)[2][2][4][2], const Unit& u, int wr, int wc, int fr, int fq) const {
        const int row0 = u.pm * BM + wr * 64 + fr, col0 = u.pn * HALF + wc * 32 + 8 * fq;
#pragma unroll
        for (int ai = 0; ai < 2; ++ai)
#pragma unroll
            for (int m = 0; m < 4; ++m) {
                float v[8];
#pragma unroll
                for (int j = 0; j < 4; ++j) { const float g0 = acc[ai][0][m][0][j], g1 = acc[ai][0][m][1][j];
                    v[j] = g0 / (1.f + __expf(-g0)) * acc[ai][1][m][0][j]; v[4 + j] = g1 / (1.f + __expf(-g1)) * acc[ai][1][m][1][j]; }
                u32x4 w; w.x = cvt_pk_bf16(v[0], v[1]); w.y = cvt_pk_bf16(v[2], v[3]); w.z = cvt_pk_bf16(v[4], v[5]); w.w = cvt_pk_bf16(v[6], v[7]);
                *(u32x4*)(hid + (size_t)(row0 + ai * HALF + m * 16) * DFF + col0) = w;
            }
    }
};

template <class Epi, class Sched, bool ALIGN_EPI = false, bool SP2 = false>
__device__ __forceinline__ void gemm_phase(PG8_LAS unsigned char* lds, const Gemm g, const Sched& S, const Epi& E) {
    const int tid = threadIdx.x, wid = __builtin_amdgcn_readfirstlane(tid >> 6), lane = tid & 63, wr = wid >> 2, wc = wid & 3, fr = lane & 15, fq = lane >> 4;
    const int K = g.K, nt = K / BK;
    unsigned voffA[2], voffB[2];
#pragma unroll
    for (int i = 0; i < 2; ++i) { int R, C; stage_rc(tid * 16 + i * 8192, R, C); const int Rb = Epi::PERM ? ((R & ~31) + perm32(R & 31)) : R;
        voffA[i] = (unsigned)(R * K + C) * 2u; voffB[i] = (unsigned)(Rb * K + C) * 2u; }
    const size_t kstep = (size_t)(BK * 2);
    const size_t hstep = (size_t)HALF * K * 2;
    const size_t tstep = 2 * hstep;
    const unsigned ldsw = (unsigned)wid * 1024u;
    const int aoff = lds_byte(wr * 64 + fr, fq * 8), boff = lds_byte(wc * 32 + fr, fq * 8);
#define PG8_SA(b, h) (((b) * 2 + (h)) * HTB)
#define PG8_SB(b, h) ((4 + (b) * 2 + (h)) * HTB)
#define PG8_STAGE(bufoff, gbase, voff) do { _Pragma("unroll") for (int _i = 0; _i < 2; ++_i) \
        __builtin_amdgcn_global_load_lds((const unsigned*)((const char*)(gbase) + (voff)[_i]), (PG8_LAS unsigned*)(lds + (bufoff) + ldsw + _i * 8192), 16, 0, 0); } while (0)
#define PG8_LDA(dst, b, h) do { _Pragma("unroll") for (int m = 0; m < 4; ++m) _Pragma("unroll") for (int k = 0; k < 2; ++k) dst[m][k] = *(const PG8_LAS bf16x8*)(lds + PG8_SA(b, h) + aoff + m * 2048 + k * 1024); } while (0)
#define PG8_LDB(dst, b, h) do { _Pragma("unroll") for (int n = 0; n < 2; ++n) _Pragma("unroll") for (int k = 0; k < 2; ++k) dst[n][k] = *(const PG8_LAS bf16x8*)(lds + PG8_SB(b, h) + boff + n * 2048 + k * 1024); } while (0)
#define PG8_MMA(ai, bj, At, Bt) do { __builtin_amdgcn_s_setprio(1); _Pragma("unroll") for (int m = 0; m < 4; ++m) _Pragma("unroll") for (int n = 0; n < 2; ++n) _Pragma("unroll") for (int k = 0; k < 2; ++k) \
        acc[ai][bj][m][n] = __builtin_amdgcn_mfma_f32_16x16x32_bf16(Bt[n][k], At[m][k], acc[ai][bj][m][n], 0, 0, 0); __builtin_amdgcn_s_setprio(0); } while (0)
#define PG8_WAIT_V(n) asm volatile("s_waitcnt vmcnt(" #n ")" ::: "memory")
#define PG8_WAIT_L(n) asm volatile("s_waitcnt lgkmcnt(" #n ")" ::: "memory")
#define PG8_BAR __builtin_amdgcn_s_barrier()
#define PG8_SCHED __builtin_amdgcn_sched_barrier(0)
    Unit cur, nxt; int ui = 0;
    if (!S.next(0, cur)) return;
    f32x4 acc[2][2][4][2];
#pragma unroll
    for (int a = 0; a < 2; ++a)
#pragma unroll
        for (int b = 0; b < 2; ++b)
#pragma unroll
            for (int m = 0; m < 4; ++m)
#pragma unroll
                for (int n = 0; n < 2; ++n) acc[a][b][m][n] = (f32x4){0.f, 0.f, 0.f, 0.f};
    bf16x8 At[4][2], B0[2][2], B1[2][2];
    const char* cA = (const char*)g.A + (size_t)cur.pm * tstep; const char* cB = (const char*)g.Bt + (size_t)cur.pn * tstep;
    S.a_ready(cur);
    if constexpr (SP2) {
        PG8_STAGE(PG8_SB(0, 0), cB, voffB); PG8_STAGE(PG8_SB(0, 1), cB + hstep, voffB); PG8_STAGE(PG8_SA(0, 0), cA, voffA); PG8_STAGE(PG8_SA(0, 1), cA + hstep, voffA);
        if (wr == 1) PG8_BAR;
        PG8_WAIT_V(2); PG8_BAR;
        PG8_STAGE(PG8_SB(1, 0), cB + kstep, voffB); PG8_STAGE(PG8_SA(1, 0), cA + kstep, voffA); PG8_STAGE(PG8_SB(1, 1), cB + hstep + kstep, voffB);
        PG8_WAIT_V(6); PG8_BAR;
    } else {
        PG8_STAGE(PG8_SB(0, 0), cB, voffB); PG8_STAGE(PG8_SA(0, 0), cA, voffA); PG8_STAGE(PG8_SB(0, 1), cB + hstep, voffB); PG8_STAGE(PG8_SA(0, 1), cA + hstep, voffA);
        if (wr == 1) PG8_BAR;
        PG8_WAIT_V(4); PG8_BAR;
        PG8_STAGE(PG8_SB(1, 0), cB + kstep, voffB); PG8_STAGE(PG8_SA(1, 0), cA + kstep, voffA); PG8_STAGE(PG8_SB(1, 1), cB + hstep + kstep, voffB);
        PG8_WAIT_V(6); PG8_BAR;
    }
    for (;;) {
        const bool has_next = S.next(ui + 1, nxt);
        const char* nA = has_next ? (const char*)g.A + (size_t)nxt.pm * tstep : cA; const char* nB = has_next ? (const char*)g.Bt + (size_t)nxt.pn * tstep : cB;
        for (int t = 0; t < nt; t += 2) {
            if constexpr (Epi::HAS_MID) { if (t == (nt >> 1)) E.mid(acc, cur, wr, wc, fr, fq); }
            const bool last = (t == nt - 2);
            const char* a1 = cA + (size_t)(t + 1) * kstep;
            const char* a2 = last ? nA : cA + (size_t)(t + 2) * kstep; const char* b2 = last ? nB : cB + (size_t)(t + 2) * kstep;
            const char* a3 = a2 + kstep; const char* b3 = b2 + kstep;
            if (last && has_next) S.a_ready(nxt);
            if constexpr (SP2) {
            PG8_LDB(B0, 0, 0); PG8_LDB(B1, 0, 1); PG8_SCHED; PG8_LDA(At, 0, 0); PG8_STAGE(PG8_SA(1, 1), a1 + hstep, voffA);
            PG8_WAIT_V(8); PG8_WAIT_L(0); PG8_BAR; PG8_MMA(0, 0, At, B0); PG8_MMA(0, 1, At, B1); PG8_BAR; PG8_SCHED;
            PG8_LDA(At, 0, 1); PG8_STAGE(PG8_SB(0, 0), b2, voffB); PG8_STAGE(PG8_SB(0, 1), b2 + hstep, voffB); PG8_STAGE(PG8_SA(0, 0), a2, voffA);
            PG8_WAIT_V(8); PG8_WAIT_L(0); PG8_BAR; PG8_MMA(1, 0, At, B0); PG8_MMA(1, 1, At, B1); PG8_BAR; PG8_SCHED;
            PG8_LDB(B0, 1, 0); PG8_LDB(B1, 1, 1); PG8_SCHED; PG8_LDA(At, 1, 0); PG8_STAGE(PG8_SA(0, 1), a2 + hstep, voffA);
            PG8_WAIT_V(8); PG8_WAIT_L(0); PG8_BAR; PG8_MMA(0, 0, At, B0); PG8_MMA(0, 1, At, B1); PG8_BAR; PG8_SCHED;
            PG8_LDA(At, 1, 1); PG8_STAGE(PG8_SB(1, 0), b3, voffB); PG8_STAGE(PG8_SB(1, 1), b3 + hstep, voffB); PG8_STAGE(PG8_SA(1, 0), a3, voffA);
            PG8_WAIT_V(8); PG8_WAIT_L(0); PG8_BAR; PG8_MMA(1, 0, At, B0); PG8_MMA(1, 1, At, B1); PG8_BAR; PG8_SCHED;
            } else {
            PG8_LDB(B0, 0, 0); PG8_SCHED; PG8_LDA(At, 0, 0); PG8_STAGE(PG8_SA(1, 1), a1 + hstep, voffA);
            PG8_WAIT_L(8); PG8_BAR; PG8_WAIT_L(0); PG8_MMA(0, 0, At, B0); PG8_BAR; PG8_SCHED;
            PG8_LDB(B1, 0, 1); PG8_STAGE(PG8_SB(0, 0), b2, voffB);
            PG8_BAR; PG8_WAIT_L(0); PG8_MMA(0, 1, At, B1); PG8_BAR;
            PG8_LDA(At, 0, 1); PG8_STAGE(PG8_SA(0, 0), a2, voffA);
            PG8_BAR; PG8_WAIT_L(0); PG8_MMA(1, 0, At, B0); PG8_BAR; PG8_SCHED;
            PG8_STAGE(PG8_SB(0, 1), b2 + hstep, voffB);
            PG8_WAIT_V(6); PG8_BAR; PG8_MMA(1, 1, At, B1); PG8_BAR;
            PG8_LDB(B0, 1, 0); PG8_SCHED; PG8_LDA(At, 1, 0); PG8_STAGE(PG8_SA(0, 1), a2 + hstep, voffA);
            PG8_WAIT_L(8); PG8_BAR; PG8_WAIT_L(0); PG8_MMA(0, 0, At, B0); PG8_BAR; PG8_SCHED;
            PG8_LDB(B1, 1, 1); PG8_STAGE(PG8_SB(1, 0), b3, voffB);
            PG8_BAR; PG8_WAIT_L(0); PG8_MMA(0, 1, At, B1); PG8_BAR;
            PG8_LDA(At, 1, 1); PG8_STAGE(PG8_SA(1, 0), a3, voffA);
            PG8_BAR; PG8_WAIT_L(0); PG8_MMA(1, 0, At, B0); PG8_BAR; PG8_SCHED;
            PG8_STAGE(PG8_SB(1, 1), b3 + hstep, voffB);
            PG8_WAIT_V(6); PG8_BAR; PG8_MMA(1, 1, At, B1); PG8_BAR;
            }
        }
        if constexpr (ALIGN_EPI) { if (wr == 0) PG8_BAR; }
        if constexpr (!Epi::AFTER_DRAIN) { E(acc, cur, wr, wc, fr, fq); S.done(cur); }
        if (!has_next) break;
#pragma unroll
        for (int a = 0; a < 2; ++a)
#pragma unroll
            for (int b = 0; b < 2; ++b)
#pragma unroll
                for (int m = 0; m < 4; ++m)
#pragma unroll
                    for (int n = 0; n < 2; ++n) acc[a][b][m][n] = (f32x4){0.f, 0.f, 0.f, 0.f};
        cur = nxt; cA = nA; cB = nB; ++ui;
        if constexpr (ALIGN_EPI) { if (wr == 1) PG8_BAR; }
    }
    PG8_WAIT_V(0);
    if constexpr (!ALIGN_EPI) { if (wr == 0) PG8_BAR; }
    PG8_BAR;
    if constexpr (Epi::AFTER_DRAIN) { E.fused(acc, cur, wr, wc, fr, fq, lds, wid, lane); S.done(cur); }
#undef PG8_SA
#undef PG8_SB
#undef PG8_STAGE
#undef PG8_LDA
#undef PG8_LDB
#undef PG8_MMA
#undef PG8_WAIT_V
#undef PG8_WAIT_L
#undef PG8_BAR
#undef PG8_SCHED
}
}

#include <hip/hip_bf16.h>
namespace fox {
constexpr int D = 128, PITCH = 1024, OPITCH = 2048;
constexpr float THR2 = 11.5f, LOG2E_ = 1.4426950408889634f;
constexpr bool WSKIP = false;
constexpr int NW = 8, QBLK = 32, KVBLK = 64, QB = NW * QBLK;
constexpr int SHM_V = KVBLK * D * 2, SHM_K = KVBLK * D * 2;
constexpr int LDS_BYTES = 2 * SHM_V + 2 * SHM_K + NW * 64 * 4;

using bf16 = __hip_bfloat16;
typedef short bf16x8 __attribute__((ext_vector_type(8)));
typedef short s16x4 __attribute__((ext_vector_type(4)));
typedef float f32x16 __attribute__((ext_vector_type(16)));
typedef float f32x4 __attribute__((ext_vector_type(4)));
typedef unsigned u32x4 __attribute__((ext_vector_type(4)));
template <class A, class Bt> struct same_t { static constexpr bool v = false; };
template <class A> struct same_t<A, A> { static constexpr bool v = true; };

#define KSWZ(row, colB) ((row) * 256 + ((colB) ^ (((row) & 7) << 4)))
#define SBAR() __builtin_amdgcn_sched_barrier(0)
__device__ __forceinline__ int v_st(int k, int c) { const int kk = (k & ~0xC) | ((k & 4) << 1) | ((k & 8) >> 1); return ((kk >> 3) * 4 + (c >> 5)) * 512 + ((kk & 7) * 32 + (c & 31)) * 2; }
__device__ __forceinline__ int v_rd_base(int lane) { return ((lane & 3) << 3) | (((lane >> 2) & 3) << 6) | (((lane >> 4) & 1) << 5) | (((lane >> 5) & 1) << 8); }
constexpr int v_rd_off(int d0, int ks, int half) { return d0 * 512 + ks * 4096 + half * 2048; }
__device__ __forceinline__ int crow(int r, int hi) { return (r & 3) + 8 * (r >> 2) + 4 * hi; }
__device__ __forceinline__ unsigned cvtpk(float lo, float hi) {
    unsigned r; asm volatile("v_cvt_pk_bf16_f32 %0, %1, %2" : "=v"(r) : "v"(lo), "v"(hi)); return r;
}
__device__ __forceinline__ bf16x8 pack8(f32x4 a, f32x4 b) {
    u32x4 w = {cvtpk(a[0], a[1]), cvtpk(a[2], a[3]), cvtpk(b[0], b[1]), cvtpk(b[2], b[3])};
    return *reinterpret_cast<bf16x8*>(&w);
}
template <class T> __device__ __forceinline__ bf16x8 load8(const T* p) {
    if constexpr (same_t<T, float>::v) { return pack8(*(const f32x4*)p, *(const f32x4*)(p + 4)); }
    else { return *reinterpret_cast<const bf16x8*>(p); }
}
__device__ __forceinline__ void mask_tile(f32x16& p0, f32x16& p1, int dq, unsigned W) {
    const float NEG = -__builtin_inff();
#pragma unroll
    for (int r = 0; r < 16; ++r) {
        const int c = (r & 3) + 8 * (r >> 2);
        if ((unsigned)(dq - c) >= W) p0[r] = NEG;
        if ((unsigned)(dq - c - 32) >= W) p1[r] = NEG;
    }
}
__device__ __forceinline__ void partialSM(f32x16& p0, f32x16& p1, float& m_reg, float& mn, float& alpha, const __attribute__((address_space(3))) float* cbt) {
    SBAR();
#pragma unroll
    for (int g = 0; g < 4; ++g) { const f32x4 b0 = *(const __attribute__((address_space(3))) f32x4*)(cbt + 8 * g), b1 = *(const __attribute__((address_space(3))) f32x4*)(cbt + 32 + 8 * g);
        p0[4 * g] += b0[0]; p0[4 * g + 1] += b0[1]; p0[4 * g + 2] += b0[2]; p0[4 * g + 3] += b0[3];
        p1[4 * g] += b1[0]; p1[4 * g + 1] += b1[1]; p1[4 * g + 2] += b1[2]; p1[4 * g + 3] += b1[3]; }
    float pmax = p0[0]; for (int r = 1; r < 16; ++r) pmax = fmaxf(pmax, p0[r]); for (int r = 0; r < 16; ++r) pmax = fmaxf(pmax, p1[r]);
    { auto rr = __builtin_amdgcn_permlane32_swap(__float_as_uint(pmax), __float_as_uint(pmax), false, false);
      pmax = fmaxf(__uint_as_float(rr[0]), __uint_as_float(rr[1])); }
    if (__builtin_expect(__all((pmax - m_reg) <= THR2), 1)) { mn = m_reg; alpha = 1.f; }
    else { mn = fmaxf(m_reg, pmax); alpha = __builtin_amdgcn_exp2f(m_reg - mn); m_reg = mn; }
    for (int r = 0; r < 16; ++r) p0[r] = p0[r] - mn; for (int r = 0; r < 16; ++r) p1[r] = p1[r] - mn;
    for (int r = 0; r < 16; ++r) p0[r] = __builtin_amdgcn_exp2f(p0[r]);
}
__device__ __forceinline__ void finishSM(f32x16& p0, f32x16& p1, float alpha, float& l_reg, bf16x8& pa0, bf16x8& pa1, bf16x8& pa2, bf16x8& pa3) {
    for (int r = 0; r < 16; ++r) p1[r] = __builtin_amdgcn_exp2f(p1[r]);
    float ps = 0; for (int r = 0; r < 16; ++r) ps += p0[r]; for (int r = 0; r < 16; ++r) ps += p1[r];
    { auto rr = __builtin_amdgcn_permlane32_swap(__float_as_uint(ps), __float_as_uint(ps), false, false);
      ps = __uint_as_float(rr[0]) + __uint_as_float(rr[1]); }
    l_reg = l_reg * alpha + ps;
#define PK4(P, B_, OUT) do { unsigned a0 = cvtpk(P[B_+0], P[B_+1]), a1 = cvtpk(P[B_+2], P[B_+3]);                          \
        unsigned b0 = cvtpk(P[B_+4], P[B_+5]), b1 = cvtpk(P[B_+6], P[B_+7]);                                             \
        auto r0 = __builtin_amdgcn_permlane32_swap(a0, b0, false, false); auto r1 = __builtin_amdgcn_permlane32_swap(a1, b1, false, false); \
        u32x4 w = {r0[0], r1[0], r0[1], r1[1]}; OUT = *reinterpret_cast<bf16x8*>(&w); } while (0)
    PK4(p0, 0, pa0); PK4(p0, 8, pa1); PK4(p1, 0, pa2); PK4(p1, 8, pa3);
#undef PK4
}
template <int KB, bool SK>
__device__ __forceinline__ void qkt(f32x16& p0, f32x16& p1, const char* K_lds, int r32, int hi, const bf16x8* qr, bool act) {
    if (SK && !act) { const float NEG = -__builtin_inff();
#pragma unroll
        for (int r = 0; r < 16; ++r) { p0[r] = NEG; p1[r] = NEG; } return; }
    p0 = f32x16{}; p1 = f32x16{};
    const char* kb[4];
#pragma unroll
    for (int dd = 0; dd < 4; ++dd) kb[dd] = K_lds + KB * SHM_K + KSWZ(r32, (dd * 16 + hi * 8) * 2);
#pragma unroll
    for (int d0 = 0; d0 < 8; ++d0) { const char* a = kb[d0 & 3] + (d0 >> 2) * 128;
        bf16x8 b0 = *reinterpret_cast<const bf16x8*>(a);
        bf16x8 b1 = *reinterpret_cast<const bf16x8*>(a + 32 * 256);
        p0 = __builtin_amdgcn_mfma_f32_32x32x16_bf16(b0, qr[d0], p0, 0, 0, 0);
        p1 = __builtin_amdgcn_mfma_f32_32x32x16_bf16(b1, qr[d0], p1, 0, 0, 0); }
}
template <int VB, bool SK>
__device__ __forceinline__ void pv_tile(f32x16* o, int vb0, bf16x8 pa0, bf16x8 pa1, bf16x8 pa2, bf16x8 pa3, bool act) {
    if (SK && !act) return;
#define TRRD(dst, off) asm volatile("ds_read_b64_tr_b16 %0, %1 offset:%2" : "=&v"(dst) : "v"(vb0), "i"(off) : "memory")
#define PV_D0(d0) do { s16x4 l0, l1, l2, l3, h0, h1, h2, h3; constexpr int b_ = VB * SHM_V + v_rd_off(d0, 0, 0);     \
        TRRD(l0, b_); TRRD(h0, b_ + 2048); TRRD(l1, b_ + 4096); TRRD(h1, b_ + 6144); TRRD(l2, b_ + 8192); TRRD(h2, b_ + 10240); TRRD(l3, b_ + 12288); TRRD(h3, b_ + 14336); \
        asm volatile("s_waitcnt lgkmcnt(0)" ::: "memory"); SBAR();                 \
        o[d0] = __builtin_amdgcn_mfma_f32_32x32x16_bf16(pa0, (bf16x8){l0[0], l0[1], l0[2], l0[3], h0[0], h0[1], h0[2], h0[3]}, o[d0], 0, 0, 0);   \
        o[d0] = __builtin_amdgcn_mfma_f32_32x32x16_bf16(pa1, (bf16x8){l1[0], l1[1], l1[2], l1[3], h1[0], h1[1], h1[2], h1[3]}, o[d0], 0, 0, 0);   \
        o[d0] = __builtin_amdgcn_mfma_f32_32x32x16_bf16(pa2, (bf16x8){l2[0], l2[1], l2[2], l2[3], h2[0], h2[1], h2[2], h2[3]}, o[d0], 0, 0, 0);   \
        o[d0] = __builtin_amdgcn_mfma_f32_32x32x16_bf16(pa3, (bf16x8){l3[0], l3[1], l3[2], l3[3], h3[0], h3[1], h3[2], h3[3]}, o[d0], 0, 0, 0); } while (0)
    PV_D0(0); PV_D0(1); PV_D0(2); PV_D0(3);
#undef PV_D0
#undef TRRD
}

template <class TIn, class TOut> struct BlockRef { const TIn* Q; const TIn* K; const TIn* V; TOut* O; const float* C; int P0; int JLO; };
template <class TIn> struct Seam {
    bf16x8 qr[8];
    bf16x8 st_v0, st_v1, st_k0, st_k1; f32x4 sf0, sf1, sf2, sf3;
    f32x4 tq[16];
};
__device__ __forceinline__ int swa_jlo(int P0, int W) { const int lowk = P0 - W + 1; return lowk > 0 ? lowk / KVBLK : 0; }
#define ROW(p, k0, rr) ((p) + (size_t)((k0) + (rr)) * PITCH + sc)
#define VMW() asm volatile("s_waitcnt vmcnt(0)" ::: "memory")
#define VMWN(n) asm volatile("s_waitcnt vmcnt(%0)" :: "i"(n) : "memory")
#define SLOAD_H(Kp, Vp, k0) do { S.st_v0 = load8<TIn>(ROW(Vp, k0, sr)); S.st_v1 = load8<TIn>(ROW(Vp, k0, 32 + sr));              \
                         S.st_k0 = load8<TIn>(ROW(Kp, k0, sr)); S.st_k1 = load8<TIn>(ROW(Kp, k0, 32 + sr)); } while (0)
#define SWRITE_HK(bf) do { *(bf16x8*)(K_lds + (bf) * SHM_K + kws) = S.st_k0; *(bf16x8*)(K_lds + (bf) * SHM_K + kws + 32 * 256) = S.st_k1; } while (0)
#define SWRITE_HV(bf) do { *(bf16x8*)(V_lds + (bf) * SHM_V + vst0) = S.st_v0; *(bf16x8*)(V_lds + (bf) * SHM_V + vst1) = S.st_v1; } while (0)
#define SWRITE_H(bf) do { SWRITE_HV(bf); SWRITE_HK(bf); } while (0)
#define SLOAD_F(p, k0) do { S.sf0 = *(const f32x4*)ROW(p, k0, sr); S.sf1 = *(const f32x4*)(ROW(p, k0, sr) + 4);                \
                            S.sf2 = *(const f32x4*)ROW(p, k0, 32 + sr); S.sf3 = *(const f32x4*)(ROW(p, k0, 32 + sr) + 4); } while (0)
#define SWRITE_KF(bf) do { *(bf16x8*)(K_lds + (bf) * SHM_K + kws) = pack8(S.sf0, S.sf1); *(bf16x8*)(K_lds + (bf) * SHM_K + kws + 32 * 256) = pack8(S.sf2, S.sf3); } while (0)
#define SWRITE_VF(bf) do { *(bf16x8*)(V_lds + (bf) * SHM_V + vst0) = pack8(S.sf0, S.sf1); *(bf16x8*)(V_lds + (bf) * SHM_V + vst1) = pack8(S.sf2, S.sf3); } while (0)
template <class TIn, class TOut>
__device__ __forceinline__ void causal_swa_prime(const BlockRef<TIn, TOut>& cur, int W, char* lds, Seam<TIn>& S) {
    constexpr bool F32 = same_t<TIn, float>::v;
    const int tid = threadIdx.x, wid = __builtin_amdgcn_readfirstlane(tid >> 6), lane = tid & 63, r32 = lane & 31, hi = lane >> 5;
    const int sr = tid >> 4, sc = (tid & 15) * 8, kws = KSWZ(sr, sc * 2); char* K_lds = lds + 2 * SHM_V;
    const int kb0 = cur.JLO * KVBLK;
    for (int d0 = 0; d0 < 8; ++d0) S.qr[d0] = load8<TIn>(cur.Q + (size_t)(wid * QBLK + r32) * PITCH + d0 * 16 + hi * 8);
    if constexpr (F32) { SLOAD_F((const float*)cur.K, kb0); VMW(); SWRITE_KF(0); SBAR(); SLOAD_F((const float*)cur.V, kb0); }
    else { SLOAD_H(cur.K, cur.V, kb0); VMW(); SWRITE_HK(0); }
    __syncthreads();
}
template <class TIn, class TOut>
__device__ __forceinline__ void causal_swa_block(const BlockRef<TIn, TOut>& cur, const BlockRef<TIn, TOut>& nxt, int skv, int W, char* lds, Seam<TIn>& S) {
    constexpr bool F32 = same_t<TIn, float>::v;
    const int tid = threadIdx.x, wid = __builtin_amdgcn_readfirstlane(tid >> 6), lane = tid & 63, r32 = lane & 31, hi = lane >> 5;
    const int j_lo = cur.JLO;
    int j_hi = (cur.P0 + QB - 1) / KVBLK + 1; if (j_hi > skv / KVBLK) j_hi = skv / KVBLK;
    const int NT = j_hi - j_lo;
    const int kbn = nxt.JLO * KVBLK;
    const int qlo = cur.P0 + wid * QBLK, qm = qlo + r32 - 4 * hi;
    char* V_lds = lds; char* K_lds = lds + 2 * SHM_V;
    float* ws = (float*)(lds + 2 * SHM_V + 2 * SHM_K) + wid * 64; float* li_l = ws, * al_l = ws + 32;
    __attribute__((address_space(3))) float* cb = (__attribute__((address_space(3))) float*)(lds + LDS_BYTES);
    { const float cref = cur.C[cur.P0]; const int nk = j_hi * KVBLK; int tq = tid * 4; asm volatile("" : "+v"(tq));
      for (int k = j_lo * KVBLK + tq; k < nk; k += 2048) { const f32x4 c4 = *(const f32x4*)(cur.C + k); *(__attribute__((address_space(3))) f32x4*)(cb + k) = (f32x4){(cref - c4[0]) * LOG2E_, (cref - c4[1]) * LOG2E_, (cref - c4[2]) * LOG2E_, (cref - c4[3]) * LOG2E_}; } }
    __syncthreads();
    const __attribute__((address_space(3))) float* cbh = cb + 4 * hi;
    float m_reg = -1e30f, l_reg = 0; f32x16 o[4] = {};
    const int sr = tid >> 4, sc = (tid & 15) * 8, vst0 = v_st(sr, sc), vst1 = v_st(32 + sr, sc), kws = KSWZ(sr, sc * 2);
    const int vb0 = (int)(uintptr_t)V_lds + v_rd_base(lane);
    const TIn* Kh = cur.K; const TIn* Vh = cur.V;
#define RESC(a) do { if (__any((a) < 1.f)) { if (hi == 0) al_l[r32] = (a); asm volatile("s_waitcnt lgkmcnt(0)" ::: "memory");              \
                     for (int d_ = 0; d_ < 4; ++d_) for (int r = 0; r < 16; ++r) o[d_][r] *= al_l[crow(r, hi)]; } } while (0)
#define KBASE(t) ((j_lo + (t)) * KVBLK)
#define ACT(t) (KBASE(t) <= qlo + QBLK - 1 && KBASE(t) + KVBLK - 1 >= qlo - W + 1)
#define MASKT(P0_, P1_, t) do { const int kb_ = KBASE(t); if ((!SK || ACT(t)) && (kb_ + KVBLK - 1 > qlo || kb_ <= qlo + QBLK - 1 - W)) mask_tile(P0_, P1_, qm - kb_, (unsigned)W); } while (0)
    constexpr int NQL = F32 ? 16 : 8;
    constexpr bool SK = WSKIP && !F32;
#define SEAM_K0() do { VMWN(NQL); if constexpr (F32) { SWRITE_KF(0); SBAR(); SLOAD_F((const float*)nxt.V, kbn); } else { SWRITE_HK(0); } SBAR(); } while (0)
    f32x16 pA0, pA1, pB0, pB1; float mnA, mnB, alA, alB; bf16x8 pa0, pa1, pa2, pa3;
    if constexpr (F32) { VMW(); SWRITE_VF(0); SBAR(); } else { SWRITE_HV(0); SBAR(); }
    if (NT > 1) { if constexpr (F32) SLOAD_F((const float*)Kh, KBASE(1)); else SLOAD_H(Kh, Vh, KBASE(1)); }
    SBAR(); qkt<0, SK>(pA0, pA1, K_lds, r32, hi, S.qr, ACT(0));
    if constexpr (F32) { if (NT > 1) { VMW(); SWRITE_KF(1); SBAR(); SLOAD_F((const float*)Vh, KBASE(1)); } }
    MASKT(pA0, pA1, 0); partialSM(pA0, pA1, m_reg, mnA, alA, cbh + KBASE(0));
    if (NT > 1) { VMW(); if constexpr (F32) { SWRITE_VF(1); SBAR(); if (NT > 2) SLOAD_F((const float*)Kh, KBASE(2)); } else SWRITE_H(1); }
    __syncthreads();
#define HALF_STEP(PX0, PX1, mnX, alX, PY0, PY1, alY, t, KB, VB, SB) do {                                                      \
        SBAR(); qkt<KB, SK>(PX0, PX1, K_lds, r32, hi, S.qr, ACT(t));                                             \
        finishSM(PY0, PY1, alY, l_reg, pa0, pa1, pa2, pa3); SBAR();                                                           \
        if ((t) + 1 < NT) { if constexpr (F32) { VMW(); SWRITE_KF(SB); SBAR(); SLOAD_F((const float*)Vh, KBASE((t) + 1)); }  \
                            else { SLOAD_H(Kh, Vh, KBASE((t) + 1)); } SBAR(); }                                               \
        pv_tile<VB, SK>(o, vb0, pa0, pa1, pa2, pa3, ACT((t) - 1)); MASKT(PX0, PX1, (t)); partialSM(PX0, PX1, m_reg, mnX, alX, cbh + KBASE(t));                                        \
        __syncthreads();                                                                                                      \
        if ((t) + 1 < NT) { VMW(); if constexpr (F32) { SWRITE_VF(SB); SBAR(); if ((t) + 2 < NT) SLOAD_F((const float*)Kh, KBASE((t) + 2)); } \
                            else { SWRITE_H(SB); } }                                                                          \
        RESC(alX); __syncthreads(); } while (0)
    for (int t = 1; t + 1 < NT; t += 2) {
        HALF_STEP(pB0, pB1, mnB, alB, pA0, pA1, alA, t, 1, 0, 0);
        HALF_STEP(pA0, pA1, mnA, alA, pB0, pB1, alB, t + 1, 0, 1, 1);
    }
    const bool even = (NT & 1) == 0;
    if (even) { SBAR(); qkt<1, SK>(pB0, pB1, K_lds, r32, hi, S.qr, ACT(NT - 1)); SBAR(); }
#define QROW(e) (nxt.Q + (size_t)(wid * QBLK + r32) * PITCH + ((e) >> 1) * 16 + hi * 8 + ((e) & 1) * 4)
    if constexpr (F32) { SLOAD_F((const float*)nxt.K, kbn); SBAR();
#pragma unroll
        for (int e = 0; e < 8; ++e) S.tq[e] = *(const f32x4*)QROW(e); }
    else { SLOAD_H(nxt.K, nxt.V, kbn); SBAR();
#pragma unroll
        for (int d0 = 0; d0 < 8; ++d0) S.qr[d0] = load8<TIn>(nxt.Q + (size_t)(wid * QBLK + r32) * PITCH + d0 * 16 + hi * 8); }
    SBAR();
    finishSM(pA0, pA1, alA, l_reg, pa0, pa1, pa2, pa3); SBAR();
    if constexpr (F32) {
#pragma unroll
        for (int e = 8; e < 16; ++e) S.tq[e] = *(const f32x4*)QROW(e); SBAR(); }
#undef QROW
    pv_tile<0, SK>(o, vb0, pa0, pa1, pa2, pa3, ACT(even ? NT - 2 : NT - 1));
    if (even) { MASKT(pB0, pB1, NT - 1); partialSM(pB0, pB1, m_reg, mnB, alB, cbh + KBASE(NT - 1)); __syncthreads(); RESC(alB);
        finishSM(pB0, pB1, alB, l_reg, pa0, pa1, pa2, pa3); SBAR(); pv_tile<1, SK>(o, vb0, pa0, pa1, pa2, pa3, ACT(NT - 1)); }
    SBAR(); SEAM_K0();
    if (hi == 0) li_l[r32] = l_reg; asm volatile("s_waitcnt lgkmcnt(0)" ::: "memory");
    float rli[16];
#pragma unroll
    for (int r = 0; r < 16; ++r) rli[r] = __builtin_amdgcn_rcpf(li_l[crow(r, hi)]);
    TOut* Ow = cur.O + (size_t)(wid * QBLK) * OPITCH;
#pragma unroll
    for (int r = 0; r < 16; ++r) { const int orow = crow(r, hi);
#pragma unroll
        for (int d0 = 0; d0 < 4; ++d0) { const float v = o[d0][r] * rli[r];
            if constexpr (same_t<TOut, float>::v) { Ow[(size_t)orow * OPITCH + d0 * 32 + r32] = v; }
            else { const float vn = __shfl_xor(v, 1);
                   if ((r32 & 1) == 0) *(unsigned*)(Ow + (size_t)orow * OPITCH + d0 * 32 + r32) = cvtpk(v, vn); } } }
    if constexpr (F32) {
#pragma unroll
        for (int d0 = 0; d0 < 8; ++d0) S.qr[d0] = pack8(S.tq[2 * d0], S.tq[2 * d0 + 1]); }
    __syncthreads();
#undef RESC
#undef KBASE
#undef ACT
#undef MASKT
#undef SEAM_K0
#undef HALF_STEP
}
#undef ROW
#undef VMW
#undef VMWN
#undef SLOAD_H
#undef SWRITE_HK
#undef SWRITE_HV
#undef SWRITE_H
#undef SLOAD_F
#undef SWRITE_KF
#undef SWRITE_VF

constexpr int FOX_LDS_BYTES = LDS_BYTES + 8192 * 4;
struct AttnT { const bf16* BQ; const bf16* BK; const bf16* BV; bf16* OB; const float* CUM; const unsigned* KMAX; };
__device__ __forceinline__ BlockRef<bf16, bf16> fox_ref(const AttnT& T, int L_, int pass, int jlo) {
    constexpr int NQB = 8192 / QB;
    const int h = L_ % 8, qb = NQB - 1 - L_ / 8; BlockRef<bf16, bf16> r; (void)pass;
    r.Q = T.BQ + (size_t)qb * QB * PITCH + h * D; r.O = T.OB + (size_t)qb * QB * OPITCH + h * D; r.K = T.BK + h * D; r.V = T.BV + h * D; r.C = T.CUM + (size_t)h * 8192; r.P0 = qb * QB; r.JLO = jlo; return r;
}
constexpr float PRUNE_T2 = 40.f;
__device__ __forceinline__ int fox_jlo(const AttnT& T, int L_, int pass, char* lds) {
    constexpr int NQB = 8192 / QB;
    int tid = threadIdx.x; asm volatile("" : "+v"(tid));
    const int lane = tid & 63, wid = tid >> 6; (void)pass;
    const int h = L_ % 8, qb = NQB - 1 - L_ / 8, P0 = qb * QB;
    float* red = (float*)(lds + LDS_BYTES + 8192 * 4);
    { const bf16* qp = T.BQ + (size_t)(P0 + (tid >> 1)) * PITCH + h * D + (tid & 1) * 64; float s = 0.f;
#pragma unroll
      for (int i = 0; i < 8; ++i) { const u32x4 v = *(const u32x4*)(qp + 8 * i);
#pragma unroll
          for (int j = 0; j < 4; ++j) s += fabsf(__uint_as_float(v[j] << 16)) + fabsf(__uint_as_float(v[j] & 0xffff0000u)); }
      s += __shfl_xor(s, 1);
#pragma unroll
      for (int o = 2; o < 64; o <<= 1) s = fmaxf(s, __shfl_xor(s, o));
      if (lane == 0) red[wid] = s; }
    __syncthreads();
    float q1 = red[0];
#pragma unroll
    for (int i = 1; i < 8; ++i) q1 = fmaxf(q1, red[i]);
    const float B2 = q1 * __uint_as_float(T.KMAX[h]) * 1.01f;
    const float* C = T.CUM + (size_t)h * 8192; const float cref = C[P0];
    const int ntb = P0 / KVBLK;
    bool skip = false;
    if (tid < ntb) skip = (cref - C[tid * KVBLK + KVBLK - 1]) * LOG2E_ + 2.f * B2 < -PRUNE_T2;
    const int cnt = __popcll(__ballot(skip));
    __syncthreads();
    if (lane == 0) red[wid] = (float)cnt;
    __syncthreads();
    int jlo = 0;
#pragma unroll
    for (int i = 0; i < 8; ++i) jlo += (int)red[i];
    __syncthreads();
    return __builtin_amdgcn_readfirstlane(jlo);
}
__device__ __forceinline__ void attn_phase(char* lds, const AttnT T, int first, int stride) {
    constexpr int NQB = 8192 / QB, TOTAL = NQB * 8;
    int SKV_ = 8192, W = 8192; asm volatile("" : "+s"(SKV_), "+s"(W));
    int L = first; if (L >= TOTAL) return;
    int pass = 0;
    BlockRef<bf16, bf16> cur = fox_ref(T, L, 0, fox_jlo(T, L, 0, lds));
    Seam<bf16> Sm;
    causal_swa_prime<bf16, bf16>(cur, W, lds, Sm);
    for (;;) {
        const bool more_pass = false, more_item = L + stride < TOTAL, last = !more_pass && !more_item;
        int passn = pass + 1, Ln = L;
        if (!more_pass) { passn = 0; Ln = more_item ? L + stride : L; }
        BlockRef<bf16, bf16> nxt = cur;
        if (!last) { const int jn = fox_jlo(T, Ln, passn, lds); nxt = fox_ref(T, Ln, passn, jn); }
        causal_swa_block<bf16, bf16>(cur, nxt, SKV_, W, lds, Sm);
        if (last) break;
        cur = nxt; pass = passn; L = Ln;
    }
}
#undef KSWZ
#undef SBAR
}

namespace hg {
typedef short bf16x8 __attribute__((ext_vector_type(8)));
typedef float f32x4 __attribute__((ext_vector_type(4)));
typedef unsigned u32x4 __attribute__((ext_vector_type(4)));
typedef unsigned short bf16;
#define HLAS __attribute__((address_space(3)))
#define HBAR() asm volatile("s_waitcnt lgkmcnt(0)\n\ts_barrier" ::: "memory")
constexpr int PQ = 136, PS = 72;
constexpr int L_B = 0;
constexpr int L_QT = 34816;
constexpr int L_Q0 = L_QT + 17408;
constexpr int L_KT = L_Q0 + 17408;
constexpr int L_VT = L_KT + 43520;
constexpr int L_P = L_VT + 18432;
constexpr int L_RED = L_P + 9216;
constexpr int L_END = L_RED + 512 + 2048;
static_assert(L_END <= 147328, "hgrn LDS map");
__device__ __forceinline__ float bfl(unsigned w) { return __uint_as_float(w << 16); }
__device__ __forceinline__ float bfh(unsigned w) { return __uint_as_float(w & 0xffff0000u); }
__device__ __forceinline__ unsigned pkbf(float lo, float hi) { return pg8::cvt_pk_bf16(lo, hi); }
struct T { const bf16 *AQ, *AK, *AI, *AG; const float* ALF; bf16* LT; float* DV; bf16* OA; const float* nw; };

__device__ __forceinline__ void load_b_issue(const float* ALF, int t0, int hcol, int tid, float (&loc)[16]) {
    const int k = tid & 127, seg = tid >> 7;
    const float* p = ALF + (size_t)(t0 + 16 * seg) * 1024 + hcol + k;
#pragma unroll
    for (int i = 0; i < 16; ++i) loc[i] = p[(size_t)i * 1024];
}
__device__ __forceinline__ void load_b_finish(HLAS unsigned char* lds, int tid, float (&loc)[16]) {
    HLAS float* B = (HLAS float*)(lds + L_B); HLAS float* tot = (HLAS float*)(lds + L_RED + 512);
    const int k = tid & 127, seg = tid >> 7;
    float run = 0.f;
#pragma unroll
    for (int i = 0; i < 16; ++i) { run += loc[i]; loc[i] = run; }
    tot[seg * 128 + k] = run;
    HBAR();
    float pre = 0.f;
#pragma unroll
    for (int s2 = 0; s2 < 3; ++s2) { const float v = tot[s2 * 128 + k]; pre += (s2 < seg) ? v : 0.f; }
#pragma unroll
    for (int i = 0; i < 16; ++i) B[(16 * seg + i) * 128 + k] = pre + loc[i];
    HBAR();
}
__device__ __forceinline__ void store_vt(HLAS unsigned char* lds, int tid, const u32x4 (&vv)[2]) {
    HLAS bf16* VT = (HLAS bf16*)(lds + L_VT);
#pragma unroll
    for (int it = 0; it < 2; ++it) { const int item = tid + 512 * it, s = item >> 4, k8 = (item & 15) * 8;
        const int sx = s ^ (((k8 >> 3) & 7) << 3);
#pragma unroll
        for (int j = 0; j < 4; ++j) { VT[(k8 + 2 * j) * PS + sx] = (bf16)(vv[it][j] & 0xffffu); VT[(k8 + 2 * j + 1) * PS + sx] = (bf16)(vv[it][j] >> 16); } }
}
struct PreA { float loc[16]; u32x4 kkv[2], vv[2]; };
__device__ __forceinline__ void passA_issue(const T& P, int u, PreA& R) {
    const int tid = threadIdx.x, t0 = (u >> 3) * 64, hcol = (u & 7) * 128;
    load_b_issue(P.ALF, t0, hcol, tid, R.loc);
#pragma unroll
    for (int it = 0; it < 2; ++it) { const int item = tid + 512 * it, s = item >> 4, k8 = (item & 15) * 8;
        R.kkv[it] = *(const u32x4*)(P.AK + (size_t)(t0 + s) * 1024 + hcol + k8); R.vv[it] = *(const u32x4*)(P.AI + (size_t)(t0 + s) * 1024 + hcol + k8); }
}
__device__ __forceinline__ void passA_unit(HLAS unsigned char* lds, const T& P, int c, int h, PreA& R, int unext) {
    const int tid = threadIdx.x, lane = tid & 63, w = __builtin_amdgcn_readfirstlane(tid >> 6);
    float (&loc)[16] = R.loc; u32x4 (&kkv)[2] = R.kkv;
    u32x4 vv[2] = {R.vv[0], R.vv[1]};
    load_b_finish(lds, tid, loc);
    HLAS float* B = (HLAS float*)(lds + L_B); HLAS bf16* KdT = (HLAS bf16*)(lds + L_KT); HLAS bf16* VT = (HLAS bf16*)(lds + L_VT);
#pragma unroll
    for (int it = 0; it < 2; ++it) { const int item = tid + 512 * it, s = item >> 4, k8 = (item & 15) * 8;
        const u32x4 kk = kkv[it];
        const f32x4 l0 = *(const HLAS f32x4*)(B + 63 * 128 + k8), l1 = *(const HLAS f32x4*)(B + 63 * 128 + k8 + 4);
        const f32x4 s0 = *(const HLAS f32x4*)(B + s * 128 + k8), s1 = *(const HLAS f32x4*)(B + s * 128 + k8 + 4);
        float kd[8];
        kd[0] = bfl(kk[0]) * __expf(l0[0] - s0[0]); kd[1] = bfh(kk[0]) * __expf(l0[1] - s0[1]); kd[2] = bfl(kk[1]) * __expf(l0[2] - s0[2]); kd[3] = bfh(kk[1]) * __expf(l0[3] - s0[3]);
        kd[4] = bfl(kk[2]) * __expf(l1[0] - s1[0]); kd[5] = bfh(kk[2]) * __expf(l1[1] - s1[1]); kd[6] = bfl(kk[3]) * __expf(l1[2] - s1[2]); kd[7] = bfh(kk[3]) * __expf(l1[3] - s1[3]);
        const int sx = s ^ (((k8 >> 3) & 7) << 3);
#pragma unroll
        for (int j = 0; j < 4; ++j) { const unsigned pw = pkbf(kd[2 * j], kd[2 * j + 1]); KdT[(k8 + 2 * j) * PS + sx] = (bf16)(pw & 0xffffu); KdT[(k8 + 2 * j + 1) * PS + sx] = (bf16)(pw >> 16); } }
    store_vt(lds, tid, vv);
    if (unext >= 0) passA_issue(P, unext, R);
    if (tid < 128) P.DV[(size_t)(c * 8 + h) * 128 + tid] = __expf(B[63 * 128 + tid]);
    HBAR();
    const int fr = lane & 15, fq = lane >> 4;
    bf16x8 a[2];
#pragma unroll
    for (int ks = 0; ks < 2; ++ks) a[ks] = *(const HLAS bf16x8*)(VT + (16 * w + fr) * PS + ((32 * ks + 8 * fq) ^ (((2 * w + (fr >> 3)) & 7) << 3)));
    bf16* out = P.LT + ((size_t)(c * 8 + h) * 128 + 16 * w + 4 * fq) * 128 + fr;
#pragma unroll
    for (int kt = 0; kt < 8; ++kt) { f32x4 acc = {0.f, 0.f, 0.f, 0.f};
#pragma unroll
        for (int ks = 0; ks < 2; ++ks) { const bf16x8 b = *(const HLAS bf16x8*)(KdT + (16 * kt + fr) * PS + ((32 * ks + 8 * fq) ^ (((2 * kt + (fr >> 3)) & 7) << 3))); acc = __builtin_amdgcn_mfma_f32_16x16x32_bf16(a[ks], b, acc, 0, 0, 0); }
#pragma unroll
        for (int r = 0; r < 4; ++r) out[(size_t)r * 128 + 16 * kt] = (bf16)(pkbf(acc[r], 0.f) & 0xffffu); }
    HBAR();
}
__device__ __forceinline__ void scan_all(const T& P, int gtid, int gthreads) {
    for (int e = gtid; e < 8 * 128 * 128; e += gthreads) {
        const int h = e >> 14, k = e & 127; bf16* p = P.LT + e; const float* d = P.DV + h * 128 + k;
        float s = 0.f;
        for (int c0 = 0; c0 < 128; c0 += 32) { float L[32], dd[32];
#pragma unroll
            for (int i = 0; i < 32; ++i) { L[i] = __uint_as_float((unsigned)p[(size_t)(c0 + i) * 131072] << 16); dd[i] = d[(size_t)(c0 + i) * 1024]; }
#pragma unroll
            for (int i = 0; i < 32; ++i) { p[(size_t)(c0 + i) * 131072] = (bf16)(pkbf(s, 0.f) & 0xffffu); s = dd[i] * s + L[i]; } }
    }
}
struct PreC { float loc[16]; u32x4 qqv[2], kkv[2], vv[2]; };
__device__ __forceinline__ void passC_issue(const T& P, int u, PreC& R) {
    const int tid = threadIdx.x, t0 = (u >> 3) * 64, hcol = (u & 7) * 128;
    load_b_issue(P.ALF, t0, hcol, tid, R.loc);
#pragma unroll
    for (int it = 0; it < 2; ++it) { const int item = tid + 512 * it, t = item >> 4, k8 = (item & 15) * 8; const size_t o_ = (size_t)(t0 + t) * 1024 + hcol + k8;
        R.qqv[it] = *(const u32x4*)(P.AQ + o_); R.kkv[it] = *(const u32x4*)(P.AK + o_); R.vv[it] = *(const u32x4*)(P.AI + o_); }
}
__device__ __forceinline__ void passC_unit(HLAS unsigned char* lds, const T& P, int c, int h, PreC& R, int unext) {
    const int tid = threadIdx.x, lane = tid & 63, w = __builtin_amdgcn_readfirstlane(tid >> 6), t0 = c * 64, hcol = h * 128;
    const int fr = lane & 15, fq = lane >> 4;
    float (&loc)[16] = R.loc; u32x4 (&qqv)[2] = R.qqv; u32x4 (&kkv)[2] = R.kkv;
    u32x4 stv[4]; bf16 gg[4][4];
    { const bf16* src = P.LT + (size_t)(c * 8 + h) * 16384;
#pragma unroll
      for (int it = 0; it < 4; ++it) { const int item = tid + 512 * it, v = item >> 4, k8 = (item & 15) * 8; stv[it] = *(const u32x4*)(src + v * 128 + k8); } }
#pragma unroll
    for (int i = 0; i < 4; ++i)
#pragma unroll
        for (int r = 0; r < 4; ++r) gg[i][r] = P.AG[(size_t)(t0 + 16 * (w >> 1) + 4 * fq + r) * 1024 + hcol + 16 * ((w & 1) * 4 + i) + fr];
    load_b_finish(lds, tid, loc);
    HLAS float* B = (HLAS float*)(lds + L_B); HLAS bf16* QT = (HLAS bf16*)(lds + L_QT); HLAS bf16* Q0 = (HLAS bf16*)(lds + L_Q0); HLAS bf16* KT = (HLAS bf16*)(lds + L_KT);
    HLAS bf16* VT = (HLAS bf16*)(lds + L_VT); HLAS bf16* PP = (HLAS bf16*)(lds + L_P); HLAS bf16* ST = (HLAS bf16*)(lds + L_B); HLAS float* red = (HLAS float*)(lds + L_RED);
#pragma unroll
    for (int it = 0; it < 2; ++it) { const int item = tid + 512 * it, t = item >> 4, k8 = (item & 15) * 8, J = t >> 4;
        const u32x4 qq = qqv[it], kk = kkv[it];
        float bt[8], q[8], kf[8];
        { const f32x4 x0 = *(const HLAS f32x4*)(B + t * 128 + k8), x1 = *(const HLAS f32x4*)(B + t * 128 + k8 + 4);
#pragma unroll
          for (int j = 0; j < 4; ++j) { bt[j] = x0[j]; bt[4 + j] = x1[j]; q[2 * j] = bfl(qq[j]); q[2 * j + 1] = bfh(qq[j]); kf[2 * j] = bfl(kk[j]); kf[2 * j + 1] = bfh(kk[j]); } }
        { float e0[8]; u32x4 o;
#pragma unroll
          for (int j = 0; j < 8; ++j) e0[j] = q[j] * __expf(bt[j]);
          o[0] = pkbf(e0[0], e0[1]); o[1] = pkbf(e0[2], e0[3]); o[2] = pkbf(e0[4], e0[5]); o[3] = pkbf(e0[6], e0[7]);
          *(HLAS u32x4*)(Q0 + t * PQ + k8) = o; }
        for (int I = J; I < 4; ++I) {
            const f32x4 r0 = *(const HLAS f32x4*)(B + (16 * I) * 128 + k8), r1 = *(const HLAS f32x4*)(B + (16 * I) * 128 + k8 + 4);
            float br[8];
#pragma unroll
            for (int j = 0; j < 4; ++j) { br[j] = r0[j]; br[4 + j] = r1[j]; }
            float e1[8]; u32x4 o;
#pragma unroll
            for (int j = 0; j < 8; ++j) e1[j] = kf[j] * __expf(br[j] - bt[j]);
            o[0] = pkbf(e1[0], e1[1]); o[1] = pkbf(e1[2], e1[3]); o[2] = pkbf(e1[4], e1[5]); o[3] = pkbf(e1[6], e1[7]);
            const int off = (I == 0) ? 0 : (I == 1) ? 16 : (I == 2) ? 48 : 96;
            *(HLAS u32x4*)(KT + (off + t) * PQ + k8) = o;
            if (I == J) {
#pragma unroll
                for (int j = 0; j < 8; ++j) e1[j] = q[j] * __expf(bt[j] - br[j]);
                o[0] = pkbf(e1[0], e1[1]); o[1] = pkbf(e1[2], e1[3]); o[2] = pkbf(e1[4], e1[5]); o[3] = pkbf(e1[6], e1[7]);
                *(HLAS u32x4*)(QT + t * PQ + k8) = o; }
        } }
    { const u32x4 vv[2] = {R.vv[0], R.vv[1]}; store_vt(lds, tid, vv); }
    if (unext >= 0) passC_issue(P, unext, R);
    HBAR();
#pragma unroll
    for (int it = 0; it < 4; ++it) { const int item = tid + 512 * it, v = item >> 4, k8 = (item & 15) * 8; *(HLAS u32x4*)(ST + v * PQ + k8) = stv[it]; }
    for (int idx = w; idx < 10; idx += 8) {
        const int I = (idx >= 6) ? 3 : (idx >= 3) ? 2 : (idx >= 1) ? 1 : 0, J = idx - ((I * (I + 1)) >> 1), off = (I == 0) ? 0 : (I == 1) ? 16 : (I == 2) ? 48 : 96;
        f32x4 acc = {0.f, 0.f, 0.f, 0.f};
#pragma unroll
        for (int ks = 0; ks < 4; ++ks) { const bf16x8 a = *(const HLAS bf16x8*)(QT + (16 * I + fr) * PQ + 32 * ks + 8 * fq), b = *(const HLAS bf16x8*)(KT + (off + 16 * J + fr) * PQ + 32 * ks + 8 * fq);
            acc = __builtin_amdgcn_mfma_f32_16x16x32_bf16(a, b, acc, 0, 0, 0); }
#pragma unroll
        for (int r = 0; r < 4; ++r) { const float v = (I == J && fr > 4 * fq + r) ? 0.f : acc[r]; PP[(16 * I + 4 * fq + r) * PS + 16 * J + fr] = (bf16)(pkbf(v, 0.f) & 0xffffu); } }
    if (w >= 2) { const int z = w - 2, I = (z < 3) ? 0 : (z < 5) ? 1 : 2, J = (z < 3) ? z + 1 : (z < 5) ? z - 1 : 3;
#pragma unroll
        for (int r = 0; r < 4; ++r) PP[(16 * I + 4 * fq + r) * PS + 16 * J + fr] = (bf16)0; }
    HBAR();
    { const int I = w >> 1, vh = w & 1;
      f32x4 acc[4];
#pragma unroll
      for (int i = 0; i < 4; ++i) { const int vt = vh * 4 + i; f32x4 a4 = {0.f, 0.f, 0.f, 0.f};
#pragma unroll
          for (int ks = 0; ks < 2; ++ks) { const bf16x8 a = *(const HLAS bf16x8*)(PP + (16 * I + fr) * PS + 32 * ks + 8 * fq), b = *(const HLAS bf16x8*)(VT + (16 * vt + fr) * PS + ((32 * ks + 8 * fq) ^ (((2 * vt + (fr >> 3)) & 7) << 3)));
              a4 = __builtin_amdgcn_mfma_f32_16x16x32_bf16(a, b, a4, 0, 0, 0); }
#pragma unroll
          for (int ks = 0; ks < 4; ++ks) { const bf16x8 a = *(const HLAS bf16x8*)(Q0 + (16 * I + fr) * PQ + 32 * ks + 8 * fq), b = *(const HLAS bf16x8*)(ST + (16 * vt + fr) * PQ + 32 * ks + 8 * fq);
              a4 = __builtin_amdgcn_mfma_f32_16x16x32_bf16(a, b, a4, 0, 0, 0); }
          acc[i] = a4; }
      float ss[4];
#pragma unroll
      for (int r = 0; r < 4; ++r) { float s = 0.f;
#pragma unroll
          for (int i = 0; i < 4; ++i) s += acc[i][r] * acc[i][r];
          s += __shfl_xor(s, 1); s += __shfl_xor(s, 2); s += __shfl_xor(s, 4); s += __shfl_xor(s, 8); ss[r] = s; }
      if (fr == 0) {
#pragma unroll
          for (int r = 0; r < 4; ++r) red[(I * 2 + vh) * 16 + 4 * fq + r] = ss[r]; }
      HBAR();
#pragma unroll
      for (int r = 0; r < 4; ++r) { const float tot = red[(I * 2) * 16 + 4 * fq + r] + red[(I * 2 + 1) * 16 + 4 * fq + r]; ss[r] = rsqrtf(tot * (1.f / 128.f) + 1e-6f); }
#pragma unroll
      for (int i = 0; i < 4; ++i) { const int v = 16 * (vh * 4 + i) + fr; const float nwv = P.nw[v];
#pragma unroll
          for (int r = 0; r < 4; ++r) { const size_t o_ = (size_t)(t0 + 16 * I + 4 * fq + r) * 1024 + hcol + v;
              const float g = __uint_as_float((unsigned)gg[i][r] << 16);
              P.OA[(size_t)(t0 + 16 * I + 4 * fq + r) * 2048 + hcol + v] = (bf16)(pkbf(acc[i][r] * ss[r] * nwv * (g / (1.f + __expf(-g))), 0.f) & 0xffffu); } }
    }
    HBAR();
}
#undef HLAS
}


#define GAS __attribute__((address_space(1)))
#define LAS __attribute__((address_space(3)))
typedef unsigned short bf16;
typedef unsigned v4u __attribute__((ext_vector_type(4)));
typedef float f32x4 __attribute__((ext_vector_type(4)));
constexpr int NWAVES = 8;
constexpr size_t MiB = 1u << 20;
constexpr size_t WS_BAR = 65536, BAR_BYTES = 16384;
constexpr size_t WS_LB = 0;
constexpr size_t WS_WUA = 1 * MiB, WS_WUB = 5 * MiB, WS_WO = 9 * MiB, WS_WFI = 17 * MiB, WS_WFD = 61 * MiB;
constexpr size_t WS_WIN = 83 * MiB;
constexpr size_t WS_OA = 83 * MiB, WS_OB = 99 * MiB, WS_DV = 115 * MiB;
constexpr size_t WS_H1 = 127 * MiB;
constexpr size_t WS_PROJ = 159 * MiB;
constexpr size_t WS_ALF = 271 * MiB;
constexpr size_t WS_T = 159 * MiB;
constexpr size_t WS_HID = 223 * MiB;
constexpr size_t WS_END = 311 * MiB;
static_assert(WS_ALF + 32 * MiB <= WS_END && WS_HID + 88 * MiB <= WS_END, "ws map");
constexpr size_t WS_LS2 = 304 * MiB, WS_CUM2 = 305 * MiB;

__device__ __forceinline__ unsigned f2bf(float f) { unsigned u = __builtin_bit_cast(unsigned, f); return (u + 0x7fffu + ((u >> 16) & 1u)) >> 16; }
__device__ __forceinline__ unsigned pk2(float lo, float hi) { return f2bf(lo) | (f2bf(hi) << 16); }
__device__ __forceinline__ float bf2f(bf16 u) { return __uint_as_float((unsigned)u << 16); }
__device__ __forceinline__ float wave_sum(float v) {
#pragma unroll
    for (int o = 1; o < 64; o <<= 1) v += __shfl_xor(v, o);
    return v;
}
#define LDS_WAIT() asm volatile("s_waitcnt lgkmcnt(0)" ::: "memory")

typedef GAS unsigned gu32;
#define RLX_AGENT __ATOMIC_RELAXED, __HIP_MEMORY_SCOPE_AGENT
struct Args { const float* in[14]; float* out; unsigned char* ws; int ph_lo, ph_hi; };

struct TrItem { const float* src; bf16* dst; };
__device__ __forceinline__ void tr_load(const TrItem& t, int ldw, int lane, f32x4 (&a)[8], f32x4 (&b)[8]) {
    const int r = lane >> 4, c = lane & 15;
#pragma unroll
    for (int i = 0; i < 8; ++i) { const float* p = t.src + (size_t)(8 * i + 2 * r) * ldw + 4 * c; a[i] = __builtin_nontemporal_load((const f32x4*)p); b[i] = __builtin_nontemporal_load((const f32x4*)(p + ldw)); }
}
__device__ __forceinline__ void tr_store(const TrItem& t, int DP, int lane, LAS unsigned* scr, const f32x4 (&a)[8], const f32x4 (&b)[8]) {
    const int r = lane >> 4, c = lane & 15;
#pragma unroll
    for (int i = 0; i < 8; ++i) { const int kp = (4 * i + r) ^ (4 * (c & 7));
#pragma unroll
        for (int j = 0; j < 4; ++j) scr[(4 * c + j) * 32 + kp] = pg8::cvt_pk_bf16(a[i][j], b[i][j]); }
    LDS_WAIT(); asm volatile("" ::: "memory");
#pragma unroll
    for (int it = 0; it < 8; ++it) { const int n = 8 * it + (lane >> 3), g = lane & 7;
        const v4u o = *(const LAS v4u*)(scr + n * 32 + ((4 * g) ^ (4 * ((n >> 2) & 7))));
        *(v4u*)(t.dst + (size_t)n * DP + 8 * g) = o; }
    LDS_WAIT(); asm volatile("" ::: "memory");
}
__device__ __forceinline__ TrItem tr_item(const float* W, int ldw, int DP, int ncols, bf16* WT, int row_off, int mode, int it) {
    const int nblk = ncols / 64, kb = it / nblk, nb = it % nblk, n0 = 64 * nb;
    const int drow0 = mode ? ((n0 >> 7) * 256 + (n0 & 127) + row_off) : (row_off + n0);
    TrItem t; t.src = W + (size_t)(64 * kb) * ldw + n0; t.dst = WT + (size_t)drow0 * DP + 64 * kb; return t;
}
__device__ __forceinline__ void p0_matrix(const float* W, int ldw, int K, int ncols, bf16* WT, int row_off, int mode, LAS unsigned* scr, int lane, int gw, int NGW, int DP = 0) {
    if (DP == 0) DP = K;
    const int nitems = (K / 64) * (ncols / 64);
    int it = gw; if (it >= nitems) return;
    f32x4 a0[8], b0[8], a1[8], b1[8];
    TrItem t0 = tr_item(W, ldw, DP, ncols, WT, row_off, mode, it), t1 = t0;
    tr_load(t0, ldw, lane, a0, b0);
    for (;;) {
        const int it1 = it + NGW, it2 = it1 + NGW;
        if (it1 < nitems) { t1 = tr_item(W, ldw, DP, ncols, WT, row_off, mode, it1); tr_load(t1, ldw, lane, a1, b1); }
        tr_store(t0, DP, lane, scr, a0, b0);
        if (it1 >= nitems) break;
        if (it2 < nitems) { t0 = tr_item(W, ldw, DP, ncols, WT, row_off, mode, it2); tr_load(t0, ldw, lane, a0, b0); }
        tr_store(t1, DP, lane, scr, a1, b1);
        if (it2 >= nitems) break;
        it = it2;
    }
}

struct Frame {
    LAS unsigned char* lds; int tid, lane, wave, G;
    const float *x, *w_in, *b_fox, *lbl, *hnw, *w_up_a, *w_up_b, *w_o, *n_mix_pre, *n_mix_post, *n_ffn_pre, *n_ffn_post, *w_ffn_in, *w_ffn_down;
    float* out; unsigned char* ws;
};

__device__ __forceinline__ void p0_prologue(Frame& F) {
    LAS unsigned* scr = (LAS unsigned*)(F.lds + F.wave * 16384);
    const int gw = blockIdx.x * NWAVES + F.wave, NGW = F.G * NWAVES;
    if (blockIdx.x == 0) { float* LB = (float*)(F.ws + WS_LB); for (int c = F.tid; c < AW; c += 512) LB[c] = 1.f / (1.f + expf(F.lbl[AW + c] - F.lbl[c])); }
    LAS float* wfT = (LAS float*)F.lds;
    for (int k = F.tid; k < DM; k += 512) { const f32x4 a4 = *(const f32x4*)(F.w_in + (size_t)k * NIN + 7168), b4 = *(const f32x4*)(F.w_in + (size_t)k * NIN + 7172);
        wfT[0 * DM + k] = a4.x; wfT[1 * DM + k] = a4.y; wfT[2 * DM + k] = a4.z; wfT[3 * DM + k] = a4.w; wfT[4 * DM + k] = b4.x; wfT[5 * DM + k] = b4.y; wfT[6 * DM + k] = b4.z; wfT[7 * DM + k] = b4.w; }
    __syncthreads();
    {
        bf16* H1 = (bf16*)(F.ws + WS_H1); float* LS = (float*)(F.ws + WS_LS2);
        f32x4 wn[8], va[8], vb[8];
#pragma unroll
        for (int j = 0; j < 8; ++j) wn[j] = ((const f32x4*)F.n_mix_pre + F.lane)[64 * j];
#define P0_LOAD(m_, v_) do { const f32x4* xr_ = (const f32x4*)(F.x + (size_t)(m_) * DM) + F.lane; _Pragma("unroll") for (int j = 0; j < 8; ++j) v_[j] = __builtin_nontemporal_load(xr_ + 64 * j); } while (0)
#define P0_ROW(m_, v) do { \
            asm volatile("" ::: "memory");                                      \
            float s = 0.f; \
            _Pragma("unroll") for (int j = 0; j < 8; ++j) s += (v[j].x * v[j].x + v[j].y * v[j].y) + (v[j].z * v[j].z + v[j].w * v[j].w); \
            const float rstd = rsqrtf(wave_sum(s) * (1.f / DM) + EPS); \
            float fd[8] = {0.f, 0.f, 0.f, 0.f, 0.f, 0.f, 0.f, 0.f}; \
            unsigned long long* o8 = (unsigned long long*)(H1 + (size_t)(m_) * DM) + F.lane; \
            _Pragma("unroll") for (int j = 0; j < 8; ++j) { v[j] = v[j] * rstd * wn[j]; \
                o8[64 * j] = (unsigned long long)pk2(v[j].x, v[j].y) | ((unsigned long long)pk2(v[j].z, v[j].w) << 32); \
                _Pragma("unroll") for (int e = 0; e < 8; ++e) { const f32x4 wv = *(const LAS f32x4*)(wfT + e * DM + 256 * j + 4 * F.lane); fd[e] += (v[j].x * wv.x + v[j].y * wv.y) + (v[j].z * wv.z + v[j].w * wv.w); } } \
            _Pragma("unroll") for (int e = 0; e < 8; ++e) fd[e] = wave_sum(fd[e]); \
            if (F.lane < 8) { float z = fd[0]; \
                _Pragma("unroll") for (int e = 1; e < 8; ++e) z = (F.lane == e) ? fd[e] : z; \
                z += F.b_fox[F.lane]; \
                LS[(size_t)(m_) * 8 + F.lane] = fminf(z, 0.f) - log1pf(expf(-fabsf(z))); } } while (0)
        int m = gw;
        if (m < S) { P0_LOAD(m, va);
            for (;;) { const int m1 = m + NGW, m2 = m1 + NGW;
                if (m1 < S) P0_LOAD(m1, vb);
                P0_ROW(m, va);
                if (m1 >= S) break;
                if (m2 < S) P0_LOAD(m2, va);
                P0_ROW(m1, vb);
                if (m2 >= S) break;
                m = m2; } }
#undef P0_LOAD
#undef P0_ROW
    }
    __syncthreads();
    p0_matrix(F.w_in, NIN, DM, 7168, (bf16*)(F.ws + WS_WIN), 0, 0, scr, F.lane, gw, NGW);
    p0_matrix(F.w_in + 7176, NIN, DM, 2048, (bf16*)(F.ws + WS_WIN), 7168, 1, scr, F.lane, gw, NGW);
    p0_matrix(F.w_in + 7176 + DM, NIN, DM, 2048, (bf16*)(F.ws + WS_WIN), 7168 + 128, 1, scr, F.lane, gw, NGW);
}
__device__ __forceinline__ void late_weights(Frame& F, int my, int nidle) {
    LAS unsigned* scr = (LAS unsigned*)(F.lds + F.wave * 16384);
    const int gw = my * NWAVES + F.wave, NGW = nidle * NWAVES;
    p0_matrix(F.w_up_a, DM, AW, DM, (bf16*)(F.ws + WS_WUA), 0, 0, scr, F.lane, gw, NGW, 2 * AW);
    p0_matrix(F.w_up_b, DM, AW, DM, (bf16*)(F.ws + WS_WUA) + AW, 0, 0, scr, F.lane, gw, NGW, 2 * AW);
    p0_matrix(F.w_o, DM, DM, DM, (bf16*)(F.ws + WS_WO), 0, 0, scr, F.lane, gw, NGW);
    p0_matrix(F.w_ffn_in, 2 * DFF, DM, DFF, (bf16*)(F.ws + WS_WFI), 0, 1, scr, F.lane, gw, NGW);
    p0_matrix(F.w_ffn_in + DFF, 2 * DFF, DM, DFF, (bf16*)(F.ws + WS_WFI), 128, 1, scr, F.lane, gw, NGW);
}
__device__ __forceinline__ void cum_scan(Frame& F) {
    const float* LS = (const float*)(F.ws + WS_LS2); float* CUM = (float*)(F.ws + WS_CUM2);
    const int h = F.wave, lane = F.lane;
    double carry = 0.0;
    for (int c0 = 0; c0 < S / 64; c0 += 8) {
        float v[8];
#pragma unroll
        for (int i = 0; i < 8; ++i) v[i] = LS[(size_t)((c0 + i) * 64 + lane) * 8 + h];
#pragma unroll
        for (int i = 0; i < 8; ++i) {
            double x = (double)v[i];
#pragma unroll
            for (int o = 1; o < 64; o <<= 1) { const double y = __shfl_up(x, o); x += (lane >= o) ? y : 0.0; }
            CUM[(size_t)h * S + (c0 + i) * 64 + lane] = (float)(carry + x);
            carry += __shfl(x, 63);
        }
    }
}
#define BF4(tw) ((f32x4){__uint_as_float((unsigned)(tw) << 16), __uint_as_float((unsigned)(tw) & 0xffff0000u), __uint_as_float((unsigned)((tw) >> 32) << 16), __uint_as_float((unsigned)((tw) >> 32) & 0xffff0000u)})
__device__ __forceinline__ void r1_load(Frame& F, int m, f32x4 (&v)[8], f32x4 (&xv)[8]) {
    const unsigned long long* tr = (const unsigned long long*)((const bf16*)(F.ws + WS_T) + (size_t)m * DM) + F.lane; const f32x4* xr = (const f32x4*)(F.x + (size_t)m * DM) + F.lane;
#pragma unroll
    for (int j = 0; j < 8; ++j) { const unsigned long long tw = tr[64 * j]; v[j] = BF4(tw); xv[j] = __builtin_nontemporal_load(xr + 64 * j); }
}
__device__ __forceinline__ void r1_finish(Frame& F, int m, f32x4 (&v)[8], const f32x4 (&xv)[8], const f32x4 (&wa)[8], const f32x4 (&wb)[8]) {
    float s = 0.f;
#pragma unroll
    for (int j = 0; j < 8; ++j) s += (v[j].x * v[j].x + v[j].y * v[j].y) + (v[j].z * v[j].z + v[j].w * v[j].w);
    const float rstd = rsqrtf(wave_sum(s) * (1.f / DM) + EPS); float s2 = 0.f;
#pragma unroll
    for (int j = 0; j < 8; ++j) { v[j] = xv[j] + v[j] * rstd * wa[j]; s2 += (v[j].x * v[j].x + v[j].y * v[j].y) + (v[j].z * v[j].z + v[j].w * v[j].w); }
    f32x4* orow = (f32x4*)(F.out + (size_t)m * DM) + F.lane;
#pragma unroll
    for (int j = 0; j < 8; ++j) orow[64 * j] = v[j];
    const float rstd2 = rsqrtf(wave_sum(s2) * (1.f / DM) + EPS);
    unsigned long long* o8 = (unsigned long long*)((bf16*)(F.ws + WS_H1) + (size_t)m * DM) + F.lane;
#pragma unroll
    for (int j = 0; j < 8; ++j) { const f32x4 h = v[j] * rstd2 * wb[j]; o8[64 * j] = (unsigned long long)pk2(h.x, h.y) | ((unsigned long long)pk2(h.z, h.w) << 32); }
}
__device__ __forceinline__ void rowpass1(Frame& F, int gw, int NGW, int mend) {
    int m = gw; if (m >= mend) return;
    f32x4 wa[8], wb[8], v0[8], x0[8], v1[8], x1[8];
#pragma unroll
    for (int j = 0; j < 8; ++j) { wa[j] = ((const f32x4*)F.n_mix_post + F.lane)[64 * j]; wb[j] = ((const f32x4*)F.n_ffn_pre + F.lane)[64 * j]; }
    r1_load(F, m, v0, x0);
    for (;;) {
        const int m1 = m + NGW, m2 = m1 + NGW;
        if (m1 < mend) r1_load(F, m1, v1, x1);
        r1_finish(F, m, v0, x0, wa, wb);
        if (m1 >= mend) break;
        if (m2 < mend) r1_load(F, m2, v0, x0);
        r1_finish(F, m1, v1, x1, wa, wb);
        if (m2 >= mend) break;
        m = m2;
    }
}
__device__ __forceinline__ void r2_load(Frame& F, int m, f32x4 (&v)[8], f32x4 (&xv)[8]) {
    const unsigned long long* tr = (const unsigned long long*)((const bf16*)(F.ws + WS_T) + (size_t)m * DM) + F.lane; const f32x4* orow = (const f32x4*)(F.out + (size_t)m * DM) + F.lane;
#pragma unroll
    for (int j = 0; j < 8; ++j) { const unsigned long long tw = tr[64 * j]; v[j] = BF4(tw); xv[j] = orow[64 * j]; }
}
__device__ __forceinline__ void r2_finish(Frame& F, int m, const f32x4 (&v)[8], const f32x4 (&xv)[8], const f32x4 (&wa)[8]) {
    float s = 0.f;
#pragma unroll
    for (int j = 0; j < 8; ++j) s += (v[j].x * v[j].x + v[j].y * v[j].y) + (v[j].z * v[j].z + v[j].w * v[j].w);
    const float rstd = rsqrtf(wave_sum(s) * (1.f / DM) + EPS);
    f32x4* orow = (f32x4*)(F.out + (size_t)m * DM) + F.lane;
#pragma unroll
    for (int j = 0; j < 8; ++j) orow[64 * j] = xv[j] + v[j] * rstd * wa[j];
}
__device__ __forceinline__ void rowpass2(Frame& F, int gw, int NGW, int mend) {
    int m = gw; if (m >= mend) return;
    f32x4 wa[8], v0[8], x0[8], v1[8], x1[8];
#pragma unroll
    for (int j = 0; j < 8; ++j) wa[j] = ((const f32x4*)F.n_ffn_post + F.lane)[64 * j];
    r2_load(F, m, v0, x0);
    for (;;) {
        const int m1 = m + NGW, m2 = m1 + NGW;
        if (m1 < mend) r2_load(F, m1, v1, x1);
        r2_finish(F, m, v0, x0, wa);
        if (m1 >= mend) break;
        if (m2 < mend) r2_load(F, m2, v0, x0);
        r2_finish(F, m1, v1, x1, wa);
        if (m2 >= mend) break;
        m = m2;
    }
}
#undef BF4

#define XB_TMO      128
#define XB_XCNT(j)  (256  + 64 * (j))
#define XB_XSUB(j)  (1280 + 64 * (j))
#define XB_XGEN(j)  (2304 + 64 * (j))
#define XB_TOP      3328
#define XB_TOPGEN   3392
#define XCD_BAR_WORDS 3456
#define XB_SPIN_CAP (1u << 18)

__device__ __forceinline__ unsigned xb_ld(unsigned* p)              { return __hip_atomic_load(p, __ATOMIC_RELAXED, __HIP_MEMORY_SCOPE_AGENT); }
__device__ __forceinline__ unsigned xb_add(unsigned* p, unsigned v) { return __hip_atomic_fetch_add(p, v, __ATOMIC_RELAXED, __HIP_MEMORY_SCOPE_AGENT); }
__device__ __forceinline__ unsigned xb_xcc_id() { return (unsigned)__builtin_amdgcn_s_getreg((3 << 11) | 20) & 0xFu; }
#define XB_SPIN(cond, bar) do { unsigned _sp = 0; while (cond) { __builtin_amdgcn_s_sleep(1); \
    if ((++_sp & 255u) == 0u) { if (xb_ld(&(bar)[XB_TMO])) break; if (_sp > XB_SPIN_CAP) { atomicAdd(&(bar)[XB_TMO], 1u); break; } } } } while (0)

struct XcdBarrier {
    unsigned* bar; unsigned x;
    volatile LAS unsigned* st;
};

__device__ __forceinline__ XcdBarrier xcd_barrier_post(unsigned* bar, volatile LAS unsigned* st) {
    XcdBarrier b; b.bar = bar; b.x = xb_xcc_id(); b.st = st;
    if (threadIdx.x == 0) (void)xb_add(&bar[XB_XCNT(b.x)], 1u);
    return b;
}
__device__ __forceinline__ void xcd_barrier_complete(unsigned* bar, unsigned x, unsigned& nloc, unsigned& nx) {
    const unsigned G = gridDim.x * gridDim.y * gridDim.z;
    unsigned sum, cnt, mine, sp = 0u;
    for (;;) {
        sum = 0u; cnt = 0u; mine = 0u;
#pragma unroll
        for (unsigned j = 0; j < 16; ++j) { const unsigned c = xb_ld(&bar[XB_XCNT(j)]); sum += c; cnt += (c > 0u) ? 1u : 0u; mine = (j == x) ? c : mine; }
        if (sum == G) break;
        __builtin_amdgcn_s_sleep(1);
        if ((++sp & 255u) == 0u) { if (xb_ld(&bar[XB_TMO])) break; if (sp > XB_SPIN_CAP) { atomicAdd(&bar[XB_TMO], 1u); break; } }
    }
    nloc = mine > 0u ? mine : 1u; nx = cnt > 0u ? cnt : 1u;
}

__device__ __forceinline__ void xcd_barrier(const XcdBarrier& b) {
    asm volatile("s_waitcnt vmcnt(0)" ::: "memory");
    __syncthreads();
    if (threadIdx.x == 0) {
        unsigned* bar = b.bar;
        __builtin_amdgcn_s_waitcnt(0);
        unsigned nloc = b.st[0], nx = b.st[1];
        if (nloc == 0u) { xcd_barrier_complete(bar, b.x, nloc, nx); b.st[0] = nloc; b.st[1] = nx; }
        const unsigned old = xb_add(&bar[XB_XSUB(b.x)], 1u);
        const unsigned gen = old / nloc;
        if (old + 1u == (gen + 1u) * nloc) {
            __builtin_amdgcn_fence(__ATOMIC_RELEASE, "agent");
            asm volatile("s_waitcnt vmcnt(0)" ::: "memory");
            const unsigned og = xb_add(&bar[XB_TOP], 1u);
            const unsigned tg = og / nx;
            if (og + 1u == (tg + 1u) * nx) xb_add(&bar[XB_TOPGEN], 1u);
            else XB_SPIN(xb_ld(&bar[XB_TOPGEN]) == tg, bar);
            __builtin_amdgcn_fence(__ATOMIC_ACQUIRE, "agent");
            xb_add(&bar[XB_XGEN(b.x)], 1u);
            asm volatile("s_waitcnt vmcnt(0)" ::: "memory");
        } else {
            XB_SPIN(xb_ld(&bar[XB_XGEN(b.x)]) == gen, bar);
            __builtin_amdgcn_fence(__ATOMIC_ACQUIRE, "agent");
            asm volatile("s_waitcnt vmcnt(0)" ::: "memory");
        }
    }
    __syncthreads();
}

constexpr int LDS_BYTES = 147456;
enum { PH_PRO = 0, PH_GEMM1 = 1, PH_MIX = 2, PH_SCAN = 3, PH_HOUT = 4, PH_UPA = 5, PH_WO = 6, PH_ROW1 = 7, PH_FFI = 8, PH_FFD = 9, PH_ROW2 = 10, PH_N = 11 };
__global__ void __launch_bounds__(NWAVES * 64, 2) mega(Args a) {
    extern __shared__ __attribute__((aligned(16))) unsigned char lds[];
    Frame F;
    F.lds = (LAS unsigned char*)lds; F.tid = threadIdx.x; F.lane = F.tid & 63; F.wave = __builtin_amdgcn_readfirstlane(F.tid >> 6); F.G = gridDim.x;
    F.x = a.in[0]; F.w_in = a.in[1]; F.b_fox = a.in[2]; F.lbl = a.in[3]; F.hnw = a.in[4]; F.w_up_a = a.in[5]; F.w_up_b = a.in[6]; F.w_o = a.in[7];
    F.n_mix_pre = a.in[8]; F.n_mix_post = a.in[9]; F.n_ffn_pre = a.in[10]; F.n_ffn_post = a.in[11]; F.w_ffn_in = a.in[12]; F.w_ffn_down = a.in[13];
    F.out = a.out; F.ws = a.ws;
    unsigned char* ws = a.ws;
    const int lo = a.ph_lo, hi = a.ph_hi;
#define IN(k) (lo <= (k) && (k) < hi)
#define REFRESH() do { int t_ = threadIdx.x; asm volatile("" : "+v"(t_)); F.tid = t_; F.lane = t_ & 63; F.wave = __builtin_amdgcn_readfirstlane(t_ >> 6); } while (0)
    if (a.ph_lo < 0) cg::this_grid().sync();
    volatile LAS unsigned* MISC = (volatile LAS unsigned*)(F.lds + 147328);
    if (threadIdx.x < 32) MISC[threadIdx.x] = 0u;
    __syncthreads();
    XcdBarrier bar; bar.bar = (unsigned*)(a.ws + WS_BAR); bar.x = 0; bar.st = nullptr;
    const bool fused = (hi - lo) > 1;
    if (fused) bar = xcd_barrier_post((unsigned*)(a.ws + WS_BAR), MISC + 8);
#define SEAM(k) do { if (IN(k) && IN((k) + 1)) xcd_barrier(bar); } while (0)
    pg8::bf16_t* H1 = (pg8::bf16_t*)(ws + WS_H1);
    if (IN(PH_PRO)) { REFRESH(); p0_prologue(F); }
    SEAM(PH_PRO);
    if (IN(PH_GEMM1)) {
        const int rounds = (32 * 44 + F.G - 1) / F.G, GC = (32 * 44 + rounds - 1) / rounds, nconv = F.G - GC;
        if ((int)blockIdx.x == F.G - 1) { REFRESH(); cum_scan(F); __syncthreads(); }
        if ((int)blockIdx.x < GC) {
            pg8::Gemm g{H1, (const pg8::bf16_t*)(ws + WS_WIN), S, 11264, DM}; pg8::StaticOrder So; So.init(S, 11264, GC, (int)blockIdx.x);
            pg8::EpiProj E{(pg8::bf16_t*)(ws + WS_PROJ), (float*)(ws + WS_ALF), (pg8::bf16_t*)a.out, (const float*)(ws + WS_LB), (unsigned*)(ws + WS_BAR + 15360)};
            pg8::gemm_phase<pg8::EpiProj, pg8::StaticOrder, true, true>(F.lds, g, So, E);
            if (nconv == 0) { REFRESH(); late_weights(F, (int)blockIdx.x, F.G); }
        } else { REFRESH(); late_weights(F, (int)blockIdx.x - GC, nconv); }
    }
    SEAM(PH_GEMM1);
    const hg::T HT{(const hg::bf16*)(ws + WS_PROJ), (const hg::bf16*)(ws + WS_PROJ) + (size_t)S * 1024, (const hg::bf16*)(ws + WS_PROJ) + (size_t)2 * S * 1024, (const hg::bf16*)(ws + WS_PROJ) + (size_t)3 * S * 1024,
                   (const float*)(ws + WS_ALF), (hg::bf16*)(ws + WS_H1), (float*)(ws + WS_DV), (hg::bf16*)(ws + WS_OA), a.in[4]};
    if (IN(PH_MIX)) {
        { const fox::bf16* PR = (const fox::bf16*)(ws + WS_PROJ);
          const fox::AttnT AT{PR + (size_t)4 * S * 1024, PR + (size_t)5 * S * 1024, PR + (size_t)6 * S * 1024, (fox::bf16*)(ws + WS_OA) + AW, (const float*)(ws + WS_CUM2), (const unsigned*)(ws + WS_BAR + 15360)};
          fox::attn_phase((char*)lds, AT, (int)blockIdx.x, (int)gridDim.x); }
        __syncthreads();
        { hg::PreA R; int u = (int)blockIdx.x; if (u < 1024) hg::passA_issue(HT, u, R);
          for (; u < 1024; u += (int)gridDim.x) { const int un = u + (int)gridDim.x; hg::passA_unit(F.lds, HT, u >> 3, u & 7, R, un < 1024 ? un : -1); } }
    }
    SEAM(PH_MIX);
    if (IN(PH_SCAN)) hg::scan_all(HT, (int)(blockIdx.x * 512 + threadIdx.x), (int)(gridDim.x * 512));
    SEAM(PH_SCAN);
    if (IN(PH_HOUT)) { hg::PreC R; int u = (int)blockIdx.x; if (u < 1024) hg::passC_issue(HT, u, R);
        for (; u < 1024; u += (int)gridDim.x) { const int un = u + (int)gridDim.x; hg::passC_unit(F.lds, HT, u >> 3, u & 7, R, un < 1024 ? un : -1); } }
    SEAM(PH_HOUT);
    if (IN(PH_UPA)) {
        pg8::Gemm g{(const pg8::bf16_t*)(ws + WS_OA), (const pg8::bf16_t*)(ws + WS_WUA), S, DM, DM}; pg8::StaticOrder So; So.init(S, DM, F.G, (int)blockIdx.x);
        pg8::EpiUp E{(const pg8::bf16_t*)a.out, (const pg8::bf16_t*)a.out + (size_t)S * DM, H1};
        pg8::gemm_phase<pg8::EpiUp, pg8::StaticOrder, true, true>(F.lds, g, So, E);
    }
    SEAM(PH_UPA);
    if (IN(PH_WO)) {
        pg8::Gemm g{H1, (const pg8::bf16_t*)(ws + WS_WO), S, DM, DM}; pg8::StaticOrder So; So.init(S, DM, F.G, (int)blockIdx.x);
        pg8::EpiT16 E{(pg8::bf16_t*)(ws + WS_T)};
        pg8::gemm_phase<pg8::EpiT16, pg8::StaticOrder, true, true>(F.lds, g, So, E);
    }
    SEAM(PH_WO);
    if (IN(PH_ROW1)) { REFRESH(); rowpass1(F, blockIdx.x * NWAVES + F.wave, F.G * NWAVES, S); }
    SEAM(PH_ROW1);
    if (IN(PH_FFI)) {
        pg8::Gemm g{H1, (const pg8::bf16_t*)(ws + WS_WFI), S, 2 * DFF, DM}; pg8::StaticOrder So; So.init(S, 2 * DFF, F.G, (int)blockIdx.x);
        pg8::EpiSwiglu E{(pg8::bf16_t*)(ws + WS_HID)};
        pg8::gemm_phase<pg8::EpiSwiglu, pg8::StaticOrder, true, true>(F.lds, g, So, E);
        { const int rem = (32 * 44) % F.G, my = rem ? (int)blockIdx.x - rem : (int)blockIdx.x;
          if (my >= 0) { REFRESH(); LAS unsigned* scr = (LAS unsigned*)(F.lds + F.wave * 16384);
              p0_matrix(F.w_ffn_down, DM, DFF, DM, (bf16*)(F.ws + WS_WFD), 0, 0, scr, F.lane, my * NWAVES + F.wave, (rem ? F.G - rem : F.G) * NWAVES); } }
    }
    SEAM(PH_FFI);
    if (IN(PH_FFD)) {
        pg8::Gemm g{(const pg8::bf16_t*)(ws + WS_HID), (const pg8::bf16_t*)(ws + WS_WFD), S, DM, DFF}; pg8::StaticOrder So; So.init(S, DM, F.G, (int)blockIdx.x);
        pg8::EpiT16 E{(pg8::bf16_t*)(ws + WS_T)};
        pg8::gemm_phase<pg8::EpiT16, pg8::StaticOrder, true, true>(F.lds, g, So, E);
    }
    SEAM(PH_FFD);
    if (IN(PH_ROW2)) { REFRESH(); rowpass2(F, blockIdx.x * NWAVES + F.wave, F.G * NWAVES, S); }
#undef IN
#undef SEAM
}

extern "C" void kernel_launch(void* const* d_in, const int* in_sizes, int n_in, void* d_out, int out_size, void* d_ws, size_t ws_size, hipStream_t stream) {
    static int grid = 0;
    if (grid == 0) {
        if (n_in != 14 || out_size != S * DM || ws_size < WS_END) { fprintf(stderr, "kernel_launch: unexpected shapes (n_in %d out %d ws %zu)\n", n_in, out_size, ws_size); grid = -1; return; }
        if (hipFuncSetAttribute((const void*)mega, hipFuncAttributeMaxDynamicSharedMemorySize, LDS_BYTES) != hipSuccess) { fprintf(stderr, "hipFuncSetAttribute failed\n"); grid = -1; return; }
        int dev = 0, cus = 0, per_cu = 0;
        hipGetDevice(&dev); hipDeviceGetAttribute(&cus, hipDeviceAttributeMultiprocessorCount, dev);
        hipOccupancyMaxActiveBlocksPerMultiprocessor(&per_cu, (const void*)mega, NWAVES * 64, LDS_BYTES);
        (void)hipGetLastError();
        if (per_cu < 1) { fprintf(stderr, "occupancy query says %d\n", per_cu); }
        grid = cus;
    }
    if (grid < 0) return;
    Args a{};
    for (int i = 0; i < 14; ++i) a.in[i] = (const float*)d_in[i];
    a.out = (float*)d_out; a.ws = (unsigned char*)d_ws;
    unsigned char* ws = (unsigned char*)d_ws;
    (void)hipMemsetAsync(ws + WS_BAR, 0, BAR_BYTES, stream);
    a.ph_lo = 0; a.ph_hi = PH_N;
    void* kargs[] = {&a};
    hipError_t e = hipLaunchCooperativeKernel((const void*)mega, dim3(grid), dim3(NWAVES * 64), kargs, LDS_BYTES, stream);
    if (e != hipSuccess) fprintf(stderr, "cooperative launch failed: %s (grid %d)\n", hipGetErrorString(e), grid);
}
```
